# Optimizing an MI355X kernel written in HIP

```python
import math
import jax, jax.numpy as jnp
from jax import lax
import numpy as np

D_MODEL = 1024
BATCH = 2
SEQ = 8192
DEPTH = 4
DEC_BATCH = 16
DEC_SEQ = 64
PAST_LEN = 4096

CHUNK = 64
EPS = 1e-6
SSD_HEADS = 8
SSD_HEAD_DIM = 64
SSD_INNER = SSD_HEADS * SSD_HEAD_DIM
SSD_GROUPS = 2
SSD_STATE = 64
CONV_W = 4
CONV_CH = SSD_INNER + 2 * SSD_GROUPS * SSD_STATE
FOX_HEADS = 4
FOX_HEAD_DIM = 64
FOX_INNER = FOX_HEADS * FOX_HEAD_DIM
FOX_BLOCK = 128
MLP_GROUPS = 4
MLP_GROUP_DIM = 64
MLP_INNER = MLP_GROUPS * MLP_GROUP_DIM
MLP_CHUNK = 128
D_MIX = SSD_INNER + FOX_INNER + MLP_INNER
PROJ_SIZES = (SSD_INNER, CONV_CH, SSD_HEADS, FOX_INNER, FOX_INNER, FOX_INNER, FOX_HEADS, MLP_INNER, MLP_INNER)
D_PROJ = SSD_INNER + CONV_CH + SSD_HEADS + 3 * FOX_INNER + FOX_HEADS + 2 * MLP_INNER
PEER_HEADS = 8
PEER_KEYS = 128
PEER_EXPERTS = PEER_KEYS * PEER_KEYS
PEER_D_KEY = 256
PEER_TOPK = 16
PEER_BLOCK = 256

kernel_name = "hymba_ssd_fox_chunkmlp_peer_stream_step"


def rms_norm(x, g):
    xf = x.astype(jnp.float32)
    return xf * lax.rsqrt(jnp.mean(xf * xf, axis=-1, keepdims=True) + EPS) * g.astype(jnp.float32)


def adaln(x, g, shift, scale):
    return rms_norm(x, g) * (1.0 + scale[:, None, :]) + shift[:, None, :]


def causal_conv(xbc, hist, w, b):
    T = xbc.shape[1]
    xp = jnp.concatenate([hist.astype(xbc.dtype), xbc], axis=1)
    out = b
    for tap in range(CONV_W):
        out = out + xp[:, tap:tap + T] * w[tap]
    return jax.nn.silu(out), xp[:, -(CONV_W - 1):]


def ssd_scan(x, dt, A, Bm, Cm, D, s0, L):
    Bt, T, H, P = x.shape
    G, N = Bm.shape[2], Bm.shape[3]
    J = H // G
    nc = T // L
    f32 = jnp.float32
    xr = x.astype(f32).reshape(Bt, nc, L, G, J, P)
    dtr = dt.astype(f32).reshape(Bt, nc, L, G, J)
    Br = Bm.astype(f32).reshape(Bt, nc, L, G, N)
    Cr = Cm.astype(f32).reshape(Bt, nc, L, G, N)
    acum = jnp.cumsum(dtr * A.astype(f32).reshape(G, J), axis=2)
    xdt = xr * dtr[..., None]
    seg = acum[:, :, :, None] - acum[:, :, None, :]
    causal = jnp.tril(jnp.ones((L, L), bool))[:, :, None, None]
    decay = jnp.exp(jnp.where(causal, seg, -jnp.inf))
    cb = jnp.einsum('bctgn,bcsgn->bctsg', Cr, Br)
    y_diag = jnp.einsum('bctsgj,bcsgjp->bctgjp', cb[..., None] * decay, xdt)
    decay_end = jnp.exp(acum[:, :, -1:] - acum)
    states = jnp.einsum('bcsgn,bcsgjp->bcgjpn', Br, xdt * decay_end[..., None])
    chunk_decay = jnp.exp(acum[:, :, -1])

    def step(s, inp):
        st, dec = inp
        return s * dec[..., None, None] + st, s

    final, prev = lax.scan(step, s0.astype(f32).reshape(Bt, G, J, P, N),
                           (jnp.moveaxis(states, 1, 0), jnp.moveaxis(chunk_decay, 1, 0)))
    prev = jnp.moveaxis(prev, 0, 1)
    y_off = jnp.einsum('bctgn,bcgjpn->bctgjp', Cr, prev) * jnp.exp(acum)[..., None]
    y = y_diag + y_off + D.astype(f32).reshape(G, J)[:, :, None] * xr
    return y.reshape(Bt, T, H, P), final.reshape(Bt, H, P, N)


def fox_block(q, k, v, Fq, Fk, qpos, kpos):
    s = jnp.einsum('bqhd,bkhd->bhqk', q, k).astype(jnp.float32) * (FOX_HEAD_DIM ** -0.5)
    s = s + (jnp.moveaxis(Fq, 1, 2)[..., :, None] - jnp.moveaxis(Fk, 1, 2)[..., None, :])
    s = jnp.where(kpos[None, :] <= qpos[:, None], s, -jnp.inf)
    p = jax.nn.softmax(s, axis=-1)
    return jnp.einsum('bhqk,bkhd->bqhd', p.astype(v.dtype), v)


def fox_prompt(q, k, v, F):
    B, T, H, d = q.shape
    nb = T // FOX_BLOCK
    pos = jnp.arange(T)
    qb = q.reshape(B, nb, FOX_BLOCK, H, d).swapaxes(0, 1)
    Fb = F.reshape(B, nb, FOX_BLOCK, H).swapaxes(0, 1)
    pb = pos.reshape(nb, FOX_BLOCK)
    out = lax.map(lambda a: fox_block(a[0], k, v, a[1], F, a[2], pos), (qb, Fb, pb))
    return out.swapaxes(0, 1).reshape(B, T, H, d)


def chunk_mlp(u, vm, w_s, b_s):
    B, T, _ = u.shape
    L = MLP_CHUNK if T % MLP_CHUNK == 0 else T
    nc = T // L
    vg = vm.astype(jnp.float32).reshape(B, T, MLP_GROUPS, MLP_GROUP_DIM)
    mu = jnp.mean(vg, axis=-1, keepdims=True)
    var = jnp.mean(jnp.square(vg - mu), axis=-1, keepdims=True)
    vn = (vg - mu) * lax.rsqrt(var + EPS)
    W = jnp.tril(w_s[:, :L, :L].astype(jnp.float32))
    sv = jnp.einsum('gts,bcsgd->bctgd', W, vn.reshape(B, nc, L, MLP_GROUPS, MLP_GROUP_DIM))
    sv = sv + jnp.transpose(b_s[:, :L])[None, None, :, :, None]
    return u * sv.reshape(B, T, MLP_INNER), vn.reshape(B, T, MLP_INNER)


def peer(h, wq, keys, u_tab, v_tab):
    B, T, D = h.shape
    n = B * T
    nb = -(-n // PEER_BLOCK)
    flat = jnp.pad(h.reshape(n, D), ((0, nb * PEER_BLOCK - n), (0, 0)))

    def block(hb):
        q = (hb @ wq).astype(jnp.float32).reshape(-1, PEER_HEADS, 2, PEER_D_KEY // 2)
        s = jnp.einsum('nhid,hikd->nhik', q, keys.astype(jnp.float32))
        top_s, top_i = lax.top_k(s, PEER_TOPK)
        cand = (top_s[:, :, 0, :, None] + top_s[:, :, 1, None, :]).reshape(-1, PEER_HEADS, PEER_TOPK * PEER_TOPK)
        cidx = (top_i[:, :, 0, :, None] * PEER_KEYS + top_i[:, :, 1, None, :]).reshape(-1, PEER_HEADS, PEER_TOPK * PEER_TOPK)
        best_s, best_pos = lax.top_k(cand, PEER_TOPK)
        eidx = jnp.take_along_axis(cidx, best_pos, axis=-1)
        g = jax.nn.softmax(best_s, axis=-1)
        ue = u_tab[eidx]
        ve = v_tab[eidx]
        act = jax.nn.gelu(jnp.einsum('nhkd,nd->nhk', ue, hb).astype(jnp.float32))
        return jnp.einsum('nhk,nhkd->nd', (g * act).astype(ve.dtype), ve)

    out = lax.map(block, flat.reshape(nb, PEER_BLOCK, D))
    return out.reshape(nb * PEER_BLOCK, D)[:n].reshape(B, T, D)


def token_mixers(h, p, conv_hist, ssm0, past):
    B, T, _ = h.shape
    proj = h @ p['w_in']
    idx = [int(i) for i in np.cumsum(PROJ_SIZES)[:-1]]
    z, xbc, dt_raw, q, k, v, f_raw, u, vm = jnp.split(proj, idx, axis=-1)
    xbc, new_conv = causal_conv(xbc, conv_hist, p['conv_w'], p['conv_b'])
    xs, Bm, Cm = jnp.split(xbc, [SSD_INNER, SSD_INNER + SSD_GROUPS * SSD_STATE], axis=-1)
    dt = jax.nn.softplus((dt_raw + p['dt_bias']).astype(jnp.float32))
    A = -jnp.exp(p['a_log'].astype(jnp.float32))
    L = CHUNK if T % CHUNK == 0 else T
    y_ssd, new_ssm = ssd_scan(xs.reshape(B, T, SSD_HEADS, SSD_HEAD_DIM), dt, A,
                              Bm.reshape(B, T, SSD_GROUPS, SSD_STATE), Cm.reshape(B, T, SSD_GROUPS, SSD_STATE),
                              p['d_skip'], ssm0, L)
    y_ssd = rms_norm(y_ssd.reshape(B, T, SSD_INNER) * jax.nn.silu(z), p['ssd_norm_g'])
    q = rms_norm(q.reshape(B, T, FOX_HEADS, FOX_HEAD_DIM), p['q_norm_g'])
    k = rms_norm(k.reshape(B, T, FOX_HEADS, FOX_HEAD_DIM), p['k_norm_g'])
    v = v.reshape(B, T, FOX_HEADS, FOX_HEAD_DIM)
    logf = jax.nn.log_sigmoid((f_raw + p['fgate_b']).astype(jnp.float32))
    if past is None:
        y_fox = fox_prompt(q, k, v, jnp.cumsum(logf, axis=1))
    else:
        pk, pv, plf = past
        P = pk.shape[1]
        k_all = jnp.concatenate([pk.astype(k.dtype), k], axis=1)
        v_all = jnp.concatenate([pv, v], axis=1)
        F_all = jnp.cumsum(jnp.concatenate([plf.astype(jnp.float32), logf], axis=1), axis=1)
        y_fox = fox_block(q, k_all, v_all, F_all[:, P:], F_all, P + jnp.arange(T), jnp.arange(P + T))
    y_mlp, v_rows = chunk_mlp(jax.nn.gelu(u), jax.nn.gelu(vm), p['w_s'], p['b_s'])
    mix = jnp.concatenate([y_ssd, y_fox.reshape(B, T, FOX_INNER).astype(y_ssd.dtype), y_mlp.astype(y_ssd.dtype)], axis=-1)
    return mix @ p['w_out'], (k, v, logf, new_ssm, new_conv, v_rows)


def trunk_layer(x, c, p, conv_hist, ssm0, past):
    mod = jax.nn.silu(c.astype(jnp.float32)) @ p['w_ada'] + p['b_ada']
    sh1, sc1, g1, sh2, sc2, g2 = jnp.split(mod, 6, axis=-1)
    h = adaln(x, p['norm1_g'], sh1, sc1)
    mix, st = token_mixers(h, p, conv_hist, ssm0, past)
    x = x + g1[:, None, :] * mix
    h2 = adaln(x, p['norm2_g'], sh2, sc2)
    x = x + g2[:, None, :] * peer(h2, p['peer_wq'], p['peer_keys'], p['peer_u'], p['peer_v'])
    return x, st


def setup_inputs(seed: int = 0) -> dict:
    key = jax.random.key(seed)
    ks = list(jax.random.split(key, 40))
    f32 = jnp.float32
    nrm = lambda k, shape, s: jax.random.normal(k, shape, f32) * s
    dt0 = jnp.exp(jax.random.uniform(ks[12], (DEPTH, SSD_HEADS), f32, math.log(1e-3), math.log(1e-1)))
    return {
        'x_prompt': nrm(ks[0], (BATCH, SEQ, D_MODEL), 1.0),
        'x_sample': nrm(ks[1], (DEC_BATCH, DEC_SEQ, D_MODEL), 1.0),
        'c_prompt': nrm(ks[2], (BATCH, D_MODEL), 1.0),
        'c_sample': nrm(ks[3], (DEC_BATCH, D_MODEL), 1.0),
        'cache_fox_k': nrm(ks[4], (DEPTH, DEC_BATCH, PAST_LEN, FOX_HEADS, FOX_HEAD_DIM), 1.0),
        'cache_fox_v': nrm(ks[5], (DEPTH, DEC_BATCH, PAST_LEN, FOX_HEADS, FOX_HEAD_DIM), 1.0),
        'cache_fox_logf': jax.nn.log_sigmoid(3.0 + nrm(ks[6], (DEPTH, DEC_BATCH, PAST_LEN, FOX_HEADS), 1.0)),
        'state_ssm': nrm(ks[7], (DEPTH, DEC_BATCH, SSD_HEADS, SSD_HEAD_DIM, SSD_STATE), 0.1),
        'state_conv': nrm(ks[8], (DEPTH, DEC_BATCH, CONV_W - 1, CONV_CH), 1.0),
        'norm1_g': 1.0 + nrm(ks[9], (DEPTH, D_MODEL), 0.05),
        'norm2_g': 1.0 + nrm(ks[10], (DEPTH, D_MODEL), 0.05),
        'w_ada': nrm(ks[11], (DEPTH, D_MODEL, 6 * D_MODEL), 0.5 * D_MODEL ** -0.5),
        'b_ada': nrm(ks[13], (DEPTH, 6 * D_MODEL), 0.02),
        'w_in': nrm(ks[14], (DEPTH, D_MODEL, D_PROJ), D_MODEL ** -0.5),
        'conv_w': nrm(ks[15], (DEPTH, CONV_W, CONV_CH), CONV_W ** -0.5),
        'conv_b': nrm(ks[16], (DEPTH, CONV_CH), 0.02),
        'dt_bias': dt0 + jnp.log(-jnp.expm1(-dt0)),
        'a_log': jnp.log(jax.random.uniform(ks[17], (DEPTH, SSD_HEADS), f32, 1.0, 16.0)),
        'd_skip': 1.0 + nrm(ks[18], (DEPTH, SSD_HEADS), 0.1),
        'ssd_norm_g': 1.0 + nrm(ks[19], (DEPTH, SSD_INNER), 0.05),
        'q_norm_g': 1.0 + nrm(ks[20], (DEPTH, FOX_HEAD_DIM), 0.05),
        'k_norm_g': 1.0 + nrm(ks[21], (DEPTH, FOX_HEAD_DIM), 0.05),
        'fgate_b': jax.random.uniform(ks[22], (DEPTH, FOX_HEADS), f32, 1.0, 5.0),
        'w_s': nrm(ks[23], (DEPTH, MLP_GROUPS, MLP_CHUNK, MLP_CHUNK), MLP_CHUNK ** -0.5),
        'b_s': 1.0 + nrm(ks[24], (DEPTH, MLP_GROUPS, MLP_CHUNK), 0.1),
        'w_out': nrm(ks[25], (DEPTH, D_MIX, D_MODEL), D_MIX ** -0.5),
        'peer_wq': nrm(ks[26], (DEPTH, D_MODEL, PEER_HEADS * PEER_D_KEY), D_MODEL ** -0.5),
        'peer_keys': nrm(ks[27], (DEPTH, PEER_HEADS, 2, PEER_KEYS, PEER_D_KEY // 2), (PEER_D_KEY // 2) ** -0.5),
        'peer_u': nrm(ks[28], (DEPTH, PEER_EXPERTS, D_MODEL), D_MODEL ** -0.5),
        'peer_v': nrm(ks[29], (DEPTH, PEER_EXPERTS, D_MODEL), 0.5 * PEER_HEADS ** -0.5),
    }


def reference(x_prompt, x_sample, c_prompt, c_sample, cache_fox_k, cache_fox_v, cache_fox_logf,
              state_ssm, state_conv, norm1_g, norm2_g, w_ada, b_ada, w_in, conv_w, conv_b, dt_bias,
              a_log, d_skip, ssd_norm_g, q_norm_g, k_norm_g, fgate_b, w_s, b_s, w_out,
              peer_wq, peer_keys, peer_u, peer_v):
    yp, ys = x_prompt, x_sample
    Bp = x_prompt.shape[0]
    kp, vp, lfp, ssmp, convp = [], [], [], [], []
    kss, vss, lfs, ssms, convs, mlpvs = [], [], [], [], [], []
    for l in range(DEPTH):
        p = {'norm1_g': norm1_g[l], 'norm2_g': norm2_g[l], 'w_ada': w_ada[l], 'b_ada': b_ada[l],
             'w_in': w_in[l], 'conv_w': conv_w[l], 'conv_b': conv_b[l], 'dt_bias': dt_bias[l],
             'a_log': a_log[l], 'd_skip': d_skip[l], 'ssd_norm_g': ssd_norm_g[l],
             'q_norm_g': q_norm_g[l], 'k_norm_g': k_norm_g[l], 'fgate_b': fgate_b[l],
             'w_s': w_s[l], 'b_s': b_s[l], 'w_out': w_out[l], 'peer_wq': peer_wq[l],
             'peer_keys': peer_keys[l], 'peer_u': peer_u[l], 'peer_v': peer_v[l]}
        yp, (k1, v1, lf1, s1, cv1, _) = trunk_layer(
            yp, c_prompt, p, jnp.zeros((Bp, CONV_W - 1, CONV_CH), x_prompt.dtype),
            jnp.zeros((Bp, SSD_HEADS, SSD_HEAD_DIM, SSD_STATE), jnp.float32), None)
        ys, (k2, v2, lf2, s2, cv2, mv2) = trunk_layer(
            ys, c_sample, p, state_conv[l], state_ssm[l], (cache_fox_k[l], cache_fox_v[l], cache_fox_logf[l]))
        kp.append(k1); vp.append(v1); lfp.append(lf1); ssmp.append(s1); convp.append(cv1)
        kss.append(k2); vss.append(v2); lfs.append(lf2); ssms.append(s2); convs.append(cv2); mlpvs.append(mv2)
    return (yp, ys,
            jnp.stack(kp), jnp.stack(vp), jnp.stack(lfp), jnp.stack(ssmp), jnp.stack(convp),
            jnp.stack(kss), jnp.stack(vss), jnp.stack(lfs), jnp.stack(ssms), jnp.stack(convs), jnp.stack(mlpvs))
```

```cpp
#include <hip/hip_runtime.h>
#include <stdint.h>
#include <math.h>

#define DEVI __device__ __forceinline__

constexpr int D = 1024, NB_P = 2, T_P = 8192, NB_S = 16, T_S = 64, PAST = 4096, DEPTH = 4;
constexpr int M_P = NB_P * T_P, M_S = NB_S * T_S, M = M_P + M_S, NSEQ = NB_P + NB_S;
constexpr int DPROJ = 2572, CONVC = 768;
constexpr int S_DT = 1280, S_F = 2056;
constexpr int NP = 2560;
constexpr int O_Z = 0, O_XBC = 512, O_Q = 1280, O_K = 1536, O_V = 1792, O_U = 2048, O_VM = 2304;
constexpr int NCH_P = T_P / 64, NCHUNK = NB_P * NCH_P + NB_S;
constexpr int NEXP = 16384;
constexpr int APS_QB0 = 16;
constexpr int FS_LEN = PAST + T_S;
constexpr float EPS = 1e-6f;

constexpr size_t OUT_Y = 0;
constexpr size_t OUT_KP = (size_t)M * D;
constexpr size_t OUT_VP = OUT_KP + (size_t)DEPTH * M_P * 256;
constexpr size_t OUT_LFP = OUT_VP + (size_t)DEPTH * M_P * 256;
constexpr size_t OUT_SSMP = OUT_LFP + (size_t)DEPTH * M_P * 4;
constexpr size_t OUT_CONVP = OUT_SSMP + (size_t)DEPTH * NB_P * 8 * 64 * 64;
constexpr size_t OUT_KS = OUT_CONVP + (size_t)DEPTH * NB_P * 3 * CONVC;
constexpr size_t OUT_VS = OUT_KS + (size_t)DEPTH * M_S * 256;
constexpr size_t OUT_LFS = OUT_VS + (size_t)DEPTH * M_S * 256;
constexpr size_t OUT_SSMS = OUT_LFS + (size_t)DEPTH * M_S * 4;
constexpr size_t OUT_CONVS = OUT_SSMS + (size_t)DEPTH * NB_S * 8 * 64 * 64;
constexpr size_t OUT_MLPV = OUT_CONVS + (size_t)DEPTH * NB_S * 3 * CONVC;
constexpr size_t OUT_TOTAL = OUT_MLPV + (size_t)DEPTH * M_S * 256;
static_assert(OUT_TOTAL == 57329664, "output size");

typedef unsigned short bf16_t;
DEVI float bf2f(bf16_t v) { return __uint_as_float((unsigned)v << 16); }
DEVI bf16_t f2bf(float f) { unsigned u = __float_as_uint(f); return (bf16_t)((u + 0x7fffu + ((u >> 16) & 1u)) >> 16); }


constexpr size_t al256(size_t x) { return (x + 255) & ~(size_t)255; }
constexpr size_t WS_BAR = 0;
constexpr size_t WS_MOD = 16384;
constexpr size_t WS_RSTD = WS_MOD + al256((size_t)DEPTH * NSEQ * 6144 * 4);
constexpr size_t WS_H = WS_RSTD + al256((size_t)M * 4);
constexpr size_t WS_FLOC = WS_H;
constexpr size_t WS_CSUM = WS_FLOC + al256((size_t)M * 4 * 4);
constexpr size_t WS_HB = WS_CSUM + al256((size_t)(NCHUNK + NB_S * 64) * 4 * 4);
constexpr size_t WS_PROJ = WS_HB + al256((size_t)M * D * 2);
constexpr size_t WS_DTF = WS_PROJ + al256((size_t)M * NP * 2);
constexpr size_t WS_XBC = WS_DTF + al256((size_t)M * 12 * 4);
constexpr size_t WS_DT = WS_XBC + al256((size_t)M * CONVC * 4);
constexpr size_t WS_ACUM = WS_DT + al256((size_t)M * 8 * 4);
constexpr size_t WS_QN = WS_ACUM + al256((size_t)M * 8 * 4);
constexpr size_t WS_QB = WS_QN;
constexpr size_t WS_KB = WS_QB + al256((size_t)M * 256 * 2);
constexpr size_t WS_VB = WS_KB + al256((size_t)M * 256 * 2);
constexpr size_t WS_APART = WS_VB + al256((size_t)M * 256 * 2);
constexpr size_t WS_AML = WS_APART + al256((size_t)NB_S * 16 * 64 * 64 * 4);
constexpr size_t WS_LOGF = WS_AML + al256((size_t)NB_S * 16 * 64 * 2 * 4);
constexpr size_t WS_FP = WS_LOGF + al256((size_t)M * 4 * 4);
constexpr size_t WS_FS = WS_FP + al256((size_t)M_P * 4 * 4);
constexpr size_t WS_VN = WS_FS + al256((size_t)NB_S * FS_LEN * 4 * 4);
constexpr size_t WS_MIX = WS_VN + al256((size_t)M * 256 * 4);
constexpr size_t WS_CB = WS_MIX + al256((size_t)M * D * 2);
constexpr size_t WS_STATES = WS_CB + al256((size_t)NCHUNK * 8192 * 4);
constexpr size_t WS_YZ = WS_STATES + al256((size_t)NCHUNK * 32768 * 4);
constexpr size_t WS_PQ = WS_YZ + al256((size_t)M * 512 * 4);
constexpr size_t WS_TS = WS_PQ + al256((size_t)M * 2048 * 2);
constexpr size_t WS_TI = WS_TS + al256((size_t)M * 256 * 4);
constexpr size_t WS_EIDX = WS_TI + al256((size_t)M * 256 * 4);
constexpr size_t WS_GW = WS_EIDX + al256((size_t)M * 128 * 4);
constexpr size_t WS_COEF = WS_GW + al256((size_t)M * 128 * 4);
constexpr size_t WS_WIN = WS_COEF + al256((size_t)M * 128 * 4);
constexpr size_t WS_WOUT = WS_WIN + al256((size_t)DEPTH * NP * D * 2);
constexpr size_t WS_WQ = WS_WOUT + al256((size_t)DEPTH * D * D * 2);
constexpr size_t WS_WSMALL = WS_WQ + al256((size_t)DEPTH * 2048 * D * 2);
constexpr size_t WS_KEYSB = WS_WSMALL + al256((size_t)DEPTH * 12 * D * 4);
constexpr size_t WS_UT = WS_KEYSB + al256((size_t)DEPTH * 16 * 128 * 128 * 2);
constexpr size_t WS_VT = WS_UT + al256((size_t)DEPTH * NEXP * D * 2);
constexpr size_t WS_SINV = WS_VT + al256((size_t)DEPTH * NEXP * D * 2);
constexpr size_t WS_H8 = WS_SINV + al256((size_t)2 * DEPTH * NEXP * 4);
constexpr size_t WS_END = WS_H8 + al256((size_t)2 * M * D);

struct P {
    const float* in[30];
    float* out;
    unsigned char* ws;
    DEVI float* x() const { return out; }
    DEVI float* mod() const { return (float*)(ws + WS_MOD); }
    DEVI float* rstd() const { return (float*)(ws + WS_RSTD); }
    DEVI float* Floc() const { return (float*)(ws + WS_FLOC); }
    DEVI float* csum() const { return (float*)(ws + WS_CSUM); }
    DEVI bf16_t* hb() const { return (bf16_t*)(ws + WS_HB); }
    DEVI bf16_t* proj() const { return (bf16_t*)(ws + WS_PROJ); }
    DEVI float* dtf() const { return (float*)(ws + WS_DTF); }
    DEVI bf16_t* prevb() const { return (bf16_t*)(ws + WS_XBC); }
    DEVI float* dt() const { return (float*)(ws + WS_DT); }
    DEVI float* acum() const { return (float*)(ws + WS_ACUM); }
    DEVI bf16_t* qb() const { return (bf16_t*)(ws + WS_QB); }
    DEVI bf16_t* kb() const { return (bf16_t*)(ws + WS_KB); }
    DEVI bf16_t* vb() const { return (bf16_t*)(ws + WS_VB); }
    DEVI float* apart() const { return (float*)(ws + WS_APART); }
    DEVI float* aml() const { return (float*)(ws + WS_AML); }
    DEVI float* logf() const { return (float*)(ws + WS_LOGF); }
    DEVI float* Fp() const { return (float*)(ws + WS_FP); }
    DEVI float* Fs() const { return (float*)(ws + WS_FS); }
    DEVI bf16_t* vnb() const { return (bf16_t*)(ws + WS_VN); }
    DEVI bf16_t* mix() const { return (bf16_t*)(ws + WS_MIX); }
    DEVI bf16_t* cact() const { return (bf16_t*)(ws + WS_CB); }
    DEVI float* states() const { return (float*)(ws + WS_STATES); }
    DEVI float* ydg() const { return (float*)(ws + WS_YZ); }
    DEVI bf16_t* pq() const { return (bf16_t*)(ws + WS_PQ); }
    DEVI float* ppart() const { return (float*)(ws + WS_PQ); }
    DEVI float* pml() const { return (float*)(ws + WS_PQ + (size_t)NB_P * 4 * (32 - APS_QB0) * 2 * 256 * 64 * 4); }
    DEVI float* ts() const { return (float*)(ws + WS_TS); }
    DEVI int* ti() const { return (int*)(ws + WS_TI); }
    DEVI int* eidx() const { return (int*)(ws + WS_EIDX); }
    DEVI float* gw() const { return (float*)(ws + WS_GW); }
    DEVI float* coef() const { return (float*)(ws + WS_COEF); }
    DEVI bf16_t* w_in_t() const { return (bf16_t*)(ws + WS_WIN); }
    DEVI bf16_t* w_out_t() const { return (bf16_t*)(ws + WS_WOUT); }
    DEVI bf16_t* wq_t() const { return (bf16_t*)(ws + WS_WQ); }
    DEVI float* wsmall() const { return (float*)(ws + WS_WSMALL); }
    DEVI bf16_t* keysb() const { return (bf16_t*)(ws + WS_KEYSB); }
    DEVI unsigned char* u8() const { return ws + WS_UT; }
    DEVI unsigned char* v8() const { return ws + WS_VT; }
    DEVI float* sinv() const { return (float*)(ws + WS_SINV); }
    DEVI unsigned char* h8() const { return ws + WS_H8; }
};

typedef const float* cfp_t;
DEVI cfp_t inp(int i) { const __attribute__((address_space(4))) cfp_t* k = (const __attribute__((address_space(4))) cfp_t*)__builtin_amdgcn_kernarg_segment_ptr(); return *(const volatile __attribute__((address_space(4))) cfp_t*)(k + i); }
DEVI int row_seq(int r) { return r < M_P ? r / T_P : NB_P + (r - M_P) / T_S; }
DEVI int row_t(int r) { return r < M_P ? r % T_P : (r - M_P) % T_S; }
DEVI float silu_f(float x) { return x / (1.f + expf(-x)); }
DEVI float softplus_f(float x) { return x > 20.f ? x : log1pf(expf(x)); }
DEVI float gelu_f(float x) { const float u = 0.7978845608028654f * (x + 0.044715f * x * x * x); return x * __builtin_amdgcn_rcpf(1.f + __expf(-2.f * u)); }
DEVI unsigned pk2bf(float lo, float hi) { unsigned r; asm volatile("v_cvt_pk_bf16_f32 %0, %1, %2" : "=v"(r) : "v"(lo), "v"(hi)); return r; }
typedef float f32x2c_t __attribute__((ext_vector_type(2)));
typedef __bf16 bf16x2c_t __attribute__((ext_vector_type(2)));
DEVI unsigned pk2bf_c(float lo, float hi) { const f32x2c_t v = {lo, hi}; const bf16x2c_t r = __builtin_convertvector(v, bf16x2c_t); return __builtin_bit_cast(unsigned, r); }
#define PROJ(r, c) bf2f(p.proj()[(size_t)(r) * NP + (c)])

namespace pg8 {
#define PG8_LAS __attribute__((address_space(3)))

typedef short bf16x8 __attribute__((ext_vector_type(8)));
typedef float f32x4 __attribute__((ext_vector_type(4)));
typedef unsigned u32x4 __attribute__((ext_vector_type(4)));
constexpr int BM = 256, BK = 64, HALF = 128, HTB = HALF * BK * 2  , STAGE_BYTES = 8 * HTB, NXCD = 8, WGM = 8;

__host__ __device__ __forceinline__ int lds_byte(int r, int c) { const int st = (r >> 4) * 2 + (c >> 5), rr = r & 15, cc = c & 31, ob = rr * 64 + cc * 2; return st * 1024 + (ob ^ (((ob >> 9) & 1) << 5)); }
__host__ __device__ __forceinline__ void stage_rc(int b, int& R, int& C) { const int st = b / 1024, sb = b % 1024, swz = sb ^ (((sb >> 9) & 1) << 5); R = (st >> 1) * 16 + swz / 64; C = (st & 1) * 32 + (swz % 64) / 2; }
__host__ __device__ __forceinline__ int perm32(int rho) { const int n = rho >> 4, i = rho & 15; return 8 * (i >> 2) + 4 * n + (i & 3); }

struct Unit { int pm, pn; };
struct Gemm { const bf16_t* A; const bf16_t* Bt; int M, N, K; };

struct StaticOrder {
    int nM, nN, nwg, G, c;
    __host__ __device__ void init(int M, int N, int G_, int c_) { nM = M / BM; nN = N / BM; nwg = nM * nN; G = G_; c = c_; }
    __host__ __device__ bool next(int i, Unit& u) const {
        const long L = (long)i * G + c; if (L >= nwg) return false;
        int wgid = (int)L; { const int q = nwg / NXCD, r = nwg % NXCD, xcd = wgid % NXCD, off = wgid / NXCD; wgid = (xcd < r ? xcd * (q + 1) : r * (q + 1) + (xcd - r) * q) + off; }
        const int nig = WGM * nN, gid = wgid / nig, fm = gid * WGM, gsz = (nM - fm) < WGM ? (nM - fm) : WGM;
        u.pm = fm + ((wgid % nig) % gsz); u.pn = (wgid % nig) / gsz; return true;
    }
    __device__ __forceinline__ void a_ready(const Unit&) const {}
    __device__ __forceinline__ void done(const Unit&) const {}
};

__device__ __forceinline__ unsigned cvt_pk_bf16(float lo, float hi) { unsigned r; asm volatile("v_cvt_pk_bf16_f32 %0, %1, %2" : "=v"(r) : "v"(lo), "v"(hi)); return r; }
struct EpiBf16 {
    static constexpr bool PERM = true, AFTER_DRAIN = false;
    bf16_t* O; int ldc;
    __device__ __forceinline__ void operator()(const f32x4 (&acc)[2][2][4][2], const Unit& u, int wr, int wc, int fr, int fq) const {
        const int row0 = u.pm * BM + wr * 64 + fr; const int col0 = u.pn * BM + wc * 32 + 8 * fq;
#pragma unroll
        for (int ai = 0; ai < 2; ++ai)
#pragma unroll
            for (int m = 0; m < 4; ++m) { bf16_t* rowp = O + (size_t)(row0 + ai * HALF + m * 16) * ldc + col0;
#pragma unroll
                for (int bj = 0; bj < 2; ++bj) { const f32x4 v0 = acc[ai][bj][m][0], v1 = acc[ai][bj][m][1];
                    u32x4 w; w.x = cvt_pk_bf16(v0[0], v0[1]); w.y = cvt_pk_bf16(v0[2], v0[3]); w.z = cvt_pk_bf16(v1[0], v1[1]); w.w = cvt_pk_bf16(v1[2], v1[3]);
                    *(u32x4*)(rowp + bj * HALF) = w; } }
    }
};
struct EpiResid {
    static constexpr bool PERM = true, AFTER_DRAIN = false;
    float* X; const float* gate; const float* Xin;
    __device__ __forceinline__ void operator()(const f32x4 (&acc)[2][2][4][2], const Unit& u, int wr, int wc, int fr, int fq) const {
        const int row0 = u.pm * BM + wr * 64 + fr; const int col0 = u.pn * BM + wc * 32 + 8 * fq;
#pragma unroll
        for (int ai = 0; ai < 2; ++ai) {
            const int rb = u.pm * BM + ai * HALF + wr * 64;
            const int s = rb < 16384 ? rb / 8192 : 2 + (rb - 16384) / 64;
            const float* gp = gate + (size_t)s * 6144 + col0;
#pragma unroll
            for (int bj = 0; bj < 2; ++bj) { const f32x4 g0 = *(const f32x4*)(gp + bj * HALF), g1 = *(const f32x4*)(gp + bj * HALF + 4);
#pragma unroll
                for (int m = 0; m < 4; ++m) { const size_t xo = (size_t)(row0 + ai * HALF + m * 16) * 1024 + col0 + bj * HALF; float* xp = X + xo; const float* xi = Xin + xo;
                    f32x4 x0 = *(const f32x4*)xi, x1 = *(const f32x4*)(xi + 4);
                    x0 += g0 * acc[ai][bj][m][0]; x1 += g1 * acc[ai][bj][m][1];
                    *(f32x4*)xp = x0; *(f32x4*)(xp + 4) = x1; } }
        }
    }
};

template <class Epi, class Sched, bool ALIGN_EPI = false, bool SP2 = false>
__device__ __forceinline__ void gemm_phase(PG8_LAS unsigned char* lds, const Gemm g, const Sched& S, const Epi& E) {
    int tid_ = threadIdx.x; asm volatile("" : "+v"(tid_));
    const int tid = tid_, wid = __builtin_amdgcn_readfirstlane(tid >> 6), lane = tid & 63, wr = wid >> 2, wc = wid & 3, fr = lane & 15, fq = lane >> 4;
    const int K = g.K, nt = K / BK;
    unsigned voffA[2], voffB[2];
#pragma unroll
    for (int i = 0; i < 2; ++i) { int R, C; stage_rc(tid * 16 + i * 8192, R, C); const int Rb = Epi::PERM ? ((R & ~31) + perm32(R & 31)) : R;
        voffA[i] = (unsigned)(R * K + C) * 2u; voffB[i] = (unsigned)(Rb * K + C) * 2u; }
    const size_t kstep = (size_t)(BK * 2);
    const size_t hstep = (size_t)HALF * K * 2;
    const size_t tstep = 2 * hstep;
    const unsigned ldsw = (unsigned)wid * 1024u;
    const int aoff = lds_byte(wr * 64 + fr, fq * 8), boff = lds_byte(wc * 32 + fr, fq * 8);
#define PG8_SA(b, h) (((b) * 2 + (h)) * HTB)
#define PG8_SB(b, h) ((4 + (b) * 2 + (h)) * HTB)
#define PG8_STAGE(bufoff, gbase, voff) do { _Pragma("unroll") for (int _i = 0; _i < 2; ++_i) \
        __builtin_amdgcn_global_load_lds((const unsigned*)((const char*)(gbase) + (voff)[_i]), (PG8_LAS unsigned*)(lds + (bufoff) + ldsw + _i * 8192), 16, 0, 0); } while (0)
#define PG8_LDA(dst, b, h) do { _Pragma("unroll") for (int m = 0; m < 4; ++m) _Pragma("unroll") for (int k = 0; k < 2; ++k) dst[m][k] = *(const PG8_LAS bf16x8*)(lds + PG8_SA(b, h) + aoff + m * 2048 + k * 1024); } while (0)
#define PG8_LDB(dst, b, h) do { _Pragma("unroll") for (int n = 0; n < 2; ++n) _Pragma("unroll") for (int k = 0; k < 2; ++k) dst[n][k] = *(const PG8_LAS bf16x8*)(lds + PG8_SB(b, h) + boff + n * 2048 + k * 1024); } while (0)
#define PG8_MMA(ai, bj, At, Bt) do { __builtin_amdgcn_s_setprio(1); _Pragma("unroll") for (int m = 0; m < 4; ++m) _Pragma("unroll") for (int n = 0; n < 2; ++n) _Pragma("unroll") for (int k = 0; k < 2; ++k) \
        acc[ai][bj][m][n] = __builtin_amdgcn_mfma_f32_16x16x32_bf16(Bt[n][k], At[m][k], acc[ai][bj][m][n], 0, 0, 0); __builtin_amdgcn_s_setprio(0); } while (0)
#define PG8_WAIT_V(n) asm volatile("s_waitcnt vmcnt(" #n ")" ::: "memory")
#define PG8_WAIT_L(n) asm volatile("s_waitcnt lgkmcnt(" #n ")" ::: "memory")
#define PG8_BAR __builtin_amdgcn_s_barrier()
#define PG8_SCHED __builtin_amdgcn_sched_barrier(0)
    Unit cur, nxt; int ui = 0;
    if (!S.next(0, cur)) return;
    f32x4 acc[2][2][4][2];
#pragma unroll
    for (int a = 0; a < 2; ++a)
#pragma unroll
        for (int b = 0; b < 2; ++b)
#pragma unroll
            for (int m = 0; m < 4; ++m)
#pragma unroll
                for (int n = 0; n < 2; ++n) acc[a][b][m][n] = (f32x4){0.f, 0.f, 0.f, 0.f};
    bf16x8 At[4][2], B0[2][2], B1[2][2];
    const char* cA = (const char*)g.A + (size_t)cur.pm * tstep; const char* cB = (const char*)g.Bt + (size_t)cur.pn * tstep;
    S.a_ready(cur);
    if constexpr (SP2) {
        PG8_STAGE(PG8_SB(0, 0), cB, voffB); PG8_STAGE(PG8_SB(0, 1), cB + hstep, voffB); PG8_STAGE(PG8_SA(0, 0), cA, voffA); PG8_STAGE(PG8_SA(0, 1), cA + hstep, voffA);
        if (wr == 1) PG8_BAR;
        PG8_WAIT_V(2); PG8_BAR;
        PG8_STAGE(PG8_SB(1, 0), cB + kstep, voffB); PG8_STAGE(PG8_SA(1, 0), cA + kstep, voffA); PG8_STAGE(PG8_SB(1, 1), cB + hstep + kstep, voffB);
        PG8_WAIT_V(6); PG8_BAR;
    } else {
        PG8_STAGE(PG8_SB(0, 0), cB, voffB); PG8_STAGE(PG8_SA(0, 0), cA, voffA); PG8_STAGE(PG8_SB(0, 1), cB + hstep, voffB); PG8_STAGE(PG8_SA(0, 1), cA + hstep, voffA);
        if (wr == 1) PG8_BAR;
        PG8_WAIT_V(4); PG8_BAR;
        PG8_STAGE(PG8_SB(1, 0), cB + kstep, voffB); PG8_STAGE(PG8_SA(1, 0), cA + kstep, voffA); PG8_STAGE(PG8_SB(1, 1), cB + hstep + kstep, voffB);
        PG8_WAIT_V(6); PG8_BAR;
    }
    for (;;) {
        const bool has_next = S.next(ui + 1, nxt);
        const char* nA = has_next ? (const char*)g.A + (size_t)nxt.pm * tstep : cA; const char* nB = has_next ? (const char*)g.Bt + (size_t)nxt.pn * tstep : cB;
        for (int t = 0; t < nt; t += 2) {
            const bool last = (t == nt - 2);
            const char* a1 = cA + (size_t)(t + 1) * kstep;
            const char* a2 = last ? nA : cA + (size_t)(t + 2) * kstep; const char* b2 = last ? nB : cB + (size_t)(t + 2) * kstep;
            const char* a3 = a2 + kstep; const char* b3 = b2 + kstep;
            if (last && has_next) S.a_ready(nxt);
            if constexpr (SP2) {
            PG8_LDB(B0, 0, 0); PG8_LDB(B1, 0, 1); PG8_SCHED; PG8_LDA(At, 0, 0); PG8_STAGE(PG8_SA(1, 1), a1 + hstep, voffA);
            PG8_WAIT_V(8); PG8_WAIT_L(0); PG8_BAR; PG8_MMA(0, 0, At, B0); PG8_MMA(0, 1, At, B1); PG8_BAR; PG8_SCHED;
            PG8_LDA(At, 0, 1); PG8_STAGE(PG8_SB(0, 0), b2, voffB); PG8_STAGE(PG8_SB(0, 1), b2 + hstep, voffB); PG8_STAGE(PG8_SA(0, 0), a2, voffA);
            PG8_WAIT_V(8); PG8_WAIT_L(0); PG8_BAR; PG8_MMA(1, 0, At, B0); PG8_MMA(1, 1, At, B1); PG8_BAR; PG8_SCHED;
            PG8_LDB(B0, 1, 0); PG8_LDB(B1, 1, 1); PG8_SCHED; PG8_LDA(At, 1, 0); PG8_STAGE(PG8_SA(0, 1), a2 + hstep, voffA);
            PG8_WAIT_V(8); PG8_WAIT_L(0); PG8_BAR; PG8_MMA(0, 0, At, B0); PG8_MMA(0, 1, At, B1); PG8_BAR; PG8_SCHED;
            PG8_LDA(At, 1, 1); PG8_STAGE(PG8_SB(1, 0), b3, voffB); PG8_STAGE(PG8_SB(1, 1), b3 + hstep, voffB); PG8_STAGE(PG8_SA(1, 0), a3, voffA);
            PG8_WAIT_V(8); PG8_WAIT_L(0); PG8_BAR; PG8_MMA(1, 0, At, B0); PG8_MMA(1, 1, At, B1); PG8_BAR; PG8_SCHED;
            } else {
            PG8_LDB(B0, 0, 0); PG8_SCHED; PG8_LDA(At, 0, 0); PG8_STAGE(PG8_SA(1, 1), a1 + hstep, voffA);
            PG8_WAIT_L(8); PG8_BAR; PG8_WAIT_L(0); PG8_MMA(0, 0, At, B0); PG8_BAR; PG8_SCHED;
            PG8_LDB(B1, 0, 1); PG8_STAGE(PG8_SB(0, 0), b2, voffB);
            PG8_BAR; PG8_WAIT_L(0); PG8_MMA(0, 1, At, B1); PG8_BAR;
            PG8_LDA(At, 0, 1); PG8_STAGE(PG8_SA(0, 0), a2, voffA);
            PG8_BAR; PG8_WAIT_L(0); PG8_MMA(1, 0, At, B0); PG8_BAR; PG8_SCHED;
            PG8_STAGE(PG8_SB(0, 1), b2 + hstep, voffB);
            PG8_WAIT_V(6); PG8_BAR; PG8_MMA(1, 1, At, B1); PG8_BAR;
            PG8_LDB(B0, 1, 0); PG8_SCHED; PG8_LDA(At, 1, 0); PG8_STAGE(PG8_SA(0, 1), a2 + hstep, voffA);
            PG8_WAIT_L(8); PG8_BAR; PG8_WAIT_L(0); PG8_MMA(0, 0, At, B0); PG8_BAR; PG8_SCHED;
            PG8_LDB(B1, 1, 1); PG8_STAGE(PG8_SB(1, 0), b3, voffB);
            PG8_BAR; PG8_WAIT_L(0); PG8_MMA(0, 1, At, B1); PG8_BAR;
            PG8_LDA(At, 1, 1); PG8_STAGE(PG8_SA(1, 0), a3, voffA);
            PG8_BAR; PG8_WAIT_L(0); PG8_MMA(1, 0, At, B0); PG8_BAR; PG8_SCHED;
            PG8_STAGE(PG8_SB(1, 1), b3 + hstep, voffB);
            PG8_WAIT_V(6); PG8_BAR; PG8_MMA(1, 1, At, B1); PG8_BAR;
            }
        }
        if constexpr (ALIGN_EPI) { if (wr == 0) PG8_BAR; }
        if constexpr (!Epi::AFTER_DRAIN) { E(acc, cur, wr, wc, fr, fq); S.done(cur); }
        if (!has_next) break;
#pragma unroll
        for (int a = 0; a < 2; ++a)
#pragma unroll
            for (int b = 0; b < 2; ++b)
#pragma unroll
                for (int m = 0; m < 4; ++m)
#pragma unroll
                    for (int n = 0; n < 2; ++n) acc[a][b][m][n] = (f32x4){0.f, 0.f, 0.f, 0.f};
        cur = nxt; cA = nA; cB = nB; ++ui;
        if constexpr (ALIGN_EPI) { if (wr == 1) PG8_BAR; }
    }
    PG8_WAIT_V(0);
    if constexpr (!ALIGN_EPI) { if (wr == 0) PG8_BAR; }
    PG8_BAR;
    if constexpr (Epi::AFTER_DRAIN) { E.fused(acc, cur, wr, wc, fr, fq, lds, wid, lane); S.done(cur); }
#undef PG8_SA
#undef PG8_SB
#undef PG8_STAGE
#undef PG8_LDA
#undef PG8_LDB
#undef PG8_MMA
#undef PG8_WAIT_V
#undef PG8_WAIT_L
#undef PG8_BAR
#undef PG8_SCHED
}
}


enum { PH_MOD, PH_PRO_SMALL, PH_CONVSTATE, PH_PRO_TAB };

template <int PH> DEVI void run_phase(const P& p, int l, long gtid, long gsz) {
    if constexpr (PH == PH_MOD) {
    } else if constexpr (PH == PH_PRO_SMALL) {
        for (long i = gtid; i < (long)DEPTH * 12 * D; i += gsz) {
            const int k = (int)(i % D), j = (int)((i / D) % 12), ll = (int)(i / (12 * D));
            p.wsmall()[i] = inp(13)[((size_t)ll * D + k) * DPROJ + (j < 8 ? S_DT + j : S_F + (j - 8))];
        }
    } else if constexpr (PH == PH_CONVSTATE) {
        for (long i = gtid; i < (long)NSEQ * 3 * CONVC; i += gsz) {
            const int c = (int)(i % CONVC), j = (int)((i / CONVC) % 3), s = (int)(i / (3 * CONVC));
            const int rlast = s < NB_P ? (s + 1) * T_P - 1 : M_P + (s - NB_P + 1) * T_S - 1;
            const float v = PROJ(rlast - 2 + j, O_XBC + c);
            if (s < NB_P) p.out[OUT_CONVP + (((size_t)l * NB_P + s) * 3 + j) * CONVC + c] = v;
            else p.out[OUT_CONVS + (((size_t)l * NB_S + (s - NB_P)) * 3 + j) * CONVC + c] = v;
        }
    } else if constexpr (PH == PH_PRO_TAB) {
        const float* ks = inp(27); uint4* kd = (uint4*)p.keysb();
        const long NK = (long)DEPTH * 16 * 128 * 128 / 8;
        for (long i = gtid; i < NK; i += gsz) {
            const float* src = ks + i * 8;
            const float4 a = *(const float4*)src, b = *(const float4*)(src + 4);
            uint4 o; o.x = (unsigned)f2bf(a.x) | ((unsigned)f2bf(a.y) << 16); o.y = (unsigned)f2bf(a.z) | ((unsigned)f2bf(a.w) << 16);
            o.z = (unsigned)f2bf(b.x) | ((unsigned)f2bf(b.y) << 16); o.w = (unsigned)f2bf(b.z) | ((unsigned)f2bf(b.w) << 16);
            kd[i] = o;
        }
    }
}
#define XB_TMO      128
#define XB_XCNT(j)  (256  + 64 * (j))
#define XB_XSUB(j)  (1280 + 64 * (j))
#define XB_XGEN(j)  (2304 + 64 * (j))
#define XB_TOP      3328
#define XB_TOPGEN   3392
#define XCD_BAR_WORDS 3456
#define XB_SPIN_CAP (1u << 18)
#define LAS __attribute__((address_space(3)))

__device__ __forceinline__ unsigned xb_ld(unsigned* p)              { return __hip_atomic_load(p, __ATOMIC_RELAXED, __HIP_MEMORY_SCOPE_AGENT); }
__device__ __forceinline__ unsigned xb_add(unsigned* p, unsigned v) { return __hip_atomic_fetch_add(p, v, __ATOMIC_RELAXED, __HIP_MEMORY_SCOPE_AGENT); }
__device__ __forceinline__ unsigned xb_xcc_id() { return (unsigned)__builtin_amdgcn_s_getreg((3 << 11) | 20) & 0xFu; }
#define XB_SPIN(cond, bar) do { unsigned _sp = 0; while (cond) { __builtin_amdgcn_s_sleep(1); \
    if ((++_sp & 255u) == 0u) { if (xb_ld(&(bar)[XB_TMO])) break; if (_sp > XB_SPIN_CAP) { atomicAdd(&(bar)[XB_TMO], 1u); break; } } } } while (0)

struct XcdBarrier { unsigned* bar; unsigned x; volatile LAS unsigned* st; };

__device__ __forceinline__ XcdBarrier xcd_barrier_post(unsigned* bar, volatile LAS unsigned* st) {
    XcdBarrier b; b.bar = bar; b.x = xb_xcc_id(); b.st = st;
    if (threadIdx.x == 0) (void)xb_add(&bar[XB_XCNT(b.x)], 1u);
    return b;
}
__device__ __forceinline__ void xcd_barrier_complete(unsigned* bar, unsigned x, unsigned& nloc, unsigned& nx) {
    const unsigned G = gridDim.x * gridDim.y * gridDim.z;
    unsigned sum, cnt, mine, sp = 0u;
    for (;;) {
        sum = 0u; cnt = 0u; mine = 0u;
#pragma unroll
        for (unsigned j = 0; j < 16; ++j) { const unsigned c = xb_ld(&bar[XB_XCNT(j)]); sum += c; cnt += (c > 0u) ? 1u : 0u; mine = (j == x) ? c : mine; }
        if (sum == G) break;
        __builtin_amdgcn_s_sleep(1);
        if ((++sp & 255u) == 0u) { if (xb_ld(&bar[XB_TMO])) break; if (sp > XB_SPIN_CAP) { atomicAdd(&bar[XB_TMO], 1u); break; } }
    }
    nloc = mine > 0u ? mine : 1u; nx = cnt > 0u ? cnt : 1u;
}
__device__ __forceinline__ void xcd_barrier(const XcdBarrier& b) {
    asm volatile("s_waitcnt vmcnt(0)" ::: "memory");
    __syncthreads();
    if (threadIdx.x == 0) {
        unsigned* bar = b.bar;
        __builtin_amdgcn_s_waitcnt(0);
        unsigned nloc = b.st[0], nx = b.st[1];
        if (nloc == 0u) { xcd_barrier_complete(bar, b.x, nloc, nx); b.st[0] = nloc; b.st[1] = nx; }
        const unsigned old = xb_add(&bar[XB_XSUB(b.x)], 1u);
        const unsigned gen = old / nloc;
        if (old + 1u == (gen + 1u) * nloc) {
            __builtin_amdgcn_fence(__ATOMIC_RELEASE, "agent");
            asm volatile("s_waitcnt vmcnt(0)" ::: "memory");
            const unsigned og = xb_add(&bar[XB_TOP], 1u);
            const unsigned tg = og / nx;
            if (og + 1u == (tg + 1u) * nx) xb_add(&bar[XB_TOPGEN], 1u);
            else XB_SPIN(xb_ld(&bar[XB_TOPGEN]) == tg, bar);
            __builtin_amdgcn_fence(__ATOMIC_ACQUIRE, "agent");
            xb_add(&bar[XB_XGEN(b.x)], 1u);
            asm volatile("s_waitcnt vmcnt(0)" ::: "memory");
        } else {
            XB_SPIN(xb_ld(&bar[XB_XGEN(b.x)]) == gen, bar);
            __builtin_amdgcn_fence(__ATOMIC_ACQUIRE, "agent");
            asm volatile("s_waitcnt vmcnt(0)" ::: "memory");
        }
    }
    __syncthreads();
}

typedef short bf16x8_t __attribute__((ext_vector_type(8)));
typedef float f32x4_t __attribute__((ext_vector_type(4)));
typedef float f32x16_t __attribute__((ext_vector_type(16)));
typedef unsigned u32x4_t __attribute__((ext_vector_type(4)));
typedef unsigned u32x2_t __attribute__((ext_vector_type(2)));
typedef float f32x2_t __attribute__((ext_vector_type(2)));

DEVI unsigned mono_u(float f) { const unsigned u = __float_as_uint(f); return u ^ ((unsigned)((int)u >> 31) | 0x80000000u); }
DEVI float unmono_f(unsigned m) { return __uint_as_float((m & 0x80000000u) ? (m ^ 0x80000000u) : ~m); }
DEVI unsigned umax_(unsigned a, unsigned b) { return a > b ? a : b; }
DEVI unsigned umin_(unsigned a, unsigned b) { return a < b ? a : b; }

#define CE_(x_, y_) do { const unsigned mx_ = umax_(x_, y_), mn_ = umin_(x_, y_); x_ = mx_; y_ = mn_; } while (0)
DEVI void sort16_desc(unsigned (&v)[16]) {
    CE_(v[0], v[1]); CE_(v[3], v[2]); CE_(v[4], v[5]); CE_(v[7], v[6]); CE_(v[8], v[9]); CE_(v[11], v[10]); CE_(v[12], v[13]); CE_(v[15], v[14]);
    CE_(v[0], v[2]); CE_(v[1], v[3]); CE_(v[6], v[4]); CE_(v[7], v[5]); CE_(v[8], v[10]); CE_(v[9], v[11]); CE_(v[14], v[12]); CE_(v[15], v[13]);
    CE_(v[0], v[1]); CE_(v[2], v[3]); CE_(v[5], v[4]); CE_(v[7], v[6]); CE_(v[8], v[9]); CE_(v[10], v[11]); CE_(v[13], v[12]); CE_(v[15], v[14]);
    CE_(v[0], v[4]); CE_(v[1], v[5]); CE_(v[2], v[6]); CE_(v[3], v[7]); CE_(v[12], v[8]); CE_(v[13], v[9]); CE_(v[14], v[10]); CE_(v[15], v[11]);
    CE_(v[0], v[2]); CE_(v[1], v[3]); CE_(v[4], v[6]); CE_(v[5], v[7]); CE_(v[10], v[8]); CE_(v[11], v[9]); CE_(v[14], v[12]); CE_(v[15], v[13]);
    CE_(v[0], v[1]); CE_(v[2], v[3]); CE_(v[4], v[5]); CE_(v[6], v[7]); CE_(v[9], v[8]); CE_(v[11], v[10]); CE_(v[13], v[12]); CE_(v[15], v[14]);
    CE_(v[0], v[8]); CE_(v[1], v[9]); CE_(v[2], v[10]); CE_(v[3], v[11]); CE_(v[4], v[12]); CE_(v[5], v[13]); CE_(v[6], v[14]); CE_(v[7], v[15]);
    CE_(v[0], v[4]); CE_(v[1], v[5]); CE_(v[2], v[6]); CE_(v[3], v[7]); CE_(v[8], v[12]); CE_(v[9], v[13]); CE_(v[10], v[14]); CE_(v[11], v[15]);
    CE_(v[0], v[2]); CE_(v[1], v[3]); CE_(v[4], v[6]); CE_(v[5], v[7]); CE_(v[8], v[10]); CE_(v[9], v[11]); CE_(v[12], v[14]); CE_(v[13], v[15]);
    CE_(v[0], v[1]); CE_(v[2], v[3]); CE_(v[4], v[5]); CE_(v[6], v[7]); CE_(v[8], v[9]); CE_(v[10], v[11]); CE_(v[12], v[13]); CE_(v[14], v[15]);
}
DEVI void merge16_desc(unsigned (&a)[16], const unsigned (&b)[16]) {
    a[0] = umax_(a[0], b[15]); a[1] = umax_(a[1], b[14]); a[2] = umax_(a[2], b[13]); a[3] = umax_(a[3], b[12]); a[4] = umax_(a[4], b[11]); a[5] = umax_(a[5], b[10]); a[6] = umax_(a[6], b[9]); a[7] = umax_(a[7], b[8]); a[8] = umax_(a[8], b[7]); a[9] = umax_(a[9], b[6]); a[10] = umax_(a[10], b[5]); a[11] = umax_(a[11], b[4]); a[12] = umax_(a[12], b[3]); a[13] = umax_(a[13], b[2]); a[14] = umax_(a[14], b[1]); a[15] = umax_(a[15], b[0]);
    CE_(a[0], a[8]); CE_(a[1], a[9]); CE_(a[2], a[10]); CE_(a[3], a[11]); CE_(a[4], a[12]); CE_(a[5], a[13]); CE_(a[6], a[14]); CE_(a[7], a[15]);
    CE_(a[0], a[4]); CE_(a[1], a[5]); CE_(a[2], a[6]); CE_(a[3], a[7]); CE_(a[8], a[12]); CE_(a[9], a[13]); CE_(a[10], a[14]); CE_(a[11], a[15]);
    CE_(a[0], a[2]); CE_(a[1], a[3]); CE_(a[4], a[6]); CE_(a[5], a[7]); CE_(a[8], a[10]); CE_(a[9], a[11]); CE_(a[12], a[14]); CE_(a[13], a[15]);
    CE_(a[0], a[1]); CE_(a[2], a[3]); CE_(a[4], a[5]); CE_(a[6], a[7]); CE_(a[8], a[9]); CE_(a[10], a[11]); CE_(a[12], a[13]); CE_(a[14], a[15]);
}

DEVI void peer_topk_unit(const bf16_t* pq, const bf16_t* keysb, int* eidx, float* gwv, int r0, int wave, int lane, LAS unsigned char* wl  ) {
    const int col = lane & 31, h = lane >> 5; const int r = r0 + col;
    unsigned S[2][16];
    bf16x8_t bq[8], acur[8], anxt[8];
    { const bf16_t* qp = pq + (size_t)r * 2048 + (wave * 2) * 128 + 8 * h;
#pragma unroll
      for (int s = 0; s < 8; ++s) bq[s] = *(const bf16x8_t*)(qp + s * 16);
      const bf16_t* kp = keysb + ((size_t)((wave * 2) * 128 + col) * 128 + 8 * h);
#pragma unroll
      for (int s = 0; s < 8; ++s) acur[s] = *(const bf16x8_t*)(kp + s * 16); }
    unsigned run[16];
#pragma unroll
    for (int blkid = 0; blkid < 8; ++blkid) {
        const int half = blkid >> 2, kb = blkid & 3, hh2 = wave * 2 + half;
        if (blkid + 1 < 8) { const int nh = (blkid + 1) >> 2, nkb = (blkid + 1) & 3; const bf16_t* kp = keysb + ((size_t)((wave * 2 + nh) * 128 + nkb * 32 + col) * 128 + 8 * h);
#pragma unroll
            for (int s = 0; s < 8; ++s) anxt[s] = *(const bf16x8_t*)(kp + s * 16); }
        f32x16_t d = {0.f, 0.f, 0.f, 0.f, 0.f, 0.f, 0.f, 0.f, 0.f, 0.f, 0.f, 0.f, 0.f, 0.f, 0.f, 0.f};
#pragma unroll
        for (int s = 0; s < 8; ++s) d = __builtin_amdgcn_mfma_f32_32x32x16_bf16(acur[s], bq[s], d, 0, 0, 0);
        if (blkid == 3) { const bf16_t* qp = pq + (size_t)r * 2048 + (wave * 2 + 1) * 128 + 8 * h;
#pragma unroll
            for (int s = 0; s < 8; ++s) bq[s] = *(const bf16x8_t*)(qp + s * 16); }
        unsigned blk[16];
#pragma unroll
        for (int g = 0; g < 16; ++g) { const int kidx = kb * 32 + (g & 3) + 8 * (g >> 2) + 4 * h; blk[g] = (mono_u(d[g]) & ~127u) | (unsigned)(127 - kidx); }
        sort16_desc(blk);
        if (kb == 0) {
#pragma unroll
            for (int i = 0; i < 16; ++i) run[i] = blk[i];
        } else merge16_desc(run, blk);
        if (kb == 3) {
            unsigned oth[16];
#pragma unroll
            for (int i = 0; i < 16; ++i) oth[i] = (unsigned)__shfl_xor((int)run[i], 32);
            merge16_desc(run, oth);
#pragma unroll
            for (int i = 0; i < 16; ++i) S[half][i] = run[i];
        }
#pragma unroll
        for (int s = 0; s < 8; ++s) acur[s] = anxt[s];
        __builtin_amdgcn_sched_barrier(0);
        (void)hh2;
    }
    {
        unsigned w0[4], w1[4];
#pragma unroll
        for (int q = 0; q < 4; ++q) { w0[q] = 0u; w1[q] = 0u;
#pragma unroll
            for (int b = 0; b < 4; ++b) { w0[q] |= (127u - (S[0][q * 4 + b] & 127u)) << (8 * b); w1[q] |= (127u - (S[1][q * 4 + b] & 127u)) << (8 * b); } }
        if (h == 0) { LAS u32x4_t* dst = (LAS u32x4_t*)(wl + col * 32); dst[0] = (u32x4_t){w0[0], w0[1], w0[2], w0[3]}; dst[1] = (u32x4_t){w1[0], w1[1], w1[2], w1[3]}; }
    }
    __builtin_amdgcn_sched_barrier(0);
    float T0[16], T1[16];
#pragma unroll
    for (int i = 0; i < 16; ++i) { const unsigned u0 = S[0][i] & ~127u, u1 = S[1][i] & ~127u; T0[i] = unmono_f(h ? u1 : u0); T1[i] = unmono_f(h ? u0 : u1); }
    __builtin_amdgcn_sched_barrier(0);
    unsigned ca[16], cb2[16];
#define MKC(a_, b_) ((mono_u(T0[a_] + T1[b_]) & ~255u) | (255u - (h ? (unsigned)((b_) * 16 + (a_)) : (unsigned)((a_) * 16 + (b_)))))
    ca[0] = MKC(0, 1);
    ca[1] = MKC(0, 2);
    ca[2] = MKC(0, 3);
    ca[3] = MKC(0, 4);
    ca[4] = MKC(0, 5);
    ca[5] = MKC(0, 6);
    ca[6] = MKC(0, 7);
    ca[7] = MKC(0, 8);
    ca[8] = MKC(0, 9);
    ca[9] = MKC(0, 10);
    ca[10] = MKC(0, 11);
    ca[11] = MKC(0, 12);
    ca[12] = MKC(0, 13);
    ca[13] = MKC(0, 14);
    ca[14] = MKC(0, 15);
    ca[15] = h ? 0u : MKC(0, 0);
    cb2[0] = MKC(1, 2);
    cb2[1] = MKC(1, 3);
    cb2[2] = MKC(1, 4);
    cb2[3] = MKC(1, 5);
    cb2[4] = MKC(1, 6);
    cb2[5] = MKC(1, 7);
    cb2[6] = MKC(2, 3);
    cb2[7] = MKC(2, 4);
    cb2[8] = h ? 0u : MKC(1, 1);
    cb2[9] = h ? 0u : MKC(2, 2);
    cb2[10] = h ? 0u : MKC(3, 3);
    cb2[11] = 0u;
    cb2[12] = 0u;
    cb2[13] = 0u;
    cb2[14] = 0u;
    cb2[15] = 0u;
#undef MKC
    sort16_desc(ca); sort16_desc(cb2); merge16_desc(ca, cb2);
    {
        unsigned oth[16];
#pragma unroll
        for (int i = 0; i < 16; ++i) oth[i] = (unsigned)__shfl_xor((int)ca[i], 32);
        merge16_desc(ca, oth);
    }
    float e[16]; float sum = 0.f; const float s0 = unmono_f(ca[0] & ~255u);
#pragma unroll
    for (int j = 0; j < 16; ++j) { e[j] = __expf(unmono_f(ca[j] & ~255u) - s0); sum += e[j]; }
    const float inv = 1.f / sum;
    const LAS unsigned char* lb = wl + col * 32;
    int ex[8]; float gx[8]; const unsigned hm = h ? 0xffffffffu : 0u;
#pragma unroll
    for (int jj = 0; jj < 8; ++jj) {
        const unsigned kj = ca[jj] ^ ((ca[jj] ^ ca[8 + jj]) & hm); const float ej = __uint_as_float(__float_as_uint(e[jj]) ^ ((__float_as_uint(e[jj]) ^ __float_as_uint(e[8 + jj])) & hm));
        const unsigned pos = 255u - (kj & 255u); const int i0 = lb[pos >> 4], i1 = lb[16 + (pos & 15u)];
        ex[jj] = i0 * 128 + i1; gx[jj] = ej * inv;
    }
    int* ep = eidx + (size_t)r * 128 + wave * 16 + 8 * h; float* gp = gwv + (size_t)r * 128 + wave * 16 + 8 * h;
    *(int4*)ep = make_int4(ex[0], ex[1], ex[2], ex[3]); *(int4*)(ep + 4) = make_int4(ex[4], ex[5], ex[6], ex[7]);
    *(float4*)gp = make_float4(gx[0], gx[1], gx[2], gx[3]); *(float4*)(gp + 4) = make_float4(gx[4], gx[5], gx[6], gx[7]);
}

DEVI void adaln_apply_1(const P& p, int l, int r, int lane, float (&v)[16]);
DEVI unsigned pk4fp8(float a, float b, float c, float d) { int w = 0; w = __builtin_amdgcn_cvt_pk_fp8_f32(a, b, w, false); w = __builtin_amdgcn_cvt_pk_fp8_f32(c, d, w, true); return (unsigned)w; }
DEVI void peer_tables_fp8(const P& p, int ll  , int rbeg, int rend, int gw, int NGW, int lane) {
    const float* us = inp(28) + (size_t)ll * NEXP * D; const float* vs = inp(29) + (size_t)ll * NEXP * D;
    for (int R0 = rbeg + gw * 4; R0 < rend; R0 += NGW * 4) {
        float4 v[4][4]; float am[4];
#pragma unroll
        for (int q = 0; q < 4; ++q) { const int R = R0 + q, tb = R >= NEXP, row = R - tb * NEXP;
            const float4* src = (const float4*)((tb ? vs : us) + (size_t)row * D) + lane;
#pragma unroll
            for (int j = 0; j < 4; ++j) v[q][j] = src[64 * j]; }
#pragma unroll
        for (int q = 0; q < 4; ++q) { float a_ = 0.f;
#pragma unroll
            for (int j = 0; j < 4; ++j) a_ = fmaxf(a_, fmaxf(fmaxf(fabsf(v[q][j].x), fabsf(v[q][j].y)), fmaxf(fabsf(v[q][j].z), fabsf(v[q][j].w))));
#pragma unroll
            for (int o = 1; o < 64; o <<= 1) a_ = fmaxf(a_, __shfl_xor(a_, o));
            am[q] = a_; }
#pragma unroll
        for (int q = 0; q < 4; ++q) { const int R = R0 + q, tb = R >= NEXP, row = ll * NEXP + (R - tb * NEXP);
            const float sc = am[q] > 0.f ? 440.f / am[q] : 1.f;
            unsigned* dst = (unsigned*)((tb ? p.v8() : p.u8()) + (size_t)row * D) + lane;
#pragma unroll
            for (int j = 0; j < 4; ++j) dst[64 * j] = pk4fp8(v[q][j].x * sc, v[q][j].y * sc, v[q][j].z * sc, v[q][j].w * sc);
            if (lane == 0) p.sinv()[(size_t)tb * DEPTH * NEXP + row] = am[q] > 0.f ? am[q] * (1.f / 440.f) : 1.f; }
    }
}

template <int NTL> DEVI void peer_gather_token_t(const P& p, int l, int tbase, int half, LAS float* xch, const unsigned char* u8, const unsigned char* v8, const float* su, const float* sv, const unsigned char* h8, const int* eidx, const float* gwv, float* x,
                            const float* gate2  , int r, int lane, LAS unsigned char* wl) {
    const int n16 = lane & 15, kq = lane >> 4;
    int e[NTL]; float g[NTL], s_u[NTL], s_v[NTL];
#pragma unroll
    for (int t = 0; t < NTL; ++t) { e[t] = eidx[(size_t)r * 128 + (tbase + t) * 16 + n16]; g[t] = gwv[(size_t)r * 128 + (tbase + t) * 16 + n16]; }
#pragma unroll
    for (int t = 0; t < NTL; ++t) { s_u[t] = su[e[t]]; s_v[t] = sv[e[t]]; }
    const unsigned char* up[NTL];
#pragma unroll
    for (int t = 0; t < NTL; ++t) up[t] = u8 + (size_t)e[t] * D + kq * 16;
    const unsigned char* hp = h8 + (n16 < 8 ? (size_t)0 : (size_t)M * D) + (size_t)r * D + kq * 16;
    f32x4_t acc[NTL];
#pragma unroll
    for (int t = 0; t < NTL; ++t) acc[t] = (f32x4_t){0.f, 0.f, 0.f, 0.f};
    u32x4_t b0[NTL], b1[NTL];
#pragma unroll
    for (int t = 0; t < NTL; ++t) { b0[t] = *(const u32x4_t*)(up[t]); b1[t] = *(const u32x4_t*)(up[t] + 64); }
#define FP8MM(av, bv, c) do { const long al_ = (long)(((unsigned long long)(av).y << 32) | (av).x), ah_ = (long)(((unsigned long long)(av).w << 32) | (av).z); \
        const long bl_ = (long)(((unsigned long long)(bv).y << 32) | (bv).x), bh_ = (long)(((unsigned long long)(bv).w << 32) | (bv).z); \
        c = __builtin_amdgcn_mfma_f32_16x16x32_fp8_fp8(al_, bl_, c, 0, 0, 0); c = __builtin_amdgcn_mfma_f32_16x16x32_fp8_fp8(ah_, bh_, c, 0, 0, 0); } while (0)
    for (int m = 0; m < 16; m += 2) {
        const u32x4_t a0 = *(const u32x4_t*)(hp + m * 64), a1 = *(const u32x4_t*)(hp + m * 64 + 64);
#pragma unroll
        for (int t = 0; t < NTL; ++t) FP8MM(a0, b0[t], acc[t]);
        if (m + 2 < 16) {
#pragma unroll
            for (int t = 0; t < NTL; ++t) b0[t] = *(const u32x4_t*)(up[t] + (m + 2) * 64);
        }
#pragma unroll
        for (int t = 0; t < NTL; ++t) FP8MM(a1, b1[t], acc[t]);
        if (m + 3 < 16) {
#pragma unroll
            for (int t = 0; t < NTL; ++t) b1[t] = *(const u32x4_t*)(up[t] + (m + 3) * 64);
        }
    }
#undef FP8MM
    LAS u32x2_t* pl = (LAS u32x2_t*)wl;
#pragma unroll
    for (int t = 0; t < NTL; ++t) { const float lo = __shfl_xor(acc[t][0], 32); const float dot = (acc[t][0] + lo * (1.f / 32.f)) * s_u[t];
        if (kq == 0) pl[t * 16 + n16] = (u32x2_t){(unsigned)e[t], __float_as_uint(g[t] * gelu_f(dot) * s_v[t])}; }
    float o[16];
#pragma unroll
    for (int i = 0; i < 16; ++i) o[i] = 0.f;
    for (int j0 = 0; j0 < NTL * 16; j0 += 16) {
        u32x4_t w[16]; float cj[16];
#pragma unroll
        for (int jj = 0; jj < 16; ++jj) { const u32x2_t pr = pl[j0 + jj]; const int ej = __builtin_amdgcn_readfirstlane((int)pr.x); cj[jj] = __uint_as_float(pr.y);
            w[jj] = *(const u32x4_t*)(v8 + (size_t)ej * D + 16 * lane); }
#pragma unroll
        for (int jj = 0; jj < 16; ++jj) { const float c = cj[jj];
#pragma unroll
            for (int q = 0; q < 4; ++q) { const f32x2_t lo = __builtin_amdgcn_cvt_pk_f32_fp8((int)w[jj][q], false), hi = __builtin_amdgcn_cvt_pk_f32_fp8((int)w[jj][q], true);
                o[4 * q] += c * lo[0]; o[4 * q + 1] += c * lo[1]; o[4 * q + 2] += c * hi[0]; o[4 * q + 3] += c * hi[1]; } }
    }
    if (NTL < 8) {
        if (half == 1) {
#pragma unroll
            for (int q = 0; q < 4; ++q) *(LAS f32x4_t*)(xch + lane * 16 + 4 * q) = (f32x4_t){o[4 * q], o[4 * q + 1], o[4 * q + 2], o[4 * q + 3]};
        }
        __syncthreads();
        if (half == 1) return;
#pragma unroll
        for (int q = 0; q < 4; ++q) { const f32x4_t t4 = *(const LAS f32x4_t*)(xch + lane * 16 + 4 * q); o[4 * q] += t4[0]; o[4 * q + 1] += t4[1]; o[4 * q + 2] += t4[2]; o[4 * q + 3] += t4[3]; }
    }
    const float* gp = gate2 + (size_t)row_seq(r) * 6144 + 16 * lane;
    float* xp = x + (size_t)r * D + 16 * lane;
#pragma unroll
    for (int q = 0; q < 4; ++q) {
        float4 xa = *(const float4*)(xp + 4 * q); const float4 ga = *(const float4*)(gp + 4 * q);
        xa.x += ga.x * o[4 * q]; xa.y += ga.y * o[4 * q + 1]; xa.z += ga.z * o[4 * q + 2]; xa.w += ga.w * o[4 * q + 3];
        *(float4*)(xp + 4 * q) = xa;
        o[4 * q] = xa.x; o[4 * q + 1] = xa.y; o[4 * q + 2] = xa.z; o[4 * q + 3] = xa.w;
    }
    __builtin_amdgcn_sched_barrier(0);
    if (l + 1 < DEPTH) adaln_apply_1(p, l + 1, r, lane, o);
}


DEVI float wave_sum(float v) {
#pragma unroll
    for (int o = 1; o < 64; o <<= 1) v += __shfl_xor(v, o);
    return v;
}
DEVI float wave_incl_scan(float v, int lane) {
#pragma unroll
    for (int o = 1; o < 64; o <<= 1) { const float t = __shfl_up(v, o); if (lane >= o) v += t; }
    return v;
}
template <int WHICH> DEVI void adaln_apply(const P& p, int l, int r, int lane_in, float (&v)[16]) {
    int lane = lane_in; asm volatile("" : "+v"(lane));
    const float* g = inp(WHICH == 1 ? 9 : 10) + (size_t)l * D + 16 * lane;
    const int osh = (WHICH == 1 ? 0 : 3) * D, osc = (WHICH == 1 ? 1 : 4) * D;
    float ss = 0.f;
#pragma unroll
    for (int i = 0; i < 16; ++i) ss += v[i] * v[i];
    const float rstd = rsqrtf(wave_sum(ss) * (1.f / D) + EPS);
    const float* md = p.mod() + ((size_t)l * NSEQ + row_seq(r)) * 6144 + 16 * lane;
#pragma unroll
    for (int q = 0; q < 4; ++q) {
        const float4 gg = *(const float4*)(g + 4 * q), sc = *(const float4*)(md + osc + 4 * q), sh = *(const float4*)(md + osh + 4 * q);
        v[4 * q] = v[4 * q] * rstd * gg.x * (1.f + sc.x) + sh.x; v[4 * q + 1] = v[4 * q + 1] * rstd * gg.y * (1.f + sc.y) + sh.y;
        v[4 * q + 2] = v[4 * q + 2] * rstd * gg.z * (1.f + sc.z) + sh.z; v[4 * q + 3] = v[4 * q + 3] * rstd * gg.w * (1.f + sc.w) + sh.w;
    }
    u32x4_t* ob = (u32x4_t*)(p.hb() + (size_t)r * D + 16 * lane);
    ob[0] = (u32x4_t){pk2bf(v[0], v[1]), pk2bf(v[2], v[3]), pk2bf(v[4], v[5]), pk2bf(v[6], v[7])};
    ob[1] = (u32x4_t){pk2bf(v[8], v[9]), pk2bf(v[10], v[11]), pk2bf(v[12], v[13]), pk2bf(v[14], v[15])};
    if constexpr (WHICH == 2) {
        unsigned hi8[4], lo8[4];
#pragma unroll
        for (int q = 0; q < 4; ++q) { hi8[q] = pk4fp8(v[4 * q], v[4 * q + 1], v[4 * q + 2], v[4 * q + 3]);
            const f32x2_t h01 = __builtin_amdgcn_cvt_pk_f32_fp8((int)hi8[q], false), h23 = __builtin_amdgcn_cvt_pk_f32_fp8((int)hi8[q], true);
            lo8[q] = pk4fp8((v[4 * q] - h01[0]) * 32.f, (v[4 * q + 1] - h01[1]) * 32.f, (v[4 * q + 2] - h23[0]) * 32.f, (v[4 * q + 3] - h23[1]) * 32.f); }
        *(u32x4_t*)(p.h8() + (size_t)r * D + 16 * lane) = (u32x4_t){hi8[0], hi8[1], hi8[2], hi8[3]};
        *(u32x4_t*)(p.h8() + (size_t)M * D + (size_t)r * D + 16 * lane) = (u32x4_t){lo8[0], lo8[1], lo8[2], lo8[3]};
    }
    if constexpr (WHICH == 1) {
        const float* dtb = inp(16) + l * 8; const float* fb = inp(22) + l * 4;
        const float* ws = p.wsmall() + (size_t)l * 12 * D + 16 * lane;
        float dot[12];
#pragma unroll
        for (int jj = 0; jj < 12; ++jj) { float a = 0.f;
#pragma unroll
            for (int q = 0; q < 4; ++q) { const float4 w = *(const float4*)(ws + (size_t)jj * D + 4 * q); a += v[4 * q] * w.x + v[4 * q + 1] * w.y + v[4 * q + 2] * w.z + v[4 * q + 3] * w.w; }
            dot[jj] = wave_sum(a); }
        if (lane < 8) {
            float d = dot[0];
#pragma unroll
            for (int jj = 1; jj < 8; ++jj) d = (lane == jj) ? dot[jj] : d;
            p.dt()[(size_t)r * 8 + lane] = softplus_f(d + dtb[lane]);
        } else if (lane < 12) {
            const int hd = lane - 8; float d = dot[8];
#pragma unroll
            for (int jj = 9; jj < 12; ++jj) d = (lane == jj) ? dot[jj] : d;
            const float lf = -softplus_f(-(d + fb[hd]));
            p.logf()[(size_t)r * 4 + hd] = lf;
            if (r < M_P) p.out[OUT_LFP + ((size_t)l * M_P + r) * 4 + hd] = lf; else p.out[OUT_LFS + ((size_t)l * M_S + (r - M_P)) * 4 + hd] = lf;
        }
    }
}
template <int WHICH> DEVI void adaln_rows(const P& p, int l, int gw, int NGW, int lane, bool from_inputs = false) {
    const float* xp_ = from_inputs ? inp(0) : p.x(); const float* xs_ = from_inputs ? inp(1) - (size_t)M_P * D : p.x();
    float4 nx[4];
    if (gw < M) {
#pragma unroll
        for (int q = 0; q < 4; ++q) nx[q] = ((const float4*)((gw < M_P ? xp_ : xs_) + (size_t)gw * D + 16 * lane))[q]; }
    for (int r = gw; r < M; r += NGW) {
        float v[16];
#pragma unroll
        for (int q = 0; q < 4; ++q) { v[4 * q] = nx[q].x; v[4 * q + 1] = nx[q].y; v[4 * q + 2] = nx[q].z; v[4 * q + 3] = nx[q].w; }
        if (r + NGW < M) { const int rn = r + NGW;
#pragma unroll
            for (int q = 0; q < 4; ++q) nx[q] = ((const float4*)((rn < M_P ? xp_ : xs_) + (size_t)rn * D + 16 * lane))[q]; }
        adaln_apply<WHICH>(p, l, r, lane, v);
    }
}
DEVI void scan_chunks(const P& p, int l, int gw, int NGW, int lane) {
    const float* alog = inp(17) + l * 8; const float* clf = inp(6) + (size_t)l * NB_S * PAST * 4;
    for (int ci = gw; ci < NCHUNK + NB_S * 64; ci += NGW) {
        if (ci < NCHUNK) {
            const size_t r = (size_t)ci * 64 + lane;
            const float4 d0 = *(const float4*)(p.dt() + r * 8), d1 = *(const float4*)(p.dt() + r * 8 + 4);
            float a[8] = {d0.x, d0.y, d0.z, d0.w, d1.x, d1.y, d1.z, d1.w};
#pragma unroll
            for (int hh = 0; hh < 8; ++hh) a[hh] = wave_incl_scan(a[hh] * -__expf(alog[hh]), lane);
            *(float4*)(p.acum() + r * 8) = make_float4(a[0], a[1], a[2], a[3]); *(float4*)(p.acum() + r * 8 + 4) = make_float4(a[4], a[5], a[6], a[7]);
            const float4 lf = *(const float4*)(p.logf() + r * 4);
            float f[4] = {lf.x, lf.y, lf.z, lf.w};
#pragma unroll
            for (int hd = 0; hd < 4; ++hd) f[hd] = wave_incl_scan(f[hd], lane);
            *(float4*)(p.Floc() + r * 4) = make_float4(f[0], f[1], f[2], f[3]);
            if (lane == 63) *(float4*)(p.csum() + (size_t)ci * 4) = make_float4(f[0], f[1], f[2], f[3]);
        } else {
            const int cc = ci - NCHUNK;
            const size_t pos = (size_t)cc * 64 + lane;
            const float4 lf = *(const float4*)(clf + pos * 4);
            float f[4] = {lf.x, lf.y, lf.z, lf.w};
#pragma unroll
            for (int hd = 0; hd < 4; ++hd) f[hd] = wave_incl_scan(f[hd], lane);
            const int b = cc / 64, pin = (cc % 64) * 64 + lane;
            *(float4*)(p.Fs() + ((size_t)b * FS_LEN + pin) * 4) = make_float4(f[0], f[1], f[2], f[3]);
            if (lane == 63) *(float4*)(p.csum() + (size_t)ci * 4) = make_float4(f[0], f[1], f[2], f[3]);
        }
    }
}
DEVI void scan_fix(const P& p, int gw, int NGW, int lane) {
    for (int ci = gw; ci < NB_P * NCH_P + NB_S * 65; ci += NGW) {
        float o[4] = {0.f, 0.f, 0.f, 0.f};
        if (ci < NB_P * NCH_P) {
            const int s = ci / NCH_P, c = ci % NCH_P;
#pragma unroll
            for (int q = 0; q < 2; ++q) { const int cc = lane + 64 * q; if (cc < c) { const float4 t = *(const float4*)(p.csum() + ((size_t)s * NCH_P + cc) * 4); o[0] += t.x; o[1] += t.y; o[2] += t.z; o[3] += t.w; } }
#pragma unroll
            for (int hd = 0; hd < 4; ++hd) o[hd] = wave_sum(o[hd]);
            const size_t r = (size_t)ci * 64 + lane; const float4 f = *(const float4*)(p.Floc() + r * 4);
            *(float4*)(p.Fp() + r * 4) = make_float4(f.x + o[0], f.y + o[1], f.z + o[2], f.w + o[3]);
        } else {
            const int cs = ci - NB_P * NCH_P; const int b = cs / 65, c = cs % 65;
            if (lane < c) { const float4 t = *(const float4*)(p.csum() + ((size_t)NCHUNK + b * 64 + lane) * 4); o[0] += t.x; o[1] += t.y; o[2] += t.z; o[3] += t.w; }
#pragma unroll
            for (int hd = 0; hd < 4; ++hd) o[hd] = wave_sum(o[hd]);
            float4* dst = (float4*)(p.Fs() + ((size_t)b * FS_LEN + c * 64 + lane) * 4);
            float4 f;
            if (c < 64) f = *dst; else f = *(const float4*)(p.Floc() + ((size_t)M_P + b * 64 + lane) * 4);
            *dst = make_float4(f.x + o[0], f.y + o[1], f.z + o[2], f.w + o[3]);
        }
    }
}

DEVI void adaln_apply_1(const P& p, int l, int r, int lane, float (&v)[16]) { adaln_apply<1>(p, l, r, lane, v); }


constexpr float LOG2E = 1.4426950408889634f;
constexpr int ATT_KP = 144, ATT_VP = 136;
constexpr int ATT_VOFF = 64 * ATT_KP, ATT_GOFF = ATT_VOFF + 64 * ATT_VP, ATT_BUF = 18432;
static_assert(ATT_GOFF + 256 <= ATT_BUF, "attention tile buffer");

template <bool DIAG> DEVI void attn_tile(const LAS unsigned char* buf, int t, int qpos, int qi, int g, float gq, const bf16x8_t (&qf)[2], float& m, float& lsum, f32x4_t (&O)[4]) {
    f32x4_t st[4];
#pragma unroll
            for (int kb = 0; kb < 4; ++kb) {
                const bf16x8_t a0 = *(const LAS bf16x8_t*)(buf + (kb * 16 + qi) * ATT_KP + 16 * g), a1 = *(const LAS bf16x8_t*)(buf + (kb * 16 + qi) * ATT_KP + 64 + 16 * g);
                const f32x4_t gk = *(const LAS f32x4_t*)(buf + ATT_GOFF + (kb * 16 + 4 * g) * 4);
                const f32x4_t bias = {gq - gk[0], gq - gk[1], gq - gk[2], gq - gk[3]};
                st[kb] = __builtin_amdgcn_mfma_f32_16x16x32_bf16(a0, qf[0], bias, 0, 0, 0);
                st[kb] = __builtin_amdgcn_mfma_f32_16x16x32_bf16(a1, qf[1], st[kb], 0, 0, 0);
            }
            float mx = -INFINITY;
#pragma unroll
            for (int kb = 0; kb < 4; ++kb) {
#pragma unroll
                for (int e = 0; e < 4; ++e) { float s = st[kb][e]; if (DIAG && (t * 64 + kb * 16 + 4 * g + e > qpos)) s = -INFINITY; st[kb][e] = s; mx = fmaxf(mx, s); } }
            mx = fmaxf(mx, __shfl_xor(mx, 16)); mx = fmaxf(mx, __shfl_xor(mx, 32));
            const float mn = fmaxf(m, mx), alpha = __builtin_amdgcn_exp2f(m - mn); m = mn;
            float ps = 0.f;
#pragma unroll
            for (int kb = 0; kb < 4; ++kb)
#pragma unroll
                for (int e = 0; e < 4; ++e) { const float pe = __builtin_amdgcn_exp2f(st[kb][e] - mn); st[kb][e] = pe; ps += pe; }
            lsum = lsum * alpha + ps;
#pragma unroll
            for (int dt = 0; dt < 4; ++dt) O[dt] *= alpha;
#pragma unroll
            for (int ks = 0; ks < 2; ++ks) {
                u32x4_t pw = {pk2bf(st[2 * ks][0], st[2 * ks][1]), pk2bf(st[2 * ks][2], st[2 * ks][3]), pk2bf(st[2 * ks + 1][0], st[2 * ks + 1][1]), pk2bf(st[2 * ks + 1][2], st[2 * ks + 1][3])};
                const bf16x8_t pf = __builtin_bit_cast(bf16x8_t, pw);
#pragma unroll
                for (int dt = 0; dt < 4; ++dt) {
                    const LAS unsigned char* vp = buf + ATT_VOFF + (dt * 16 + qi) * ATT_VP + (32 * ks + 4 * g) * 2;
                    const u32x2_t lo = *(const LAS u32x2_t*)vp, hi = *(const LAS u32x2_t*)(vp + 32);
                    const u32x4_t aw = {lo.x, lo.y, hi.x, hi.y};
                    O[dt] = __builtin_amdgcn_mfma_f32_16x16x32_bf16(__builtin_bit_cast(bf16x8_t, aw), pf, O[dt], 0, 0, 0);
                }
            }
}
template <bool DIAG, bool FIX, int NQ> DEVI void attn_pair(const LAS unsigned char* buf, int tA, const int (&qpos)[NQ], int qi, int g, const float (&gq)[NQ], const bf16x8_t (&qf)[NQ][2], float (&m)[NQ], float (&lsum)[NQ], f32x4_t (&O)[NQ][4], f32x4_t (&OL)[NQ]) {
#pragma unroll
    for (int hf = 0; hf < 2; ++hf) {
        const LAS unsigned char* tbuf = buf + hf * ATT_BUF; const int k0 = (tA - hf) * 64;
        f32x4_t st[NQ][4];
#pragma unroll
        for (int kb = 0; kb < 4; ++kb) {
            const LAS unsigned char* tb = tbuf + (kb * 16 + qi) * ATT_KP;
            const bf16x8_t a0 = *(const LAS bf16x8_t*)(tb + 16 * g), a1 = *(const LAS bf16x8_t*)(tb + 64 + 16 * g);
            const f32x4_t gk = *(const LAS f32x4_t*)(tbuf + ATT_GOFF + (kb * 16 + 4 * g) * 4);
#pragma unroll
            for (int j = 0; j < NQ; ++j) {
                const f32x4_t bias = {gq[j] - gk[0], gq[j] - gk[1], gq[j] - gk[2], gq[j] - gk[3]};
                st[j][kb] = __builtin_amdgcn_mfma_f32_16x16x32_bf16(a0, qf[j][0], bias, 0, 0, 0);
                st[j][kb] = __builtin_amdgcn_mfma_f32_16x16x32_bf16(a1, qf[j][1], st[j][kb], 0, 0, 0);
            }
            if (NQ > 1) __builtin_amdgcn_sched_barrier(0);
        }
#pragma unroll
        for (int j = 0; j < NQ; ++j) {
            if (NQ > 1) __builtin_amdgcn_sched_barrier(0);
            if (FIX) {
#pragma unroll
                for (int kb = 0; kb < 4; ++kb)
#pragma unroll
                    for (int e = 0; e < 4; ++e) { float s = st[j][kb][e]; if (DIAG && (k0 + kb * 16 + 4 * g + e > qpos[j])) s = -INFINITY; st[j][kb][e] = __builtin_amdgcn_exp2f(s); }
            } else {
                float mx = -INFINITY;
#pragma unroll
                for (int kb = 0; kb < 4; ++kb) {
#pragma unroll
                    for (int e = 0; e < 4; ++e) { float s = st[j][kb][e]; if (DIAG && (k0 + kb * 16 + 4 * g + e > qpos[j])) s = -INFINITY; st[j][kb][e] = s; mx = fmaxf(mx, s); } }
                mx = fmaxf(mx, __shfl_xor(mx, 16)); mx = fmaxf(mx, __shfl_xor(mx, 32));
                const float mn = fmaxf(m[j], mx);
                if (mn == -INFINITY) {
#pragma unroll
                    for (int kb = 0; kb < 4; ++kb) st[j][kb] = (f32x4_t){0.f, 0.f, 0.f, 0.f};
                } else {
                    const float alpha = __builtin_amdgcn_exp2f(m[j] - mn); m[j] = mn;
                    float ps = 0.f;
#pragma unroll
                    for (int kb = 0; kb < 4; ++kb)
#pragma unroll
                        for (int e = 0; e < 4; ++e) { const float pe = __builtin_amdgcn_exp2f(st[j][kb][e] - mn); st[j][kb][e] = pe; ps += pe; }
                    lsum[j] = lsum[j] * alpha + ps;
#pragma unroll
                    for (int dt = 0; dt < 4; ++dt) O[j][dt] *= alpha;
                }
            }
        }
#pragma unroll
        for (int ks = 0; ks < 2; ++ks) {
            bf16x8_t pf[NQ];
#pragma unroll
            for (int j = 0; j < NQ; ++j) {
                u32x4_t pw = {pk2bf_c(st[j][2 * ks][0], st[j][2 * ks][1]), pk2bf_c(st[j][2 * ks][2], st[j][2 * ks][3]), pk2bf_c(st[j][2 * ks + 1][0], st[j][2 * ks + 1][1]), pk2bf_c(st[j][2 * ks + 1][2], st[j][2 * ks + 1][3])};
                pf[j] = __builtin_bit_cast(bf16x8_t, pw);
                if (FIX) { const unsigned o2 = qi == 0 ? 0x3f803f80u : 0u; const u32x4_t ow = {o2, o2, o2, o2}; OL[j] = __builtin_amdgcn_mfma_f32_16x16x32_bf16(__builtin_bit_cast(bf16x8_t, ow), pf[j], OL[j], 0, 0, 0); }
            }
#pragma unroll
            for (int dt = 0; dt < 4; ++dt) {
                const LAS unsigned char* vp = tbuf + ATT_VOFF + (dt * 16 + qi) * ATT_VP + (32 * ks + 4 * g) * 2;
                const u32x2_t lo = *(const LAS u32x2_t*)vp, hi = *(const LAS u32x2_t*)(vp + 32);
                const u32x4_t aw = {lo.x, lo.y, hi.x, hi.y};
#pragma unroll
                for (int j = 0; j < NQ; ++j) O[j][dt] = __builtin_amdgcn_mfma_f32_16x16x32_bf16(__builtin_bit_cast(bf16x8_t, aw), pf[j], O[j][dt], 0, 0, 0);
            }
            if (NQ > 1) __builtin_amdgcn_sched_barrier(0);
        }
        __builtin_amdgcn_sched_barrier(0);
    }
}
template <bool SAMPLE> DEVI void attn_unit(const P& p, int l, int b, int h, int qb_or_sp, float sbound2  , LAS unsigned char* lds, int tid, int wave, int lane, int part = -1) {
    asm volatile("" : "+v"(lane), "+v"(tid), "+s"(wave));
    const int qi = lane & 15, g = lane >> 4;
    const bf16_t* Qb = p.qb(); const bf16_t* Kb = p.kb(); const bf16_t* Vb = p.vb();
    constexpr int NQ = SAMPLE ? 1 : 2;
    int t0, t1, nwav, qlo; int qpos[NQ]; size_t qrow[NQ];
    const float* Fk;
    if constexpr (!SAMPLE) { const int q0 = qb_or_sp * 256; t0 = 0; t1 = (q0 + 256) / 64; qlo = q0 + 32 * wave; nwav = 8; Fk = p.Fp() + (size_t)b * T_P * 4;
#pragma unroll
        for (int j = 0; j < NQ; ++j) { qpos[j] = qlo + 16 * j + qi; qrow[j] = (size_t)b * T_P + qpos[j]; }
        if (part == 0) t0 = t1 / 2; else if (part == 1) t1 = t1 / 2; }
    else { const int sp = qb_or_sp; t0 = sp * 16; t1 = sp == 3 ? 66 : sp * 16 + 16;        qlo = PAST + 16 * (wave & 3); qpos[0] = qlo + qi; qrow[0] = (size_t)M_P + b * T_S + 16 * (wave & 3) + qi; nwav = 4; Fk = p.Fs() + (size_t)b * FS_LEN * 4; }
    const float* ck = inp(4) + ((size_t)l * NB_S + b) * PAST * 256; const float* cv = inp(5) + ((size_t)l * NB_S + b) * PAST * 256;
    const bool active = wave < nwav;
    const bool fix = sbound2 < 96.f;
    bf16x8_t qf[NQ][2]; float gqx[NQ], m[NQ], lsum[NQ]; f32x4_t O[NQ][4], OL[NQ];
#pragma unroll
    for (int j = 0; j < NQ; ++j) {
        qf[j][0] = *(const bf16x8_t*)(Qb + qrow[j] * 256 + h * 64 + 8 * g); qf[j][1] = *(const bf16x8_t*)(Qb + qrow[j] * 256 + h * 64 + 32 + 8 * g);
        const float gq = Fk[(size_t)qpos[j] * 4 + h] * LOG2E;
        gqx[j] = fix ? gq - 0.5f * sbound2 : gq; m[j] = fix ? 0.f : -INFINITY; lsum[j] = 0.f; OL[j] = (f32x4_t){0.f, 0.f, 0.f, 0.f};
#pragma unroll
        for (int dt = 0; dt < 4; ++dt) O[j][dt] = (f32x4_t){0.f, 0.f, 0.f, 0.f};
    }
    u32x4_t kreg0, vreg0, kreg1, vreg1; float greg0 = 0.f, greg1 = 0.f;
    int kkey = tid >> 3, kpc = tid & 7, vkey = tid & 63, vdg = tid >> 6;
#define ATT_LOAD(t, kreg, vreg, greg) do { const int k0_ = (t) * 64; \
        if (SAMPLE && (t) < 64) { \
            const float* ks_ = ck + ((size_t)(k0_ + kkey) * 4 + h) * 64 + kpc * 8; const float4 a_ = *(const float4*)ks_, b_ = *(const float4*)(ks_ + 4); \
            kreg = (u32x4_t){pk2bf(a_.x, a_.y), pk2bf(a_.z, a_.w), pk2bf(b_.x, b_.y), pk2bf(b_.z, b_.w)}; \
            const float* vs_ = cv + ((size_t)(k0_ + vkey) * 4 + h) * 64 + vdg * 8; const float4 c_ = *(const float4*)vs_, d_ = *(const float4*)(vs_ + 4); \
            vreg = (u32x4_t){pk2bf(c_.x, c_.y), pk2bf(c_.z, c_.w), pk2bf(d_.x, d_.y), pk2bf(d_.z, d_.w)}; \
        } else { const size_t rb_ = SAMPLE ? (size_t)M_P + b * T_S : (size_t)b * T_P + k0_; \
            kreg = *(const u32x4_t*)(Kb + (rb_ + kkey) * 256 + h * 64 + kpc * 8); vreg = *(const u32x4_t*)(Vb + (rb_ + vkey) * 256 + h * 64 + vdg * 8); } \
        if (tid < 64) greg = Fk[(size_t)(k0_ + tid) * 4 + h] * LOG2E; } while (0)
#define ATT_STORE(buf, kreg, vreg, greg) do { \
        *(LAS u32x4_t*)((buf) + kkey * ATT_KP + kpc * 16) = kreg; \
        { LAS unsigned short* vt = (LAS unsigned short*)((buf) + ATT_VOFF) + (vdg * 8) * (ATT_VP / 2) + vkey; \
          _Pragma("unroll") for (int i = 0; i < 4; ++i) { vt[(2 * i) * (ATT_VP / 2)] = (unsigned short)(vreg[i] & 0xffffu); vt[(2 * i + 1) * (ATT_VP / 2)] = (unsigned short)(vreg[i] >> 16); } } \
        if (tid < 64) ((LAS float*)((buf) + ATT_GOFF))[tid] = greg; } while (0)
    ATT_LOAD(t1 - 1, kreg0, vreg0, greg0); ATT_LOAD(t1 - 2, kreg1, vreg1, greg1);
    int cur = 0;
    for (int t = t1 - 1; t >= t0; t -= 2) {
        { int tl = tid; asm volatile("" : "+v"(tl)); kkey = tl >> 3; kpc = tl & 7; vkey = tl & 63; vdg = tl >> 6; }
        if (!SAMPLE && (Fk[(size_t)qb_or_sp * 256 * 4 + h] - Fk[(size_t)(t * 64 + 63) * 4 + h]) * LOG2E + sbound2 < -152.f) break;
        LAS unsigned char* buf = lds + cur * (2 * ATT_BUF);
        ATT_STORE(buf, kreg0, vreg0, greg0); ATT_STORE(buf + ATT_BUF, kreg1, vreg1, greg1);
        __syncthreads();
        if (t - 2 >= t0) { ATT_LOAD(t - 2, kreg0, vreg0, greg0); ATT_LOAD(t - 3, kreg1, vreg1, greg1); }
        if (active && (SAMPLE || (t - 1) * 64 <= qlo + 31)) {
            const bool dg = t * 64 + 63 > qlo;
            if (fix) { if (dg) attn_pair<true, true, NQ>(buf, t, qpos, qi, g, gqx, qf, m, lsum, O, OL); else attn_pair<false, true, NQ>(buf, t, qpos, qi, g, gqx, qf, m, lsum, O, OL); }
            else { if (dg) attn_pair<true, false, NQ>(buf, t, qpos, qi, g, gqx, qf, m, lsum, O, OL); else attn_pair<false, false, NQ>(buf, t, qpos, qi, g, gqx, qf, m, lsum, O, OL); } }
        cur ^= 1;
    }
#undef ATT_STORE
#undef ATT_LOAD
    if (active) {
#pragma unroll
        for (int j = 0; j < NQ; ++j) {
            float ls = lsum[j];
            if (fix) ls = __shfl(OL[j][0], qi);
            else { ls += __shfl_xor(ls, 16); ls += __shfl_xor(ls, 32); }
            if constexpr (!SAMPLE) {
                if (part >= 0) {
                    const size_t u = ((size_t)(((b * 4 + h) * (32 - APS_QB0) + (qb_or_sp - APS_QB0)) * 2 + part)) * 256 + 32 * wave + 16 * j + qi;
                    float* op = p.ppart() + u * 64 + 4 * g;
#pragma unroll
                    for (int dt = 0; dt < 4; ++dt) *(float4*)(op + 16 * dt) = make_float4(O[j][dt][0], O[j][dt][1], O[j][dt][2], O[j][dt][3]);
                    if (g == 0) { p.pml()[u * 2] = m[j]; p.pml()[u * 2 + 1] = ls; }
                    continue;
                }
                const float inv = 1.f / ls; bf16_t* op = p.mix() + qrow[j] * D + 512 + h * 64 + 4 * g;
#pragma unroll
                for (int dt = 0; dt < 4; ++dt) { uint2 o; o.x = pk2bf(O[j][dt][0] * inv, O[j][dt][1] * inv); o.y = pk2bf(O[j][dt][2] * inv, O[j][dt][3] * inv); *(uint2*)(op + 16 * dt) = o; }
            } else {
                const size_t u = ((size_t)(b * 4 + h) * 4 + qb_or_sp) * 64 + 16 * (wave & 3) + qi;
                float* op = p.apart() + u * 64 + 4 * g;
#pragma unroll
                for (int dt = 0; dt < 4; ++dt) *(float4*)(op + 16 * dt) = make_float4(O[j][dt][0], O[j][dt][1], O[j][dt][2], O[j][dt][3]);
                if (g == 0) { p.aml()[u * 2] = m[j]; p.aml()[u * 2 + 1] = ls; }
            }
        }
    }
    __syncthreads();
}
DEVI void attn_sample_combine(const P& p, long gtid, long gsz) {
    for (long i = gtid; i < (long)NB_S * 4 * 64 * 16; i += gsz) {
        const int d4 = (int)(i % 16), q = (int)((i / 16) % 64), bh = (int)(i / 1024);
        float mm = -INFINITY; float ms[4], ls[4];
#pragma unroll
        for (int s = 0; s < 4; ++s) { const size_t u = ((size_t)bh * 4 + s) * 64 + q; ms[s] = p.aml()[u * 2]; ls[s] = p.aml()[u * 2 + 1]; mm = fmaxf(mm, ms[s]); }
        float L = 0.f; float4 o = make_float4(0.f, 0.f, 0.f, 0.f);
#pragma unroll
        for (int s = 0; s < 4; ++s) { const float w = __builtin_amdgcn_exp2f(ms[s] - mm); L += w * ls[s]; const float4 a = *(const float4*)(p.apart() + (((size_t)bh * 4 + s) * 64 + q) * 64 + d4 * 4);
            o.x += w * a.x; o.y += w * a.y; o.z += w * a.z; o.w += w * a.w; }
        const float inv = 1.f / L; const int b = bh / 4, h = bh % 4;
        uint2 w2; w2.x = pk2bf(o.x * inv, o.y * inv); w2.y = pk2bf(o.z * inv, o.w * inv);
        *(uint2*)(p.mix() + ((size_t)M_P + b * T_S + q) * D + 512 + h * 64 + d4 * 4) = w2;
    }
}

DEVI void attn_prompt_combine(const P& p, long gtid, long gsz) {
    for (long i = gtid; i < (long)NB_P * 4 * (32 - APS_QB0) * 256 * 16; i += gsz) {
        const int d4 = (int)(i % 16), r = (int)((i / 16) % 256), un = (int)(i / 4096);
        const size_t u0 = ((size_t)un * 2) * 256 + r, u1 = u0 + 256;
        const float m0 = p.pml()[u0 * 2], l0 = p.pml()[u0 * 2 + 1], m1 = p.pml()[u1 * 2], l1 = p.pml()[u1 * 2 + 1];
        const float mm = fmaxf(m0, m1);
        const float w0 = __builtin_amdgcn_exp2f(m0 - mm), w1 = __builtin_amdgcn_exp2f(m1 - mm);
        const float4 a = *(const float4*)(p.ppart() + u0 * 64 + d4 * 4), c = *(const float4*)(p.ppart() + u1 * 64 + d4 * 4);
        const float inv = 1.f / (w0 * l0 + w1 * l1);
        const int qb = APS_QB0 + un % (32 - APS_QB0), bh = un / (32 - APS_QB0), b = bh / 4, h = bh % 4;
        uint2 w2; w2.x = pk2bf((w0 * a.x + w1 * c.x) * inv, (w0 * a.y + w1 * c.y) * inv); w2.y = pk2bf((w0 * a.z + w1 * c.z) * inv, (w0 * a.w + w1 * c.w) * inv);
        *(uint2*)(p.mix() + ((size_t)b * T_P + qb * 256 + r) * D + 512 + h * 64 + d4 * 4) = w2;
    }
}
constexpr int SSD_BCP = 528;
constexpr int SSD_BFRAG = 64 * SSD_BCP;
constexpr int SSD_SC = SSD_BFRAG + 16384;
constexpr int SSD_RAW = SSD_SC + 3 * 2048;
constexpr int SSD_RAWW = 67 * 128;
constexpr int SSD_LDS = SSD_RAW + 8 * SSD_RAWW;
static_assert(SSD_LDS <= 147456 - 64, "SSD chunk LDS");
DEVI float silu_fast(float x) { return x / (1.f + __expf(-x)); }

template <int NC16> DEVI void stage_raw(const bf16_t* proj, int r0, int col0, const float* hist, int hcol0, bool first_chunk, LAS unsigned char* rawb, int lane) {
    constexpr int RPI = 64 / NC16;
#pragma unroll
    for (int i = 0; i * RPI < 67; ++i) {
        const int row = i * RPI + lane / NC16, pc = lane % NC16;
        if (row < 67) { const int s = row - 3; u32x4_t v = {0u, 0u, 0u, 0u};
            if (s >= 0 || !first_chunk) v = *(const u32x4_t*)(proj + (size_t)(r0 + s) * NP + col0 + pc * 8);
            else if (hist) { const float* hp = hist + (3 + s) * CONVC + hcol0 + pc * 8; v = (u32x4_t){pk2bf(hp[0], hp[1]), pk2bf(hp[2], hp[3]), pk2bf(hp[4], hp[5]), pk2bf(hp[6], hp[7])}; }
            *(LAS u32x4_t*)(rawb + row * 128 + pc * 16) = v; }
    }
}
DEVI void conv_block(const LAS unsigned short* raw, float w0, float w1, float w2, float w3, float bs, int hh, float (&out)[32]) {
    const LAS unsigned short* rb = raw + (4 * hh) * 64;
#pragma unroll
    for (int j = 0; j < 8; ++j) {
        float rw[7];
#pragma unroll
        for (int i = 0; i < 7; ++i) rw[i] = bf2f(rb[(8 * j + i) * 64]);
#pragma unroll
        for (int e = 0; e < 4; ++e) out[4 * j + e] = silu_fast(bs + w0 * rw[e] + w1 * rw[e + 1] + w2 * rw[e + 2] + w3 * rw[e + 3]);
    }
}
DEVI bf16x8_t pack8(float a0, float a1, float a2, float a3, float a4, float a5, float a6, float a7) {
    const u32x4_t w = {pk2bf_c(a0, a1), pk2bf_c(a2, a3), pk2bf_c(a4, a5), pk2bf_c(a6, a7)}; return __builtin_bit_cast(bf16x8_t, w);
}

DEVI void ssd_chunk_unit(const P& p, int l, int ci, LAS unsigned char* lds, int tid, int wave, int lane) {
    const int c32 = lane & 31, hh = lane >> 5, r0 = ci * 64, g = wave >> 2;
    const int seq = ci < NB_P * NCH_P ? ci / NCH_P : NB_P + (ci - NB_P * NCH_P);
    const bool first_chunk = ci >= NB_P * NCH_P || (ci % NCH_P) == 0;
    const float* hist = seq >= NB_P ? inp(8) + ((size_t)l * NB_S + (seq - NB_P)) * 3 * CONVC : nullptr;
    const float* cw = inp(14) + (size_t)l * 4 * CONVC; const float* cbias = inp(15) + (size_t)l * CONVC;
    LAS float* acumL = (LAS float*)(lds + SSD_SC); LAS float* dtL = acumL + 512; LAS float* wgtL = dtL + 512;
    {
        const float dtv = p.dt()[(size_t)(r0 + lane) * 8 + wave]; const float A = -__expf(inp(17)[l * 8 + wave]);
        const float ac = wave_incl_scan(dtv * A, lane); const float alast = __shfl(ac, 63);
        p.acum()[(size_t)(r0 + lane) * 8 + wave] = ac;
        acumL[wave * 64 + lane] = ac; dtL[wave * 64 + lane] = dtv; wgtL[wave * 64 + lane] = dtv * __expf(alast - ac);
    }
    {
        float v[32];
        LAS unsigned char* rawb = lds + SSD_RAW + wave * SSD_RAWW;
        stage_raw<4>(p.proj(), r0, O_XBC + 512 + 32 * wave, hist, 512 + 32 * wave, first_chunk, rawb, lane);
        { const int ch = 512 + 32 * wave + c32; conv_block((const LAS unsigned short*)rawb + c32, cw[ch], cw[CONVC + ch], cw[2 * CONVC + ch], cw[3 * CONVC + ch], cbias[ch], hh, v); }
        LAS unsigned short* rowimg = (LAS unsigned short*)lds;
#pragma unroll
        for (int j = 0; j < 8; ++j)
#pragma unroll
            for (int e = 0; e < 4; ++e) rowimg[(8 * j + 4 * hh + e) * (SSD_BCP / 2) + 32 * wave + c32] = f2bf(v[4 * j + e]);
        if (wave < 4) {
#pragma unroll
            for (int ks = 0; ks < 4; ++ks)
                *(LAS bf16x8_t*)(lds + SSD_BFRAG + ((wave * 4 + ks) * 64 + lane) * 16) = pack8(v[8 * ks], v[8 * ks + 1], v[8 * ks + 2], v[8 * ks + 3], v[8 * ks + 4], v[8 * ks + 5], v[8 * ks + 6], v[8 * ks + 7]);
        }
    }
    bf16x8_t xf[2][4];
    __syncthreads();
    const f32x16_t z16 = {0.f, 0.f, 0.f, 0.f, 0.f, 0.f, 0.f, 0.f, 0.f, 0.f, 0.f, 0.f, 0.f, 0.f, 0.f, 0.f};
    stage_raw<8>(p.proj(), r0, O_XBC + 64 * wave, hist, 64 * wave, first_chunk, lds + SSD_RAW + wave * SSD_RAWW, lane);
#pragma unroll
    for (int pb = 0; pb < 2; ++pb) {
        bf16x8_t xs[4];
        {
            float v[32];
            { const int ch = 64 * wave + 32 * pb + c32; conv_block((const LAS unsigned short*)(lds + SSD_RAW + wave * SSD_RAWW) + 32 * pb + c32, cw[ch], cw[CONVC + ch], cw[2 * CONVC + ch], cw[3 * CONVC + ch], cbias[ch], hh, v); }
#pragma unroll
            for (int ks = 0; ks < 4; ++ks) {
                xf[pb][ks] = pack8(v[8 * ks], v[8 * ks + 1], v[8 * ks + 2], v[8 * ks + 3], v[8 * ks + 4], v[8 * ks + 5], v[8 * ks + 6], v[8 * ks + 7]);
                const f32x4_t wa = *(const LAS f32x4_t*)(wgtL + wave * 64 + 16 * ks + 4 * hh), wb = *(const LAS f32x4_t*)(wgtL + wave * 64 + 16 * ks + 8 + 4 * hh);
                xs[ks] = pack8(v[8 * ks] * wa[0], v[8 * ks + 1] * wa[1], v[8 * ks + 2] * wa[2], v[8 * ks + 3] * wa[3], v[8 * ks + 4] * wb[0], v[8 * ks + 5] * wb[1], v[8 * ks + 6] * wb[2], v[8 * ks + 7] * wb[3]);
            }
        }
        __builtin_amdgcn_sched_barrier(0);
#pragma unroll
        for (int nb = 0; nb < 2; ++nb) {
            f32x16_t Z = z16;
#pragma unroll
            for (int ks = 0; ks < 4; ++ks) { const bf16x8_t bfr = *(const LAS bf16x8_t*)(lds + SSD_BFRAG + (((g * 2 + nb) * 4 + ks) * 64 + lane) * 16); Z = __builtin_amdgcn_mfma_f32_32x32x16_bf16(xs[ks], bfr, Z, 0, 0, 0); }
            float* sp = p.states() + ((size_t)(ci * 8 + wave) * 64 + 32 * pb) * 64 + 32 * nb + c32;
#pragma unroll
            for (int e = 0; e < 16; ++e) sp[(size_t)(8 * (e >> 2) + 4 * hh + (e & 3)) * 64] = Z[e];
        }
        __builtin_amdgcn_sched_barrier(0);
    }
    for (int i = tid; i < 64 * 16; i += 512) { const int s = i >> 4, pc = i & 15; *(u32x4_t*)(p.cact() + (size_t)(r0 + s) * 128 + pc * 8) = *(const LAS u32x4_t*)(lds + s * SSD_BCP + 256 + pc * 16); }
    const float dskip = inp(18)[l * 8 + wave];
#pragma unroll
    for (int tb = 0; tb < 2; ++tb) {
        const int t = 32 * tb + c32; const float at = acumL[wave * 64 + t];
        bf16x8_t LT[2][2];
#pragma unroll
        for (int sb = 0; sb <= tb; ++sb) {
            f32x16_t D1 = z16;
#pragma unroll
            for (int kk = 0; kk < 4; ++kk) {
                const bf16x8_t a = *(const LAS bf16x8_t*)(lds + (32 * sb + c32) * SSD_BCP + (g * 64 + 16 * kk + 8 * hh) * 2);
                const bf16x8_t b = *(const LAS bf16x8_t*)(lds + (32 * tb + c32) * SSD_BCP + 256 + (g * 64 + 16 * kk + 8 * hh) * 2);
                D1 = __builtin_amdgcn_mfma_f32_32x32x16_bf16(a, b, D1, 0, 0, 0);
            }
            float lv[16];
#pragma unroll
            for (int q = 0; q < 4; ++q) { const int sq = 32 * sb + 8 * q + 4 * hh;
                const f32x4_t as = *(const LAS f32x4_t*)(acumL + wave * 64 + sq), ds = *(const LAS f32x4_t*)(dtL + wave * 64 + sq);
#pragma unroll
                for (int e = 0; e < 4; ++e) { const int s = sq + e; float val = D1[4 * q + e] * __expf(at - as[e]) * ds[e]; val = (s <= t) ? val : 0.f; val = (s == t) ? val + dskip : val; lv[4 * q + e] = val; } }
            LT[sb][0] = pack8(lv[0], lv[1], lv[2], lv[3], lv[4], lv[5], lv[6], lv[7]); LT[sb][1] = pack8(lv[8], lv[9], lv[10], lv[11], lv[12], lv[13], lv[14], lv[15]);
        }
#pragma unroll
        for (int pb = 0; pb < 2; ++pb) {
            f32x16_t Y = z16;
#pragma unroll
            for (int sb = 0; sb <= tb; ++sb)
#pragma unroll
                for (int kk = 0; kk < 2; ++kk) Y = __builtin_amdgcn_mfma_f32_32x32x16_bf16(xf[pb][2 * sb + kk], LT[sb][kk], Y, 0, 0, 0);
            float* yp = p.ydg() + (size_t)(r0 + t) * 512 + wave * 64 + 32 * pb + 4 * hh;
#pragma unroll
            for (int q = 0; q < 4; ++q) *(float4*)(yp + 8 * q) = make_float4(Y[4 * q], Y[4 * q + 1], Y[4 * q + 2], Y[4 * q + 3]);
        }
    }
    __syncthreads();
}

DEVI void ssd_scan(const P& p, int l, long gtid, long gsz) {
    const float* s0 = inp(7) + (size_t)l * NB_S * 32768;
    for (long i = gtid; i < (long)NB_P * 32768; i += gsz) {
        const int e = (int)(i % 32768), s = (int)(i / 32768); const int hh = e / 4096;
        if (s < NB_P) { float st = 0.f;
            for (int c0 = 0; c0 < NCH_P; c0 += 16) {
                float v[16], dc[16];
#pragma unroll
                for (int k = 0; k < 16; ++k) { const size_t ci = (size_t)s * NCH_P + c0 + k; v[k] = p.states()[ci * 32768 + e]; dc[k] = p.acum()[(ci * 64 + 63) * 8 + hh]; }
#pragma unroll
                for (int k = 0; k < 16; ++k) { const size_t ci = (size_t)s * NCH_P + c0 + k; p.prevb()[ci * 32768 + e] = f2bf(st); st = st * __expf(dc[k]) + v[k]; }
            }
            p.out[OUT_SSMP + ((size_t)l * NB_P + s) * 32768 + e] = st;
        } else { const int b = s - NB_P; const size_t ci = (size_t)NB_P * NCH_P + b; float st = s0[(size_t)b * 32768 + e];
            p.prevb()[ci * 32768 + e] = f2bf(st); st = st * __expf(p.acum()[(ci * 64 + 63) * 8 + hh]) + p.states()[ci * 32768 + e];
            p.out[OUT_SSMS + ((size_t)l * NB_S + b) * 32768 + e] = st; }
    }
}

DEVI void ssd_scan_sample(const P& p, int l, int b, int tid) {
    const float* s0 = inp(7) + ((size_t)l * NB_S + b) * 32768;
    const size_t ci = (size_t)NB_P * NCH_P + b;
#pragma unroll 4
    for (int e = tid * 4; e < 32768; e += 512 * 4) {
        const float4 s = *(const float4*)(s0 + e), v = *(const float4*)(p.states() + ci * 32768 + e);
        const float dc = __expf(p.acum()[(ci * 64 + 63) * 8 + e / 4096]);
        uint2 o; o.x = pk2bf(s.x, s.y); o.y = pk2bf(s.z, s.w); *(uint2*)(p.prevb() + ci * 32768 + e) = o;
        float4 f; f.x = s.x * dc + v.x; f.y = s.y * dc + v.y; f.z = s.z * dc + v.z; f.w = s.w * dc + v.w;
        *(float4*)(p.out + OUT_SSMS + ((size_t)l * NB_S + b) * 32768 + e) = f;
    }
}

DEVI void ssd_y_unit(const P& p, int l, int ci, LAS unsigned char* lds, int tid, int wave, int lane) {
    const int c32 = lane & 31, hh = lane >> 5, r0 = ci * 64, g = wave >> 2;
    LAS float* part = (LAS float*)lds;
    const f32x16_t z16 = {0.f, 0.f, 0.f, 0.f, 0.f, 0.f, 0.f, 0.f, 0.f, 0.f, 0.f, 0.f, 0.f, 0.f, 0.f, 0.f};
    float y[2][2][16];
#pragma unroll
    for (int tb = 0; tb < 2; ++tb) {
        const size_t r = (size_t)r0 + 32 * tb + c32; const float eat = __expf(p.acum()[r * 8 + wave]); float ssq = 0.f;
#pragma unroll
        for (int pb = 0; pb < 2; ++pb) {
            f32x16_t YO = z16;
#pragma unroll
            for (int kk = 0; kk < 4; ++kk) {
                const bf16x8_t a = *(const bf16x8_t*)(p.prevb() + ((size_t)(ci * 8 + wave) * 64 + 32 * pb + c32) * 64 + 16 * kk + 8 * hh);
                const bf16x8_t b = *(const bf16x8_t*)(p.cact() + r * 128 + g * 64 + 16 * kk + 8 * hh);
                YO = __builtin_amdgcn_mfma_f32_32x32x16_bf16(a, b, YO, 0, 0, 0);
            }
#pragma unroll
            for (int q = 0; q < 4; ++q) { const int p0 = wave * 64 + 32 * pb + 8 * q + 4 * hh;
                const float4 yd = *(const float4*)(p.ydg() + r * 512 + p0); const uint2 zz = *(const uint2*)(p.proj() + r * NP + O_Z + p0);
                const float z0 = __uint_as_float(zz.x << 16), z1 = __uint_as_float(zz.x & 0xffff0000u), z2 = __uint_as_float(zz.y << 16), z3 = __uint_as_float(zz.y & 0xffff0000u);
                const float v0 = (yd.x + YO[4 * q] * eat) * silu_fast(z0), v1 = (yd.y + YO[4 * q + 1] * eat) * silu_fast(z1), v2 = (yd.z + YO[4 * q + 2] * eat) * silu_fast(z2), v3 = (yd.w + YO[4 * q + 3] * eat) * silu_fast(z3);
                y[tb][pb][4 * q] = v0; y[tb][pb][4 * q + 1] = v1; y[tb][pb][4 * q + 2] = v2; y[tb][pb][4 * q + 3] = v3; ssq += v0 * v0 + v1 * v1 + v2 * v2 + v3 * v3; }
        }
        ssq += __shfl_xor(ssq, 32);
        if (hh == 0) part[wave * 64 + 32 * tb + c32] = ssq;
    }
    __syncthreads();
    const float* gn = inp(19) + (size_t)l * 512;
#pragma unroll
    for (int tb = 0; tb < 2; ++tb) {
        const int t = 32 * tb + c32; float tot = 0.f;
#pragma unroll
        for (int w = 0; w < 8; ++w) tot += part[w * 64 + t];
        const float rstd = rsqrtf(tot * (1.f / 512) + EPS); const size_t r = (size_t)r0 + t;
#pragma unroll
        for (int pb = 0; pb < 2; ++pb)
#pragma unroll
            for (int q = 0; q < 4; ++q) { const int p0 = wave * 64 + 32 * pb + 8 * q + 4 * hh; const float4 gg = *(const float4*)(gn + p0);
                uint2 o; o.x = pk2bf(y[tb][pb][4 * q] * rstd * gg.x, y[tb][pb][4 * q + 1] * rstd * gg.y); o.y = pk2bf(y[tb][pb][4 * q + 2] * rstd * gg.z, y[tb][pb][4 * q + 3] * rstd * gg.w);
                *(uint2*)(p.mix() + r * D + p0) = o; }
    }
    __syncthreads();
}

DEVI float sum8(float v) { v += __shfl_xor(v, 1); v += __shfl_xor(v, 2); v += __shfl_xor(v, 4); return v; }
DEVI void unpack8(const u32x4_t w, float (&f)[8]) {
    f[0] = __uint_as_float(w.x << 16); f[1] = __uint_as_float(w.x & 0xffff0000u); f[2] = __uint_as_float(w.y << 16); f[3] = __uint_as_float(w.y & 0xffff0000u);
    f[4] = __uint_as_float(w.z << 16); f[5] = __uint_as_float(w.z & 0xffff0000u); f[6] = __uint_as_float(w.w << 16); f[7] = __uint_as_float(w.w & 0xffff0000u);
}
DEVI void rows_qkv(const P& p, int l, int gw, int NGW, int lane) {
    const int hi = lane >> 5, l32 = lane & 31;
    const float* gq = inp(20) + l * 64; const float* gk = inp(21) + l * 64;
    float gain[8];
#pragma unroll
    for (int i = 0; i < 8; ++i) gain[i] = (hi ? gk : gq)[(l32 & 7) * 8 + i] * (hi ? 1.f : 0.125f * LOG2E);
    u32x4_t nwa = {0u, 0u, 0u, 0u}, nwb = {0u, 0u, 0u, 0u};
    if (gw < M) { const bf16_t* pr = p.proj() + (size_t)gw * NP; nwa = *(const u32x4_t*)(pr + O_Q + 8 * lane); nwb = *(const u32x4_t*)(pr + (hi ? O_VM : O_V) + 8 * l32); }
    for (int r = gw; r < M; r += NGW) {
        const u32x4_t wa = nwa;
        const u32x4_t wb = nwb;
        if (r + NGW < M) { const bf16_t* pr = p.proj() + (size_t)(r + NGW) * NP; nwa = *(const u32x4_t*)(pr + O_Q + 8 * lane); nwb = *(const u32x4_t*)(pr + (hi ? O_VM : O_V) + 8 * l32); }
        float a[8], b[8]; unpack8(wa, a); unpack8(wb, b);
        float ss = 0.f;
#pragma unroll
        for (int i = 0; i < 8; ++i) ss += a[i] * a[i];
        const float rs = rsqrtf(sum8(ss) * (1.f / 64) + EPS);
        float o[8];
#pragma unroll
        for (int i = 0; i < 8; ++i) o[i] = a[i] * rs * gain[i];
        const u32x4_t ow = {pk2bf(o[0], o[1]), pk2bf(o[2], o[3]), pk2bf(o[4], o[5]), pk2bf(o[6], o[7])};
        if (hi == 0) *(u32x4_t*)(p.qb() + (size_t)r * 256 + 8 * l32) = ow;
        else { *(u32x4_t*)(p.kb() + (size_t)r * 256 + 8 * l32) = ow;
            float* ko = r < M_P ? p.out + OUT_KP + ((size_t)l * M_P + r) * 256 + 8 * l32 : p.out + OUT_KS + ((size_t)l * M_S + (r - M_P)) * 256 + 8 * l32;
            *(float4*)ko = make_float4(o[0], o[1], o[2], o[3]); *(float4*)(ko + 4) = make_float4(o[4], o[5], o[6], o[7]); }
        float ge[8]; float s1 = 0.f;
#pragma unroll
        for (int i = 0; i < 8; ++i) { ge[i] = gelu_f(b[i]); s1 += ge[i]; }
        const float mu = sum8(s1) * (1.f / 64); float s2 = 0.f;
#pragma unroll
        for (int i = 0; i < 8; ++i) { ge[i] -= mu; s2 += ge[i] * ge[i]; }
        const float rv = rsqrtf(sum8(s2) * (1.f / 64) + EPS);
        if (hi == 0) { *(u32x4_t*)(p.vb() + (size_t)r * 256 + 8 * l32) = wb;
            float* vo = r < M_P ? p.out + OUT_VP + ((size_t)l * M_P + r) * 256 + 8 * l32 : p.out + OUT_VS + ((size_t)l * M_S + (r - M_P)) * 256 + 8 * l32;
            *(float4*)vo = make_float4(b[0], b[1], b[2], b[3]); *(float4*)(vo + 4) = make_float4(b[4], b[5], b[6], b[7]);
        } else {
#pragma unroll
            for (int i = 0; i < 8; ++i) ge[i] *= rv;
            *(u32x4_t*)(p.vnb() + (size_t)r * 256 + 8 * l32) = (u32x4_t){pk2bf(ge[0], ge[1]), pk2bf(ge[2], ge[3]), pk2bf(ge[4], ge[5]), pk2bf(ge[6], ge[7])};
            if (r >= M_P) { float* mo = p.out + OUT_MLPV + ((size_t)l * M_S + (r - M_P)) * 256 + 8 * l32;
                *(float4*)mo = make_float4(ge[0], ge[1], ge[2], ge[3]); *(float4*)(mo + 4) = make_float4(ge[4], ge[5], ge[6], ge[7]); }
        }
    }
}

DEVI void mlp_unit(const P& p, int l, int u, int wave, int lane) {
    const int c32 = lane & 31, hh = lane >> 5, g = wave >> 1, db = wave & 1;
    const int L = u < 128 ? 128 : 64; const int r0 = u < 128 ? u * 128 : M_P + (u - 128) * 64;
    const int col = g * 64 + 32 * db + c32;
    const float* W = inp(23) + ((size_t)l * 4 + g) * 128 * 128; const float* bsv = inp(24) + ((size_t)l * 4 + g) * 128;
    const int NKS = L / 16;
    bf16x8_t vf[8];
#pragma unroll
    for (int ks = 0; ks < 8; ++ks) {
        if (ks < NKS) { const bf16_t* vp = p.vnb() + (size_t)(r0 + 16 * ks + 8 * hh) * 256 + col;
            unsigned short e[8];
#pragma unroll
            for (int j = 0; j < 8; ++j) e[j] = vp[(size_t)j * 256];
            const u32x4_t w = {(unsigned)e[0] | ((unsigned)e[1] << 16), (unsigned)e[2] | ((unsigned)e[3] << 16), (unsigned)e[4] | ((unsigned)e[5] << 16), (unsigned)e[6] | ((unsigned)e[7] << 16)};
            vf[ks] = __builtin_bit_cast(bf16x8_t, w); }
    }
    const f32x16_t z16 = {0.f, 0.f, 0.f, 0.f, 0.f, 0.f, 0.f, 0.f, 0.f, 0.f, 0.f, 0.f, 0.f, 0.f, 0.f, 0.f};
#pragma unroll
    for (int tb = 0; tb < 4; ++tb) {
        if (32 * tb < L) {
            const int t = 32 * tb + c32; f32x16_t Dv = z16;
#pragma unroll
            for (int ks = 0; ks < 2 * tb + 2; ++ks) {
                const float* wp = W + (size_t)t * 128 + 16 * ks + 8 * hh; const float4 w0 = *(const float4*)wp, w1 = *(const float4*)(wp + 4); const int sb = 16 * ks + 8 * hh;
                const bf16x8_t a = pack8(sb <= t ? w0.x : 0.f, sb + 1 <= t ? w0.y : 0.f, sb + 2 <= t ? w0.z : 0.f, sb + 3 <= t ? w0.w : 0.f, sb + 4 <= t ? w1.x : 0.f, sb + 5 <= t ? w1.y : 0.f, sb + 6 <= t ? w1.z : 0.f, sb + 7 <= t ? w1.w : 0.f);
                Dv = __builtin_amdgcn_mfma_f32_32x32x16_bf16(a, vf[ks], Dv, 0, 0, 0);
            }
#pragma unroll
            for (int e = 0; e < 16; ++e) { const int tt = 32 * tb + 8 * (e >> 2) + 4 * hh + (e & 3); const size_t r = (size_t)r0 + tt;
                const float uu = bf2f(p.proj()[r * NP + O_U + col]);
                p.mix()[r * D + 768 + col] = f2bf(gelu_f(uu) * (Dv[e] + bsv[tt])); }
        }
    }
}


DEVI void mod_phase(const P& p, LAS unsigned char* lds, int bid, int nblk, int tid, int wave, int lane) {
    LAS float* sc = (LAS float*)lds;
    LAS float* red = sc + NSEQ * D;
    const float* cp = inp(2); const float* cs = inp(3); const float* w_ada = inp(11); const float* b_ada = inp(12);
    for (int i = tid; i < NSEQ * D; i += 512) { const int s = i / D, k = i % D; const float c = s < NB_P ? cp[(size_t)s * D + k] : cs[(size_t)(s - NB_P) * D + k]; sc[i] = silu_f(c); }
    __syncthreads();
    for (int it = bid; it < DEPTH * 96; it += nblk) {
        const int ll = it / 96, j0 = (it % 96) * 64;
        const float* wp = w_ada + ((size_t)ll * D + 128 * wave) * 6144 + j0 + lane;
        float acc[NSEQ];
#pragma unroll
        for (int s = 0; s < NSEQ; ++s) acc[s] = 0.f;
        for (int k4 = 0; k4 < 32; ++k4) {
            const float w0 = wp[(size_t)(4 * k4) * 6144], w1 = wp[(size_t)(4 * k4 + 1) * 6144], w2 = wp[(size_t)(4 * k4 + 2) * 6144], w3 = wp[(size_t)(4 * k4 + 3) * 6144];
#pragma unroll
            for (int s = 0; s < NSEQ; ++s) { const f32x4_t c4 = *(const LAS f32x4_t*)(sc + s * D + 128 * wave + 4 * k4); acc[s] += c4[0] * w0 + c4[1] * w1 + c4[2] * w2 + c4[3] * w3; }
        }
#pragma unroll
        for (int s = 0; s < NSEQ; ++s) red[(wave * NSEQ + s) * 64 + lane] = acc[s];
        __syncthreads();
        for (int o = tid; o < NSEQ * 64; o += 512) { const int s = o >> 6, j = o & 63; float t = b_ada[(size_t)ll * 6144 + j0 + j];
#pragma unroll
            for (int w = 0; w < 8; ++w) t += red[(w * NSEQ + s) * 64 + j];
            p.mod()[((size_t)ll * NSEQ + s) * 6144 + j0 + j] = t; }
        __syncthreads();
    }
}

template <int MODE> DEVI void light_gemm_tile(const bf16_t* A, const bf16_t* Bt, int row0, int col0, bf16_t* Obf, int ldo, float* X, const float* Xin, const float* gate, LAS unsigned char* lds, int tid, int wave, int lane) {
    const int r32 = lane & 31, h = lane >> 5;
    bf16x8_t af[2][8], bfr[2][8];
#pragma unroll
    for (int rb = 0; rb < 2; ++rb)
#pragma unroll
        for (int ks = 0; ks < 8; ++ks) {
            af[rb][ks] = *(const bf16x8_t*)(A + (size_t)(row0 + 32 * rb + r32) * D + 128 * wave + 16 * ks + 8 * h);
            bfr[rb][ks] = *(const bf16x8_t*)(Bt + (size_t)(col0 + 32 * rb + r32) * D + 128 * wave + 16 * ks + 8 * h);
        }
    LAS float* part = (LAS float*)lds;
#pragma unroll
    for (int rb = 0; rb < 2; ++rb)
#pragma unroll
        for (int cb = 0; cb < 2; ++cb) {
            f32x16_t acc = {0.f, 0.f, 0.f, 0.f, 0.f, 0.f, 0.f, 0.f, 0.f, 0.f, 0.f, 0.f, 0.f, 0.f, 0.f, 0.f};
#pragma unroll
            for (int ks = 0; ks < 8; ++ks) acc = __builtin_amdgcn_mfma_f32_32x32x16_bf16(af[rb][ks], bfr[cb][ks], acc, 0, 0, 0);
#pragma unroll
            for (int g = 0; g < 16; ++g) part[((wave * 4 + rb * 2 + cb) * 16 + g) * 64 + lane] = acc[g];
        }
    __syncthreads();
#pragma unroll
    for (int i = 0; i < 8; ++i) {
        const int o = tid + 512 * i; const int ln = o & 63, g = (o >> 6) & 15, t4 = o >> 10;
        float v = 0.f;
#pragma unroll
        for (int w = 0; w < 8; ++w) v += part[((w * 4 + t4) * 16 + g) * 64 + ln];
        const int row = row0 + 32 * (t4 >> 1) + (g & 3) + 8 * (g >> 2) + 4 * (ln >> 5), col = col0 + 32 * (t4 & 1) + (ln & 31);
        if (MODE == 0) Obf[(size_t)row * ldo + col] = f2bf(v);
        else X[(size_t)row * D + col] = Xin[(size_t)row * D + col] + gate[(size_t)row_seq(row) * 6144 + col] * v;
    }
    __syncthreads();
}
constexpr int NTHR = 512;
constexpr int CONV_TOPK_ROWS = 19456, CONV_Q_ITEMS = (2 * NEXP - CONV_TOPK_ROWS) / 128;
constexpr int Q_PROMPT = 8 * 2 * (32 - APS_QB0) + 8 * APS_QB0;
constexpr int Q_ATT = Q_PROMPT + 256;
constexpr int QEND = ((Q_ATT - 1) / 4) * 5 + ((Q_ATT - 1) % 4) + 1;
static_assert(CONV_TOPK_ROWS % 4 == 0 && CONV_TOPK_ROWS < 2 * NEXP && 5 * (CONV_Q_ITEMS - 1) + 4 < QEND && (2 * NEXP - CONV_TOPK_ROWS) % 128 == 0, "every conversion item needs a queue slot");
constexpr int LDS_BYTES = 147456;

struct Args { P p; unsigned* bar; };

DEVI void tr_item(const float* W, int ldw, int K, bf16_t* WT, int dst_row0, int src_col0, int k0, LAS float* scr, int lane) {
#pragma unroll 8
    for (int i = 0; i < 32; ++i) { const int kk = 2 * i + (lane >> 5); scr[kk * 33 + (lane & 31)] = W[(size_t)(k0 + kk) * ldw + src_col0 + (lane & 31)]; }
    asm volatile("s_waitcnt lgkmcnt(0)" ::: "memory");
    const int c = lane & 7;
#pragma unroll
    for (int j = 0; j < 4; ++j) { const int n = (lane >> 3) + 8 * j; const LAS float* s = scr + (8 * c) * 33 + n;
        uint4 o; o.x = (unsigned)f2bf(s[0 * 33]) | ((unsigned)f2bf(s[1 * 33]) << 16); o.y = (unsigned)f2bf(s[2 * 33]) | ((unsigned)f2bf(s[3 * 33]) << 16);
        o.z = (unsigned)f2bf(s[4 * 33]) | ((unsigned)f2bf(s[5 * 33]) << 16); o.w = (unsigned)f2bf(s[6 * 33]) | ((unsigned)f2bf(s[7 * 33]) << 16);
        *(uint4*)(WT + (size_t)(dst_row0 + n) * K + k0 + 8 * c) = o; }
    asm volatile("s_waitcnt lgkmcnt(0)" ::: "memory");
}

__global__ void __launch_bounds__(NTHR, 2) mega_fwd(Args a) {
    extern __shared__ __attribute__((aligned(16))) unsigned char lds[];
    LAS unsigned* ctl = (LAS unsigned*)(lds + LDS_BYTES - 64);
    if (threadIdx.x < 16) ctl[threadIdx.x] = 0u;
    __syncthreads();
    const unsigned bar_x = (unsigned)__builtin_amdgcn_readfirstlane((int)xcd_barrier_post(a.bar, (volatile LAS unsigned*)ctl).x);
    const long gsz = (long)gridDim.x * NTHR;
    const int lane = threadIdx.x & 63, wave = __builtin_amdgcn_readfirstlane(threadIdx.x >> 6);
    const int gw = blockIdx.x * 8 + wave, NGW = gridDim.x * 8;
#define LPQ() P q_; q_.out = a.p.out; q_.ws = a.p.ws; asm volatile("" : "+s"(q_.out), "+s"(q_.ws))
#define RUN(PH) do { LPQ(); int t_ = threadIdx.x, b_ = blockIdx.x, lr_ = l; asm volatile("" : "+v"(t_), "+s"(b_), "+s"(lr_)); const long g_ = (long)b_ * NTHR + t_; run_phase<PH>(q_, lr_, g_, gsz); } while (0)
#define LAUNDER() LPQ(); int l_ = l, gw_ = gw, lane_ = lane, bid_ = (int)blockIdx.x; asm volatile("" : "+s"(l_), "+s"(gw_), "+v"(lane_), "+s"(bid_)); (void)l_; (void)gw_; (void)lane_; (void)bid_
#define BAR() do { XcdBarrier bb_; bb_.bar = a.bar; asm volatile("" : "+s"(bb_.bar)); unsigned bx_ = bar_x; asm volatile("" : "+s"(bx_)); bb_.x = bx_; bb_.st = (volatile LAS unsigned*)(lds + LDS_BYTES - 64); xcd_barrier(bb_); } while (0)
    { LPQ(); int t_ = threadIdx.x, b_ = blockIdx.x; asm volatile("" : "+v"(t_), "+s"(b_)); mod_phase(q_, (LAS unsigned char*)lds, b_, (int)gridDim.x, t_, __builtin_amdgcn_readfirstlane(t_ >> 6), t_ & 63); }
    { const int l = 0; RUN(PH_PRO_SMALL); RUN(PH_PRO_TAB); }
    { LPQ(); const P& p = q_;
        LAS float* scr = (LAS float*)(lds + wave * 16384);
        constexpr int I_IN = (NP / 32) * 16, I_OUT = (D / 32) * 16, I_Q = (2048 / 32) * 16, I_L = I_IN + I_OUT + I_Q;
        for (int it = gw; it < DEPTH * I_L; it += NGW) {
            const int ll = it / I_L; int r = it % I_L;
            if (r < I_IN) { const int nb = r / 16, kb = r % 16; const int n0 = nb * 32; const int src = n0 < 1280 ? n0 : (n0 < 2048 ? n0 + 8 : n0 + 12);
                tr_item(inp(13) + (size_t)ll * D * DPROJ, DPROJ, D, p.w_in_t() + (size_t)ll * NP * D, n0, src, kb * 64, scr, lane); continue; }
            r -= I_IN;
            if (r < I_OUT) { const int nb = r / 16, kb = r % 16; tr_item(inp(25) + (size_t)ll * D * D, D, D, p.w_out_t() + (size_t)ll * D * D, nb * 32, nb * 32, kb * 64, scr, lane); continue; }
            r -= I_OUT;
            { const int nb = r / 16, kb = r % 16; tr_item(inp(26) + (size_t)ll * D * 2048, 2048, D, p.wq_t() + (size_t)ll * 2048 * D, nb * 32, nb * 32, kb * 64, scr, lane); }
        }
    }
    BAR();
    for (int l = 0; l < DEPTH; ++l) {
        if (l == 0) { { LAUNDER(); adaln_rows<1>(q_, l_, gw_, NGW, lane_, true); } BAR(); }
        { LAUNDER(); pg8::Gemm g{q_.hb(), q_.w_in_t() + (size_t)l_ * NP * D, M, NP, D}; pg8::StaticOrder S; S.init(M, NP, (int)gridDim.x, bid_);
          pg8::EpiBf16 E{q_.proj(), NP};
          pg8::gemm_phase<pg8::EpiBf16, pg8::StaticOrder, true, true>((PG8_LAS unsigned char*)lds, g, S, E); }
        { LAUNDER(); const int rem_ = ((M / 256) * (NP / 256)) % (int)gridDim.x;
          if (rem_ > 0 && ((int)gridDim.x - rem_) * 4 >= (int)gridDim.x) { if (bid_ >= rem_) scan_chunks(q_, l_, gw_ - rem_ * 8, NGW - rem_ * 8, lane_); }
          else scan_chunks(q_, l_, gw_, NGW, lane_);
        }
        BAR();
        { LAUNDER(); int tid_ = threadIdx.x; asm volatile("" : "+v"(tid_)); const int wv_ = __builtin_amdgcn_readfirstlane(tid_ >> 6);
          for (int ci = bid_; ci < NB_P * NCH_P; ci += (int)gridDim.x) ssd_chunk_unit(q_, l_, ci, (LAS unsigned char*)lds, tid_, wv_, tid_ & 63); }
        RUN(PH_CONVSTATE);
        { LAUNDER(); const int nx_ = NB_P * NCH_P - (int)gridDim.x;
          if (nx_ > 0 && nx_ * 2 < (int)gridDim.x) { if (bid_ >= nx_) { rows_qkv(q_, l_, gw_ - nx_ * 8, NGW - nx_ * 8, lane_); scan_fix(q_, gw_ - nx_ * 8, NGW - nx_ * 8, lane_); } }
          else { rows_qkv(q_, l_, gw_, NGW, lane_); scan_fix(q_, gw_, NGW, lane_); } }
        BAR();
        { LAUNDER(); for (int u = bid_; u < 144; u += (int)gridDim.x) mlp_unit(q_, l_, u, wave, lane_); }
        { LPQ(); int t_ = threadIdx.x, b_ = blockIdx.x, lr_ = l; asm volatile("" : "+v"(t_), "+s"(b_), "+s"(lr_)); const long g_ = (long)b_ * NTHR + t_; ssd_scan(q_, lr_, g_, gsz); }
        { LAUNDER(); int tid_ = threadIdx.x; asm volatile("" : "+v"(tid_)); const int wv_ = __builtin_amdgcn_readfirstlane(tid_ >> 6);
          const int sb_ = bid_ - ((int)gridDim.x - NB_S);
          if (sb_ >= 0 && (int)gridDim.x >= NB_S) {
              const int ci = NB_P * NCH_P + sb_;
              ssd_chunk_unit(q_, l_, ci, (LAS unsigned char*)lds, tid_, wv_, tid_ & 63);
              asm volatile("s_waitcnt vmcnt(0)" ::: "memory"); __syncthreads();
              ssd_scan_sample(q_, l_, sb_, tid_);
              asm volatile("s_waitcnt vmcnt(0)" ::: "memory"); __syncthreads();
              ssd_y_unit(q_, l_, ci, (LAS unsigned char*)lds, tid_, wv_, tid_ & 63);
              __syncthreads();
          } }
        { LAUNDER(); int tid_ = threadIdx.x; asm volatile("" : "+v"(tid_)); const int wv_ = __builtin_amdgcn_readfirstlane(tid_ >> 6);
          float mq = fabsf(inp(20)[l_ * 64 + lane_]), mk = fabsf(inp(21)[l_ * 64 + lane_]);
#pragma unroll
          for (int o = 1; o < 64; o <<= 1) { mq = fmaxf(mq, __shfl_xor(mq, o)); mk = fmaxf(mk, __shfl_xor(mk, o)); }
          const float sb2 = 2.02f * 64.f * 0.125f * LOG2E * mq * mk;
          unsigned* qctr = a.bar + 3600 + l_; asm volatile("" : "+s"(qctr));
          LAS int* qslot = (LAS int*)(lds + 81920);
          for (;;) {
              if (tid_ == 0) *qslot = (int)__hip_atomic_fetch_add(qctr, 1u, __ATOMIC_RELAXED, __HIP_MEMORY_SCOPE_AGENT);
              __syncthreads();
              const int it0 = __builtin_amdgcn_readfirstlane(*qslot);
              if (it0 >= QEND) break;
              const int qc = it0 / 5, qr = it0 - 5 * qc;
              if (qr == 4) {
                  if (qc < CONV_Q_ITEMS) peer_tables_fp8(q_, l_, CONV_TOPK_ROWS + qc * 128, CONV_TOPK_ROWS + (qc + 1) * 128, wv_, 8, tid_ & 63);
                  __syncthreads(); continue; }
              const int it = qc * 4 + qr;
              if (it < Q_PROMPT) {
                  static_assert(APS_QB0 == 16, "queue order below assumes 16 split + 16 whole row blocks");
                  const int r_ = it / 24, k_ = it - 24 * r_;
                  if (k_ < 16) { const int bh = k_ >> 1; attn_unit<false>(q_, l_, bh >> 2, bh & 3, 31 - r_, sb2, (LAS unsigned char*)lds, tid_, wv_, tid_ & 63, k_ & 1); }
                  else { const int bh = k_ - 16; attn_unit<false>(q_, l_, bh >> 2, bh & 3, 15 - r_, sb2, (LAS unsigned char*)lds, tid_, wv_, tid_ & 63, -1); } }
              else { const int si = it - Q_PROMPT; attn_unit<true>(q_, l_, si >> 4, (si >> 2) & 3, si & 3, sb2, (LAS unsigned char*)lds, tid_, wv_, tid_ & 63); }
          } }
        BAR();
        { LAUNDER(); int tid_ = threadIdx.x; asm volatile("" : "+v"(tid_)); const int wv_ = __builtin_amdgcn_readfirstlane(tid_ >> 6);
          for (int ci = bid_; ci < NB_P * NCH_P; ci += (int)gridDim.x) ssd_y_unit(q_, l_, ci, (LAS unsigned char*)lds, tid_, wv_, tid_ & 63); }
        { LPQ(); int t_ = threadIdx.x, b_ = blockIdx.x; asm volatile("" : "+v"(t_), "+s"(b_)); const int nx_ = NB_P * NCH_P - (int)gridDim.x;
          if (nx_ > 0 && nx_ * 2 < (int)gridDim.x) { if (b_ >= nx_) attn_sample_combine(q_, (long)(b_ - nx_) * NTHR + t_, gsz - (long)nx_ * NTHR); }
          else attn_sample_combine(q_, (long)b_ * NTHR + t_, gsz);
          attn_prompt_combine(q_, (long)b_ * NTHR + t_, gsz); }
        BAR();
        { LAUNDER(); pg8::Gemm g{q_.mix(), q_.w_out_t() + (size_t)l_ * D * D, M_P, D, D}; pg8::StaticOrder S; S.init(M_P, D, (int)gridDim.x, bid_);
          pg8::EpiResid E{q_.x(), q_.mod() + (size_t)l_ * NSEQ * 6144 + 2 * D, l_ == 0 ? inp(0) : (const float*)q_.x()};
          pg8::gemm_phase<pg8::EpiResid, pg8::StaticOrder, true, true>((PG8_LAS unsigned char*)lds, g, S, E); }
        { LAUNDER(); int tid_ = threadIdx.x; asm volatile("" : "+v"(tid_));
          for (int t = bid_; t < (M_S / 64) * (D / 64); t += (int)gridDim.x)
              light_gemm_tile<1>(q_.mix(), q_.w_out_t() + (size_t)l_ * D * D, M_P + 64 * (t / (D / 64)), 64 * (t % (D / 64)), (bf16_t*)nullptr, 0, q_.x(), l_ == 0 ? inp(1) - (size_t)M_P * D : (const float*)q_.x(), q_.mod() + (size_t)l_ * NSEQ * 6144 + 2 * D, (LAS unsigned char*)lds, tid_, wave, tid_ & 63); }
        BAR();
        { LAUNDER(); adaln_rows<2>(q_, l_, gw_, NGW, lane_); }
        BAR();
        { LAUNDER(); pg8::Gemm g{q_.hb(), q_.wq_t() + (size_t)l_ * 2048 * D, M_P, 2048, D}; pg8::StaticOrder S; S.init(M_P, 2048, (int)gridDim.x, bid_);
          pg8::EpiBf16 E{q_.pq(), 2048};
          pg8::gemm_phase<pg8::EpiBf16, pg8::StaticOrder, true, true>((PG8_LAS unsigned char*)lds, g, S, E); }
        { LAUNDER(); int tid_ = threadIdx.x; asm volatile("" : "+v"(tid_));
          for (int t = bid_; t < (M_S / 64) * (2048 / 64); t += (int)gridDim.x)
              light_gemm_tile<0>(q_.hb(), q_.wq_t() + (size_t)l_ * 2048 * D, M_P + 64 * (t / 32), 64 * (t % 32), q_.pq(), 2048, (float*)nullptr, (const float*)nullptr, (const float*)nullptr, (LAS unsigned char*)lds, tid_, wave, tid_ & 63); }
        BAR();
        { LAUNDER();
          for (int u = bid_; u < M / 32; u += (int)gridDim.x)
              peer_topk_unit(q_.pq(), q_.keysb() + (size_t)l_ * 16 * 128 * 128, q_.eidx(), q_.gw(), u * 32, wave, lane_, (LAS unsigned char*)lds + wave * 1024); }
        { LAUNDER(); const int rem_ = (M / 32) % (int)gridDim.x;
          if (rem_ > 0 && ((int)gridDim.x - rem_) * 2 >= (int)gridDim.x) { if (bid_ >= rem_) peer_tables_fp8(q_, l_, 0, CONV_TOPK_ROWS, gw_ - rem_ * 8, NGW - rem_ * 8, lane_); }
          else peer_tables_fp8(q_, l_, 0, CONV_TOPK_ROWS, gw_, NGW, lane_); }
        BAR();
        { LAUNDER();
          for (int tok = gw_; tok < M_P; tok += NGW)
              peer_gather_token_t<8>(q_, l_, 0, -1, (LAS float*)nullptr, q_.u8() + (size_t)l_ * NEXP * D, q_.v8() + (size_t)l_ * NEXP * D, q_.sinv() + (size_t)l_ * NEXP, q_.sinv() + (size_t)(DEPTH + l_) * NEXP, q_.h8(), q_.eidx(), q_.gw(), q_.x(), q_.mod() + (size_t)l_ * NSEQ * 6144 + 5 * D, tok, lane_, (LAS unsigned char*)lds + wave * 1024);
          for (int j = bid_; j < M_S / 4; j += (int)gridDim.x)
              peer_gather_token_t<4>(q_, l_, 4 * (wave >> 2), wave >> 2, (LAS float*)(lds + 8192) + (wave & 3) * 1024, q_.u8() + (size_t)l_ * NEXP * D, q_.v8() + (size_t)l_ * NEXP * D, q_.sinv() + (size_t)l_ * NEXP, q_.sinv() + (size_t)(DEPTH + l_) * NEXP, q_.h8(), q_.eidx(), q_.gw(), q_.x(), q_.mod() + (size_t)l_ * NSEQ * 6144 + 5 * D, M_P + 4 * j + (wave & 3), lane_, (LAS unsigned char*)lds + wave * 1024);
        }
        BAR();
    }
#undef RUN
#undef BAR
}

extern "C" void kernel_launch(void* const* d_in, const int* in_sizes, int n_in, void* d_out, int out_size, void* d_ws, size_t ws_size, hipStream_t stream) {
    static int grid = 0;
    if (grid == 0) {
        int dev = 0, cus = 0;
        (void)hipGetDevice(&dev); (void)hipDeviceGetAttribute(&cus, hipDeviceAttributeMultiprocessorCount, dev);
        (void)hipFuncSetAttribute((const void*)mega_fwd, hipFuncAttributeMaxDynamicSharedMemorySize, LDS_BYTES);
        (void)hipGetLastError();
        grid = cus > 0 ? cus : 256;
    }
    if (ws_size < WS_END || n_in < 30) return;
    Args a{};
    P& p = a.p;
    for (int i = 0; i < 30; ++i) p.in[i] = (const float*)d_in[i];
    p.out = (float*)d_out;
    p.ws = (unsigned char*)d_ws; a.bar = (unsigned*)d_ws;
    (void)hipMemsetAsync(d_ws, 0, 16384, stream);
    hipLaunchKernelGGL(mega_fwd, dim3(grid), dim3(NTHR), LDS_BYTES, stream, a);
}
```

```cpp
#include <hip/hip_runtime.h>
#include <stdint.h>
#include <math.h>

#define DEVI __device__ __forceinline__

constexpr int D = 1024, NB_P = 2, T_P = 8192, NB_S = 16, T_S = 64, PAST = 4096, DEPTH = 4;
constexpr int M_P = NB_P * T_P, M_S = NB_S * T_S, M = M_P + M_S, NSEQ = NB_P + NB_S;
constexpr int DPROJ = 2572, CONVC = 768;
constexpr int S_DT = 1280, S_F = 2056;
constexpr int NP = 2560;
constexpr int O_Z = 0, O_XBC = 512, O_Q = 1280, O_K = 1536, O_V = 1792, O_U = 2048, O_VM = 2304;
constexpr int NCH_P = T_P / 64, NCHUNK = NB_P * NCH_P + NB_S;
constexpr int NEXP = 16384;
constexpr int APS_QB0 = 16;
constexpr int FS_LEN = PAST + T_S;
constexpr float EPS = 1e-6f;

constexpr size_t OUT_Y = 0;
constexpr size_t OUT_KP = (size_t)M * D;
constexpr size_t OUT_VP = OUT_KP + (size_t)DEPTH * M_P * 256;
constexpr size_t OUT_LFP = OUT_VP + (size_t)DEPTH * M_P * 256;
constexpr size_t OUT_SSMP = OUT_LFP + (size_t)DEPTH * M_P * 4;
constexpr size_t OUT_CONVP = OUT_SSMP + (size_t)DEPTH * NB_P * 8 * 64 * 64;
constexpr size_t OUT_KS = OUT_CONVP + (size_t)DEPTH * NB_P * 3 * CONVC;
constexpr size_t OUT_VS = OUT_KS + (size_t)DEPTH * M_S * 256;
constexpr size_t OUT_LFS = OUT_VS + (size_t)DEPTH * M_S * 256;
constexpr size_t OUT_SSMS = OUT_LFS + (size_t)DEPTH * M_S * 4;
constexpr size_t OUT_CONVS = OUT_SSMS + (size_t)DEPTH * NB_S * 8 * 64 * 64;
constexpr size_t OUT_MLPV = OUT_CONVS + (size_t)DEPTH * NB_S * 3 * CONVC;
constexpr size_t OUT_TOTAL = OUT_MLPV + (size_t)DEPTH * M_S * 256;
static_assert(OUT_TOTAL == 57329664, "output size");

typedef unsigned short bf16_t;
DEVI float bf2f(bf16_t v) { return __uint_as_float((unsigned)v << 16); }
DEVI bf16_t f2bf(float f) { unsigned u = __float_as_uint(f); return (bf16_t)((u + 0x7fffu + ((u >> 16) & 1u)) >> 16); }


constexpr size_t al256(size_t x) { return (x + 255) & ~(size_t)255; }
constexpr size_t WS_BAR = 0;
constexpr size_t WS_MOD = 16384;
constexpr size_t WS_RSTD = WS_MOD + al256((size_t)DEPTH * NSEQ * 6144 * 4);
constexpr size_t WS_H = WS_RSTD + al256((size_t)M * 4);
constexpr size_t WS_FLOC = WS_H;
constexpr size_t WS_CSUM = WS_FLOC + al256((size_t)M * 4 * 4);
constexpr size_t WS_HB = WS_CSUM + al256((size_t)(NCHUNK + NB_S * 64) * 4 * 4);
constexpr size_t WS_PROJ = WS_HB + al256((size_t)M * D * 2);
constexpr size_t WS_DTF = WS_PROJ + al256((size_t)M * NP * 2);
constexpr size_t WS_XBC = WS_DTF + al256((size_t)M * 12 * 4);
constexpr size_t WS_DT = WS_XBC + al256((size_t)M * CONVC * 4);
constexpr size_t WS_ACUM = WS_DT + al256((size_t)M * 8 * 4);
constexpr size_t WS_QN = WS_ACUM + al256((size_t)M * 8 * 4);
constexpr size_t WS_QB = WS_QN;
constexpr size_t WS_KB = WS_QB + al256((size_t)M * 256 * 2);
constexpr size_t WS_VB = WS_KB + al256((size_t)M * 256 * 2);
constexpr size_t WS_APART = WS_VB + al256((size_t)M * 256 * 2);
constexpr size_t WS_AML = WS_APART + al256((size_t)NB_S * 16 * 64 * 64 * 4);
constexpr size_t WS_LOGF = WS_AML + al256((size_t)NB_S * 16 * 64 * 2 * 4);
constexpr size_t WS_FP = WS_LOGF + al256((size_t)M * 4 * 4);
constexpr size_t WS_FS = WS_FP + al256((size_t)M_P * 4 * 4);
constexpr size_t WS_VN = WS_FS + al256((size_t)NB_S * FS_LEN * 4 * 4);
constexpr size_t WS_MIX = WS_VN + al256((size_t)M * 256 * 4);
constexpr size_t WS_CB = WS_MIX + al256((size_t)M * D * 2);
constexpr size_t WS_STATES = WS_CB + al256((size_t)NCHUNK * 8192 * 4);
constexpr size_t WS_YZ = WS_STATES + al256((size_t)NCHUNK * 32768 * 4);
constexpr size_t WS_PQ = WS_YZ + al256((size_t)M * 512 * 4);
constexpr size_t WS_TS = WS_PQ + al256((size_t)M * 2048 * 2);
constexpr size_t WS_TI = WS_TS + al256((size_t)M * 256 * 4);
constexpr size_t WS_EIDX = WS_TI + al256((size_t)M * 256 * 4);
constexpr size_t WS_GW = WS_EIDX + al256((size_t)M * 128 * 4);
constexpr size_t WS_COEF = WS_GW + al256((size_t)M * 128 * 4);
constexpr size_t WS_WIN = WS_COEF + al256((size_t)M * 128 * 4);
constexpr size_t WS_WOUT = WS_WIN + al256((size_t)DEPTH * NP * D * 2);
constexpr size_t WS_WQ = WS_WOUT + al256((size_t)DEPTH * D * D * 2);
constexpr size_t WS_WSMALL = WS_WQ + al256((size_t)DEPTH * 2048 * D * 2);
constexpr size_t WS_KEYSB = WS_WSMALL + al256((size_t)DEPTH * 12 * D * 4);
constexpr size_t WS_UT = WS_KEYSB + al256((size_t)DEPTH * 16 * 128 * 128 * 2);
constexpr size_t WS_VT = WS_UT + al256((size_t)DEPTH * NEXP * D * 2);
constexpr size_t WS_SINV = WS_VT + al256((size_t)DEPTH * NEXP * D * 2);
constexpr size_t WS_H8 = WS_SINV + al256((size_t)2 * DEPTH * NEXP * 4);
constexpr size_t WS_END = WS_H8 + al256((size_t)2 * M * D);

struct P {
    const float* in[30];
    float* out;
    unsigned char* ws;
    DEVI float* x() const { return out; }
    DEVI float* mod() const { return (float*)(ws + WS_MOD); }
    DEVI float* rstd() const { return (float*)(ws + WS_RSTD); }
    DEVI float* Floc() const { return (float*)(ws + WS_FLOC); }
    DEVI float* csum() const { return (float*)(ws + WS_CSUM); }
    DEVI bf16_t* hb() const { return (bf16_t*)(ws + WS_HB); }
    DEVI bf16_t* proj() const { return (bf16_t*)(ws + WS_PROJ); }
    DEVI float* dtf() const { return (float*)(ws + WS_DTF); }
    DEVI bf16_t* prevb() const { return (bf16_t*)(ws + WS_XBC); }
    DEVI float* dt() const { return (float*)(ws + WS_DT); }
    DEVI float* acum() const { return (float*)(ws + WS_ACUM); }
    DEVI bf16_t* qb() const { return (bf16_t*)(ws + WS_QB); }
    DEVI bf16_t* kb() const { return (bf16_t*)(ws + WS_KB); }
    DEVI bf16_t* vb() const { return (bf16_t*)(ws + WS_VB); }
    DEVI float* apart() const { return (float*)(ws + WS_APART); }
    DEVI float* aml() const { return (float*)(ws + WS_AML); }
    DEVI float* logf() const { return (float*)(ws + WS_LOGF); }
    DEVI float* Fp() const { return (float*)(ws + WS_FP); }
    DEVI float* Fs() const { return (float*)(ws + WS_FS); }
    DEVI bf16_t* vnb() const { return (bf16_t*)(ws + WS_VN); }
    DEVI bf16_t* mix() const { return (bf16_t*)(ws + WS_MIX); }
    DEVI bf16_t* cact() const { return (bf16_t*)(ws + WS_CB); }
    DEVI float* states() const { return (float*)(ws + WS_STATES); }
    DEVI float* ydg() const { return (float*)(ws + WS_YZ); }
    DEVI bf16_t* pq() const { return (bf16_t*)(ws + WS_PQ); }
    DEVI float* ppart() const { return (float*)(ws + WS_PQ); }
    DEVI float* pml() const { return (float*)(ws + WS_PQ + (size_t)NB_P * 4 * (32 - APS_QB0) * 2 * 256 * 64 * 4); }
    DEVI float* ts() const { return (float*)(ws + WS_TS); }
    DEVI int* ti() const { return (int*)(ws + WS_TI); }
    DEVI int* eidx() const { return (int*)(ws + WS_EIDX); }
    DEVI float* gw() const { return (float*)(ws + WS_GW); }
    DEVI float* coef() const { return (float*)(ws + WS_COEF); }
    DEVI bf16_t* w_in_t() const { return (bf16_t*)(ws + WS_WIN); }
    DEVI bf16_t* w_out_t() const { return (bf16_t*)(ws + WS_WOUT); }
    DEVI bf16_t* wq_t() const { return (bf16_t*)(ws + WS_WQ); }
    DEVI float* wsmall() const { return (float*)(ws + WS_WSMALL); }
    DEVI bf16_t* keysb() const { return (bf16_t*)(ws + WS_KEYSB); }
    DEVI unsigned char* u8() const { return ws + WS_UT; }
    DEVI unsigned char* v8() const { return ws + WS_VT; }
    DEVI float* sinv() const { return (float*)(ws + WS_SINV); }
    DEVI unsigned char* h8() const { return ws + WS_H8; }
};

typedef const float* cfp_t;
#define AS_GLOBAL(T, ptr) ((T*)((__attribute__((address_space(1))) T*)(ptr)))
DEVI cfp_t inp(int i) { const __attribute__((address_space(4))) cfp_t* k = (const __attribute__((address_space(4))) cfp_t*)__builtin_amdgcn_kernarg_segment_ptr(); typedef const __attribute__((address_space(1))) float* gcfp_t; const gcfp_t r = *(const volatile __attribute__((address_space(4))) gcfp_t*)(k + i); return (cfp_t)r; }
DEVI int row_seq(int r) { return r < M_P ? r / T_P : NB_P + (r - M_P) / T_S; }
DEVI int row_t(int r) { return r < M_P ? r % T_P : (r - M_P) % T_S; }
DEVI float silu_f(float x) { return x / (1.f + expf(-x)); }
DEVI float softplus_f(float x) { return x > 20.f ? x : log1pf(expf(x)); }
DEVI float gelu_f(float x) { const float u = 0.7978845608028654f * (x + 0.044715f * x * x * x); return x * __builtin_amdgcn_rcpf(1.f + __expf(-2.f * u)); }
DEVI unsigned pk2bf(float lo, float hi) { unsigned r; asm volatile("v_cvt_pk_bf16_f32 %0, %1, %2" : "=v"(r) : "v"(lo), "v"(hi)); return r; }
typedef float f32x2c_t __attribute__((ext_vector_type(2)));
typedef __bf16 bf16x2c_t __attribute__((ext_vector_type(2)));
DEVI unsigned pk2bf_c(float lo, float hi) { const f32x2c_t v = {lo, hi}; const bf16x2c_t r = __builtin_convertvector(v, bf16x2c_t); return __builtin_bit_cast(unsigned, r); }
#define PROJ(r, c) bf2f(p.proj()[(size_t)(r) * NP + (c)])

namespace pg8 {
#define PG8_LAS __attribute__((address_space(3)))

typedef short bf16x8 __attribute__((ext_vector_type(8)));
typedef float f32x4 __attribute__((ext_vector_type(4)));
typedef unsigned u32x4 __attribute__((ext_vector_type(4)));
constexpr int BM = 256, BK = 64, HALF = 128, HTB = HALF * BK * 2  , STAGE_BYTES = 8 * HTB, NXCD = 8, WGM = 8;

__host__ __device__ __forceinline__ int lds_byte(int r, int c) { const int st = (r >> 4) * 2 + (c >> 5), rr = r & 15, cc = c & 31, ob = rr * 64 + cc * 2; return st * 1024 + (ob ^ (((ob >> 9) & 1) << 5)); }
__host__ __device__ __forceinline__ void stage_rc(int b, int& R, int& C) { const int st = b / 1024, sb = b % 1024, swz = sb ^ (((sb >> 9) & 1) << 5); R = (st >> 1) * 16 + swz / 64; C = (st & 1) * 32 + (swz % 64) / 2; }
__host__ __device__ __forceinline__ int perm32(int rho) { const int n = rho >> 4, i = rho & 15; return 8 * (i >> 2) + 4 * n + (i & 3); }

struct Unit { int pm, pn; };
struct Gemm { const bf16_t* A; const bf16_t* Bt; int M, N, K; };

struct StaticOrder {
    int nM, nN, nwg, G, c;
    __host__ __device__ void init(int M, int N, int G_, int c_) { nM = M / BM; nN = N / BM; nwg = nM * nN; G = G_; c = c_; }
    __host__ __device__ bool next(int i, Unit& u) const {
        const long L = (long)i * G + c; if (L >= nwg) return false;
        int wgid = (int)L; { const int q = nwg / NXCD, r = nwg % NXCD, xcd = wgid % NXCD, off = wgid / NXCD; wgid = (xcd < r ? xcd * (q + 1) : r * (q + 1) + (xcd - r) * q) + off; }
        const int nig = WGM * nN, gid = wgid / nig, fm = gid * WGM, gsz = (nM - fm) < WGM ? (nM - fm) : WGM;
        u.pm = fm + ((wgid % nig) % gsz); u.pn = (wgid % nig) / gsz; return true;
    }
    __device__ __forceinline__ void a_ready(const Unit&) const {}
    __device__ __forceinline__ void done(const Unit&) const {}
};

__device__ __forceinline__ unsigned cvt_pk_bf16(float lo, float hi) { unsigned r; asm volatile("v_cvt_pk_bf16_f32 %0, %1, %2" : "=v"(r) : "v"(lo), "v"(hi)); return r; }
struct EpiBf16 {
    static constexpr bool PERM = true, AFTER_DRAIN = false;
    bf16_t* O; int ldc;
    __device__ __forceinline__ void operator()(const f32x4 (&acc)[2][2][4][2], const Unit& u, int wr, int wc, int fr, int fq) const {
        const int row0 = u.pm * BM + wr * 64 + fr; const int col0 = u.pn * BM + wc * 32 + 8 * fq;
#pragma unroll
        for (int ai = 0; ai < 2; ++ai)
#pragma unroll
            for (int m = 0; m < 4; ++m) { bf16_t* rowp = O + (size_t)(row0 + ai * HALF + m * 16) * ldc + col0;
#pragma unroll
                for (int bj = 0; bj < 2; ++bj) { const f32x4 v0 = acc[ai][bj][m][0], v1 = acc[ai][bj][m][1];
                    u32x4 w; w.x = cvt_pk_bf16(v0[0], v0[1]); w.y = cvt_pk_bf16(v0[2], v0[3]); w.z = cvt_pk_bf16(v1[0], v1[1]); w.w = cvt_pk_bf16(v1[2], v1[3]);
                    *(u32x4*)(rowp + bj * HALF) = w; } }
    }
};
struct EpiResid {
    static constexpr bool PERM = true, AFTER_DRAIN = false;
    float* X; const float* gate; const float* Xin;
    __device__ __forceinline__ void operator()(const f32x4 (&acc)[2][2][4][2], const Unit& u, int wr, int wc, int fr, int fq) const {
        const int row0 = u.pm * BM + wr * 64 + fr; const int col0 = u.pn * BM + wc * 32 + 8 * fq;
#pragma unroll
        for (int ai = 0; ai < 2; ++ai) {
            const int rb = u.pm * BM + ai * HALF + wr * 64;
            const int s = rb < 16384 ? rb / 8192 : 2 + (rb - 16384) / 64;
            const float* gp = gate + (size_t)s * 6144 + col0;
#pragma unroll
            for (int bj = 0; bj < 2; ++bj) { const f32x4 g0 = *(const f32x4*)(gp + bj * HALF), g1 = *(const f32x4*)(gp + bj * HALF + 4);
#pragma unroll
                for (int m = 0; m < 4; ++m) { const size_t xo = (size_t)(row0 + ai * HALF + m * 16) * 1024 + col0 + bj * HALF; float* xp = X + xo; const float* xi = Xin + xo;
                    f32x4 x0 = *(const f32x4*)xi, x1 = *(const f32x4*)(xi + 4);
                    x0 += g0 * acc[ai][bj][m][0]; x1 += g1 * acc[ai][bj][m][1];
                    *(f32x4*)xp = x0; *(f32x4*)(xp + 4) = x1; } }
        }
    }
};

template <class Epi, class Sched, bool ALIGN_EPI = false, bool SP2 = false>
__device__ __forceinline__ void gemm_phase(PG8_LAS unsigned char* lds, const Gemm g, const Sched& S, const Epi& E) {
    int tid_ = threadIdx.x; asm volatile("" : "+v"(tid_));
    const int tid = tid_, wid = __builtin_amdgcn_readfirstlane(tid >> 6), lane = tid & 63, wr = wid >> 2, wc = wid & 3, fr = lane & 15, fq = lane >> 4;
    const int K = g.K, nt = K / BK;
    unsigned voffA[2], voffB[2];
#pragma unroll
    for (int i = 0; i < 2; ++i) { int R, C; stage_rc(tid * 16 + i * 8192, R, C); const int Rb = Epi::PERM ? ((R & ~31) + perm32(R & 31)) : R;
        voffA[i] = (unsigned)(R * K + C) * 2u; voffB[i] = (unsigned)(Rb * K + C) * 2u; }
    const size_t kstep = (size_t)(BK * 2);
    const size_t hstep = (size_t)HALF * K * 2;
    const size_t tstep = 2 * hstep;
    const unsigned ldsw = (unsigned)wid * 1024u;
    const int aoff = lds_byte(wr * 64 + fr, fq * 8), boff = lds_byte(wc * 32 + fr, fq * 8);
#define PG8_SA(b, h) (((b) * 2 + (h)) * HTB)
#define PG8_SB(b, h) ((4 + (b) * 2 + (h)) * HTB)
#define PG8_STAGE(bufoff, gbase, voff) do { _Pragma("unroll") for (int _i = 0; _i < 2; ++_i) \
        __builtin_amdgcn_global_load_lds((const unsigned*)((const char*)(gbase) + (voff)[_i]), (PG8_LAS unsigned*)(lds + (bufoff) + ldsw + _i * 8192), 16, 0, 0); } while (0)
#define PG8_LDA(dst, b, h) do { _Pragma("unroll") for (int m = 0; m < 4; ++m) _Pragma("unroll") for (int k = 0; k < 2; ++k) dst[m][k] = *(const PG8_LAS bf16x8*)(lds + PG8_SA(b, h) + aoff + m * 2048 + k * 1024); } while (0)
#define PG8_LDB(dst, b, h) do { _Pragma("unroll") for (int n = 0; n < 2; ++n) _Pragma("unroll") for (int k = 0; k < 2; ++k) dst[n][k] = *(const PG8_LAS bf16x8*)(lds + PG8_SB(b, h) + boff + n * 2048 + k * 1024); } while (0)
#define PG8_MMA(ai, bj, At, Bt) do { __builtin_amdgcn_s_setprio(1); _Pragma("unroll") for (int m = 0; m < 4; ++m) _Pragma("unroll") for (int n = 0; n < 2; ++n) _Pragma("unroll") for (int k = 0; k < 2; ++k) \
        acc[ai][bj][m][n] = __builtin_amdgcn_mfma_f32_16x16x32_bf16(Bt[n][k], At[m][k], acc[ai][bj][m][n], 0, 0, 0); __builtin_amdgcn_s_setprio(0); } while (0)
#define PG8_WAIT_V(n) asm volatile("s_waitcnt vmcnt(" #n ")" ::: "memory")
#define PG8_WAIT_L(n) asm volatile("s_waitcnt lgkmcnt(" #n ")" ::: "memory")
#define PG8_BAR __builtin_amdgcn_s_barrier()
#define PG8_SCHED __builtin_amdgcn_sched_barrier(0)
    Unit cur, nxt; int ui = 0;
    if (!S.next(0, cur)) return;
    f32x4 acc[2][2][4][2];
#pragma unroll
    for (int a = 0; a < 2; ++a)
#pragma unroll
        for (int b = 0; b < 2; ++b)
#pragma unroll
            for (int m = 0; m < 4; ++m)
#pragma unroll
                for (int n = 0; n < 2; ++n) acc[a][b][m][n] = (f32x4){0.f, 0.f, 0.f, 0.f};
    bf16x8 At[4][2], B0[2][2], B1[2][2];
    const char* cA = (const char*)g.A + (size_t)cur.pm * tstep; const char* cB = (const char*)g.Bt + (size_t)cur.pn * tstep;
    S.a_ready(cur);
    if constexpr (SP2) {
        PG8_STAGE(PG8_SB(0, 0), cB, voffB); PG8_STAGE(PG8_SB(0, 1), cB + hstep, voffB); PG8_STAGE(PG8_SA(0, 0), cA, voffA); PG8_STAGE(PG8_SA(0, 1), cA + hstep, voffA);
        if (wr == 1) PG8_BAR;
        PG8_WAIT_V(2); PG8_BAR;
        PG8_STAGE(PG8_SB(1, 0), cB + kstep, voffB); PG8_STAGE(PG8_SA(1, 0), cA + kstep, voffA); PG8_STAGE(PG8_SB(1, 1), cB + hstep + kstep, voffB);
        PG8_WAIT_V(6); PG8_BAR;
    } else {
        PG8_STAGE(PG8_SB(0, 0), cB, voffB); PG8_STAGE(PG8_SA(0, 0), cA, voffA); PG8_STAGE(PG8_SB(0, 1), cB + hstep, voffB); PG8_STAGE(PG8_SA(0, 1), cA + hstep, voffA);
        if (wr == 1) PG8_BAR;
        PG8_WAIT_V(4); PG8_BAR;
        PG8_STAGE(PG8_SB(1, 0), cB + kstep, voffB); PG8_STAGE(PG8_SA(1, 0), cA + kstep, voffA); PG8_STAGE(PG8_SB(1, 1), cB + hstep + kstep, voffB);
        PG8_WAIT_V(6); PG8_BAR;
    }
    for (;;) {
        const bool has_next = S.next(ui + 1, nxt);
        const char* nA = has_next ? (const char*)g.A + (size_t)nxt.pm * tstep : cA; const char* nB = has_next ? (const char*)g.Bt + (size_t)nxt.pn * tstep : cB;
        for (int t = 0; t < nt; t += 2) {
            const bool last = (t == nt - 2);
            const char* a1 = cA + (size_t)(t + 1) * kstep;
            const char* a2 = last ? nA : cA + (size_t)(t + 2) * kstep; const char* b2 = last ? nB : cB + (size_t)(t + 2) * kstep;
            const char* a3 = a2 + kstep; const char* b3 = b2 + kstep;
            if (last && has_next) S.a_ready(nxt);
            if constexpr (SP2) {
            PG8_LDB(B0, 0, 0); PG8_LDB(B1, 0, 1); PG8_SCHED; PG8_LDA(At, 0, 0); PG8_STAGE(PG8_SA(1, 1), a1 + hstep, voffA);
            PG8_WAIT_V(8); PG8_WAIT_L(0); PG8_BAR; PG8_MMA(0, 0, At, B0); PG8_MMA(0, 1, At, B1); PG8_BAR; PG8_SCHED;
            PG8_LDA(At, 0, 1); PG8_STAGE(PG8_SB(0, 0), b2, voffB); PG8_STAGE(PG8_SB(0, 1), b2 + hstep, voffB); PG8_STAGE(PG8_SA(0, 0), a2, voffA);
            PG8_WAIT_V(8); PG8_WAIT_L(0); PG8_BAR; PG8_MMA(1, 0, At, B0); PG8_MMA(1, 1, At, B1); PG8_BAR; PG8_SCHED;
            PG8_LDB(B0, 1, 0); PG8_LDB(B1, 1, 1); PG8_SCHED; PG8_LDA(At, 1, 0); PG8_STAGE(PG8_SA(0, 1), a2 + hstep, voffA);
            PG8_WAIT_V(8); PG8_WAIT_L(0); PG8_BAR; PG8_MMA(0, 0, At, B0); PG8_MMA(0, 1, At, B1); PG8_BAR; PG8_SCHED;
            PG8_LDA(At, 1, 1); PG8_STAGE(PG8_SB(1, 0), b3, voffB); PG8_STAGE(PG8_SB(1, 1), b3 + hstep, voffB); PG8_STAGE(PG8_SA(1, 0), a3, voffA);
            PG8_WAIT_V(8); PG8_WAIT_L(0); PG8_BAR; PG8_MMA(1, 0, At, B0); PG8_MMA(1, 1, At, B1); PG8_BAR; PG8_SCHED;
            } else {
            PG8_LDB(B0, 0, 0); PG8_SCHED; PG8_LDA(At, 0, 0); PG8_STAGE(PG8_SA(1, 1), a1 + hstep, voffA);
            PG8_WAIT_L(8); PG8_BAR; PG8_WAIT_L(0); PG8_MMA(0, 0, At, B0); PG8_BAR; PG8_SCHED;
            PG8_LDB(B1, 0, 1); PG8_STAGE(PG8_SB(0, 0), b2, voffB);
            PG8_BAR; PG8_WAIT_L(0); PG8_MMA(0, 1, At, B1); PG8_BAR;
            PG8_LDA(At, 0, 1); PG8_STAGE(PG8_SA(0, 0), a2, voffA);
            PG8_BAR; PG8_WAIT_L(0); PG8_MMA(1, 0, At, B0); PG8_BAR; PG8_SCHED;
            PG8_STAGE(PG8_SB(0, 1), b2 + hstep, voffB);
            PG8_WAIT_V(6); PG8_BAR; PG8_MMA(1, 1, At, B1); PG8_BAR;
            PG8_LDB(B0, 1, 0); PG8_SCHED; PG8_LDA(At, 1, 0); PG8_STAGE(PG8_SA(0, 1), a2 + hstep, voffA);
            PG8_WAIT_L(8); PG8_BAR; PG8_WAIT_L(0); PG8_MMA(0, 0, At, B0); PG8_BAR; PG8_SCHED;
            PG8_LDB(B1, 1, 1); PG8_STAGE(PG8_SB(1, 0), b3, voffB);
            PG8_BAR; PG8_WAIT_L(0); PG8_MMA(0, 1, At, B1); PG8_BAR;
            PG8_LDA(At, 1, 1); PG8_STAGE(PG8_SA(1, 0), a3, voffA);
            PG8_BAR; PG8_WAIT_L(0); PG8_MMA(1, 0, At, B0); PG8_BAR; PG8_SCHED;
            PG8_STAGE(PG8_SB(1, 1), b3 + hstep, voffB);
            PG8_WAIT_V(6); PG8_BAR; PG8_MMA(1, 1, At, B1); PG8_BAR;
            }
        }
        if constexpr (ALIGN_EPI) { if (wr == 0) PG8_BAR; }
        if constexpr (!Epi::AFTER_DRAIN) { E(acc, cur, wr, wc, fr, fq); S.done(cur); }
        if (!has_next) break;
#pragma unroll
        for (int a = 0; a < 2; ++a)
#pragma unroll
            for (int b = 0; b < 2; ++b)
#pragma unroll
                for (int m = 0; m < 4; ++m)
#pragma unroll
                    for (int n = 0; n < 2; ++n) acc[a][b][m][n] = (f32x4){0.f, 0.f, 0.f, 0.f};
        cur = nxt; cA = nA; cB = nB; ++ui;
        if constexpr (ALIGN_EPI) { if (wr == 1) PG8_BAR; }
    }
    PG8_WAIT_V(0);
    if constexpr (!ALIGN_EPI) { if (wr == 0) PG8_BAR; }
    PG8_BAR;
    if constexpr (Epi::AFTER_DRAIN) { E.fused(acc, cur, wr, wc, fr, fq, lds, wid, lane); S.done(cur); }
#undef PG8_SA
#undef PG8_SB
#undef PG8_STAGE
#undef PG8_LDA
#undef PG8_LDB
#undef PG8_MMA
#undef PG8_WAIT_V
#undef PG8_WAIT_L
#undef PG8_BAR
#undef PG8_SCHED
}
}


enum { PH_MOD, PH_PRO_SMALL, PH_CONVSTATE, PH_PRO_TAB };

template <int PH> DEVI void run_phase(const P& p, int l, long gtid, long gsz) {
    if constexpr (PH == PH_MOD) {
    } else if constexpr (PH == PH_PRO_SMALL) {
        for (long i = gtid; i < (long)DEPTH * 12 * D; i += gsz) {
            const int k = (int)(i % D), j = (int)((i / D) % 12), ll = (int)(i / (12 * D));
            p.wsmall()[i] = inp(13)[((size_t)ll * D + k) * DPROJ + (j < 8 ? S_DT + j : S_F + (j - 8))];
        }
    } else if constexpr (PH == PH_CONVSTATE) {
        for (long i = gtid; i < (long)NSEQ * 3 * CONVC; i += gsz) {
            const int c = (int)(i % CONVC), j = (int)((i / CONVC) % 3), s = (int)(i / (3 * CONVC));
            const int rlast = s < NB_P ? (s + 1) * T_P - 1 : M_P + (s - NB_P + 1) * T_S - 1;
            const float v = PROJ(rlast - 2 + j, O_XBC + c);
            if (s < NB_P) p.out[OUT_CONVP + (((size_t)l * NB_P + s) * 3 + j) * CONVC + c] = v;
            else p.out[OUT_CONVS + (((size_t)l * NB_S + (s - NB_P)) * 3 + j) * CONVC + c] = v;
        }
    } else if constexpr (PH == PH_PRO_TAB) {
        const float* ks = inp(27); uint4* kd = (uint4*)p.keysb();
        const long NK = (long)DEPTH * 16 * 128 * 128 / 8;
        for (long i = gtid; i < NK; i += gsz) {
            const float* src = ks + i * 8;
            const float4 a = *(const float4*)src, b = *(const float4*)(src + 4);
            uint4 o; o.x = (unsigned)f2bf(a.x) | ((unsigned)f2bf(a.y) << 16); o.y = (unsigned)f2bf(a.z) | ((unsigned)f2bf(a.w) << 16);
            o.z = (unsigned)f2bf(b.x) | ((unsigned)f2bf(b.y) << 16); o.w = (unsigned)f2bf(b.z) | ((unsigned)f2bf(b.w) << 16);
            kd[i] = o;
        }
    }
}
#define XB_TMO      128
#define XB_XCNT(j)  (256  + 64 * (j))
#define XB_XSUB(j)  (1280 + 64 * (j))
#define XB_XGEN(j)  (2304 + 64 * (j))
#define XB_TOP      3328
#define XB_TOPGEN   3392
#define XCD_BAR_WORDS 3456
#define XB_SPIN_CAP (1u << 18)
#define LAS __attribute__((address_space(3)))

__device__ __forceinline__ unsigned xb_ld(unsigned* p)              { return __hip_atomic_load(p, __ATOMIC_RELAXED, __HIP_MEMORY_SCOPE_AGENT); }
__device__ __forceinline__ unsigned xb_add(unsigned* p, unsigned v) { return __hip_atomic_fetch_add(p, v, __ATOMIC_RELAXED, __HIP_MEMORY_SCOPE_AGENT); }
__device__ __forceinline__ unsigned xb_xcc_id() { return (unsigned)__builtin_amdgcn_s_getreg((3 << 11) | 20) & 0xFu; }
#define XB_SPIN(cond, bar) do { unsigned _sp = 0; while (cond) { __builtin_amdgcn_s_sleep(1); \
    if ((++_sp & 255u) == 0u) { if (xb_ld(&(bar)[XB_TMO])) break; if (_sp > XB_SPIN_CAP) { atomicAdd(&(bar)[XB_TMO], 1u); break; } } } } while (0)

struct XcdBarrier { unsigned* bar; unsigned x; volatile LAS unsigned* st; };

__device__ __forceinline__ XcdBarrier xcd_barrier_post(unsigned* bar, volatile LAS unsigned* st) {
    XcdBarrier b; b.bar = bar; b.x = xb_xcc_id(); b.st = st;
    if (threadIdx.x == 0) (void)xb_add(&bar[XB_XCNT(b.x)], 1u);
    return b;
}
__device__ __forceinline__ void xcd_barrier_complete(unsigned* bar, unsigned x, unsigned& nloc, unsigned& nx) {
    const unsigned G = gridDim.x * gridDim.y * gridDim.z;
    unsigned sum, cnt, mine, sp = 0u;
    for (;;) {
        sum = 0u; cnt = 0u; mine = 0u;
#pragma unroll
        for (unsigned j = 0; j < 16; ++j) { const unsigned c = xb_ld(&bar[XB_XCNT(j)]); sum += c; cnt += (c > 0u) ? 1u : 0u; mine = (j == x) ? c : mine; }
        if (sum == G) break;
        __builtin_amdgcn_s_sleep(1);
        if ((++sp & 255u) == 0u) { if (xb_ld(&bar[XB_TMO])) break; if (sp > XB_SPIN_CAP) { atomicAdd(&bar[XB_TMO], 1u); break; } }
    }
    nloc = mine > 0u ? mine : 1u; nx = cnt > 0u ? cnt : 1u;
}
__device__ __forceinline__ void xcd_barrier(const XcdBarrier& b) {
    asm volatile("s_waitcnt vmcnt(0)" ::: "memory");
    __syncthreads();
    if (threadIdx.x == 0) {
        unsigned* bar = b.bar;
        __builtin_amdgcn_s_waitcnt(0);
        unsigned nloc = b.st[0], nx = b.st[1];
        if (nloc == 0u) { xcd_barrier_complete(bar, b.x, nloc, nx); b.st[0] = nloc; b.st[1] = nx; }
        const unsigned old = xb_add(&bar[XB_XSUB(b.x)], 1u);
        const unsigned gen = old / nloc;
        if (old + 1u == (gen + 1u) * nloc) {
            __builtin_amdgcn_fence(__ATOMIC_RELEASE, "agent");
            asm volatile("s_waitcnt vmcnt(0)" ::: "memory");
            const unsigned og = xb_add(&bar[XB_TOP], 1u);
            const unsigned tg = og / nx;
            if (og + 1u == (tg + 1u) * nx) xb_add(&bar[XB_TOPGEN], 1u);
            else XB_SPIN(xb_ld(&bar[XB_TOPGEN]) == tg, bar);
            __builtin_amdgcn_fence(__ATOMIC_ACQUIRE, "agent");
            xb_add(&bar[XB_XGEN(b.x)], 1u);
            asm volatile("s_waitcnt vmcnt(0)" ::: "memory");
        } else {
            XB_SPIN(xb_ld(&bar[XB_XGEN(b.x)]) == gen, bar);
            __builtin_amdgcn_fence(__ATOMIC_ACQUIRE, "agent");
            asm volatile("s_waitcnt vmcnt(0)" ::: "memory");
        }
    }
    __syncthreads();
}

typedef short bf16x8_t __attribute__((ext_vector_type(8)));
typedef float f32x4_t __attribute__((ext_vector_type(4)));
typedef float f32x16_t __attribute__((ext_vector_type(16)));
typedef unsigned u32x4_t __attribute__((ext_vector_type(4)));
typedef unsigned u32x2_t __attribute__((ext_vector_type(2)));
typedef float f32x2_t __attribute__((ext_vector_type(2)));

DEVI unsigned mono_u(float f) { const unsigned u = __float_as_uint(f); return u ^ ((unsigned)((int)u >> 31) | 0x80000000u); }
DEVI float unmono_f(unsigned m) { return __uint_as_float((m & 0x80000000u) ? (m ^ 0x80000000u) : ~m); }
DEVI unsigned umax_(unsigned a, unsigned b) { return a > b ? a : b; }
DEVI unsigned umin_(unsigned a, unsigned b) { return a < b ? a : b; }

#define CE_(x_, y_) do { const unsigned mx_ = umax_(x_, y_), mn_ = umin_(x_, y_); x_ = mx_; y_ = mn_; } while (0)
DEVI void sort16_desc(unsigned (&v)[16]) {
    CE_(v[0], v[1]); CE_(v[3], v[2]); CE_(v[4], v[5]); CE_(v[7], v[6]); CE_(v[8], v[9]); CE_(v[11], v[10]); CE_(v[12], v[13]); CE_(v[15], v[14]);
    CE_(v[0], v[2]); CE_(v[1], v[3]); CE_(v[6], v[4]); CE_(v[7], v[5]); CE_(v[8], v[10]); CE_(v[9], v[11]); CE_(v[14], v[12]); CE_(v[15], v[13]);
    CE_(v[0], v[1]); CE_(v[2], v[3]); CE_(v[5], v[4]); CE_(v[7], v[6]); CE_(v[8], v[9]); CE_(v[10], v[11]); CE_(v[13], v[12]); CE_(v[15], v[14]);
    CE_(v[0], v[4]); CE_(v[1], v[5]); CE_(v[2], v[6]); CE_(v[3], v[7]); CE_(v[12], v[8]); CE_(v[13], v[9]); CE_(v[14], v[10]); CE_(v[15], v[11]);
    CE_(v[0], v[2]); CE_(v[1], v[3]); CE_(v[4], v[6]); CE_(v[5], v[7]); CE_(v[10], v[8]); CE_(v[11], v[9]); CE_(v[14], v[12]); CE_(v[15], v[13]);
    CE_(v[0], v[1]); CE_(v[2], v[3]); CE_(v[4], v[5]); CE_(v[6], v[7]); CE_(v[9], v[8]); CE_(v[11], v[10]); CE_(v[13], v[12]); CE_(v[15], v[14]);
    CE_(v[0], v[8]); CE_(v[1], v[9]); CE_(v[2], v[10]); CE_(v[3], v[11]); CE_(v[4], v[12]); CE_(v[5], v[13]); CE_(v[6], v[14]); CE_(v[7], v[15]);
    CE_(v[0], v[4]); CE_(v[1], v[5]); CE_(v[2], v[6]); CE_(v[3], v[7]); CE_(v[8], v[12]); CE_(v[9], v[13]); CE_(v[10], v[14]); CE_(v[11], v[15]);
    CE_(v[0], v[2]); CE_(v[1], v[3]); CE_(v[4], v[6]); CE_(v[5], v[7]); CE_(v[8], v[10]); CE_(v[9], v[11]); CE_(v[12], v[14]); CE_(v[13], v[15]);
    CE_(v[0], v[1]); CE_(v[2], v[3]); CE_(v[4], v[5]); CE_(v[6], v[7]); CE_(v[8], v[9]); CE_(v[10], v[11]); CE_(v[12], v[13]); CE_(v[14], v[15]);
}
DEVI void merge16_desc(unsigned (&a)[16], const unsigned (&b)[16]) {
    a[0] = umax_(a[0], b[15]); a[1] = umax_(a[1], b[14]); a[2] = umax_(a[2], b[13]); a[3] = umax_(a[3], b[12]); a[4] = umax_(a[4], b[11]); a[5] = umax_(a[5], b[10]); a[6] = umax_(a[6], b[9]); a[7] = umax_(a[7], b[8]); a[8] = umax_(a[8], b[7]); a[9] = umax_(a[9], b[6]); a[10] = umax_(a[10], b[5]); a[11] = umax_(a[11], b[4]); a[12] = umax_(a[12], b[3]); a[13] = umax_(a[13], b[2]); a[14] = umax_(a[14], b[1]); a[15] = umax_(a[15], b[0]);
    CE_(a[0], a[8]); CE_(a[1], a[9]); CE_(a[2], a[10]); CE_(a[3], a[11]); CE_(a[4], a[12]); CE_(a[5], a[13]); CE_(a[6], a[14]); CE_(a[7], a[15]);
    CE_(a[0], a[4]); CE_(a[1], a[5]); CE_(a[2], a[6]); CE_(a[3], a[7]); CE_(a[8], a[12]); CE_(a[9], a[13]); CE_(a[10], a[14]); CE_(a[11], a[15]);
    CE_(a[0], a[2]); CE_(a[1], a[3]); CE_(a[4], a[6]); CE_(a[5], a[7]); CE_(a[8], a[10]); CE_(a[9], a[11]); CE_(a[12], a[14]); CE_(a[13], a[15]);
    CE_(a[0], a[1]); CE_(a[2], a[3]); CE_(a[4], a[5]); CE_(a[6], a[7]); CE_(a[8], a[9]); CE_(a[10], a[11]); CE_(a[12], a[13]); CE_(a[14], a[15]);
}

DEVI void peer_topk_unit(const bf16_t* pq, const bf16_t* keysb, int* eidx, float* gwv, int r0, int wave, int lane, LAS unsigned char* wl  ) {
    const int col = lane & 31, h = lane >> 5; const int r = r0 + col;
    unsigned S[2][16];
    bf16x8_t bq[8], acur[8], anxt[8];
    { const bf16_t* qp = pq + (size_t)r * 2048 + (wave * 2) * 128 + 8 * h;
#pragma unroll
      for (int s = 0; s < 8; ++s) bq[s] = *(const bf16x8_t*)(qp + s * 16);
      const bf16_t* kp = keysb + ((size_t)((wave * 2) * 128 + col) * 128 + 8 * h);
#pragma unroll
      for (int s = 0; s < 8; ++s) acur[s] = *(const bf16x8_t*)(kp + s * 16); }
    unsigned run[16];
#pragma unroll
    for (int blkid = 0; blkid < 8; ++blkid) {
        const int half = blkid >> 2, kb = blkid & 3, hh2 = wave * 2 + half;
        if (blkid + 1 < 8) { const int nh = (blkid + 1) >> 2, nkb = (blkid + 1) & 3; const bf16_t* kp = keysb + ((size_t)((wave * 2 + nh) * 128 + nkb * 32 + col) * 128 + 8 * h);
#pragma unroll
            for (int s = 0; s < 8; ++s) anxt[s] = *(const bf16x8_t*)(kp + s * 16); }
        f32x16_t d = {0.f, 0.f, 0.f, 0.f, 0.f, 0.f, 0.f, 0.f, 0.f, 0.f, 0.f, 0.f, 0.f, 0.f, 0.f, 0.f};
#pragma unroll
        for (int s = 0; s < 8; ++s) d = __builtin_amdgcn_mfma_f32_32x32x16_bf16(acur[s], bq[s], d, 0, 0, 0);
        if (blkid == 3) { const bf16_t* qp = pq + (size_t)r * 2048 + (wave * 2 + 1) * 128 + 8 * h;
#pragma unroll
            for (int s = 0; s < 8; ++s) bq[s] = *(const bf16x8_t*)(qp + s * 16); }
        unsigned blk[16];
#pragma unroll
        for (int g = 0; g < 16; ++g) { const int kidx = kb * 32 + (g & 3) + 8 * (g >> 2) + 4 * h; blk[g] = (mono_u(d[g]) & ~127u) | (unsigned)(127 - kidx); }
        sort16_desc(blk);
        if (kb == 0) {
#pragma unroll
            for (int i = 0; i < 16; ++i) run[i] = blk[i];
        } else merge16_desc(run, blk);
        if (kb == 3) {
            unsigned oth[16];
#pragma unroll
            for (int i = 0; i < 16; ++i) oth[i] = (unsigned)__shfl_xor((int)run[i], 32);
            merge16_desc(run, oth);
#pragma unroll
            for (int i = 0; i < 16; ++i) S[half][i] = run[i];
        }
#pragma unroll
        for (int s = 0; s < 8; ++s) acur[s] = anxt[s];
        __builtin_amdgcn_sched_barrier(0);
        (void)hh2;
    }
    {
        unsigned w0[4], w1[4];
#pragma unroll
        for (int q = 0; q < 4; ++q) { w0[q] = 0u; w1[q] = 0u;
#pragma unroll
            for (int b = 0; b < 4; ++b) { w0[q] |= (127u - (S[0][q * 4 + b] & 127u)) << (8 * b); w1[q] |= (127u - (S[1][q * 4 + b] & 127u)) << (8 * b); } }
        if (h == 0) { LAS u32x4_t* dst = (LAS u32x4_t*)(wl + col * 32); dst[0] = (u32x4_t){w0[0], w0[1], w0[2], w0[3]}; dst[1] = (u32x4_t){w1[0], w1[1], w1[2], w1[3]}; }
    }
    __builtin_amdgcn_sched_barrier(0);
    float T0[16], T1[16];
#pragma unroll
    for (int i = 0; i < 16; ++i) { const unsigned u0 = S[0][i] & ~127u, u1 = S[1][i] & ~127u; T0[i] = unmono_f(h ? u1 : u0); T1[i] = unmono_f(h ? u0 : u1); }
    __builtin_amdgcn_sched_barrier(0);
    unsigned ca[16], cb2[16];
#define MKC(a_, b_) ((mono_u(T0[a_] + T1[b_]) & ~255u) | (255u - (h ? (unsigned)((b_) * 16 + (a_)) : (unsigned)((a_) * 16 + (b_)))))
    ca[0] = MKC(0, 1);
    ca[1] = MKC(0, 2);
    ca[2] = MKC(0, 3);
    ca[3] = MKC(0, 4);
    ca[4] = MKC(0, 5);
    ca[5] = MKC(0, 6);
    ca[6] = MKC(0, 7);
    ca[7] = MKC(0, 8);
    ca[8] = MKC(0, 9);
    ca[9] = MKC(0, 10);
    ca[10] = MKC(0, 11);
    ca[11] = MKC(0, 12);
    ca[12] = MKC(0, 13);
    ca[13] = MKC(0, 14);
    ca[14] = MKC(0, 15);
    ca[15] = h ? 0u : MKC(0, 0);
    cb2[0] = MKC(1, 2);
    cb2[1] = MKC(1, 3);
    cb2[2] = MKC(1, 4);
    cb2[3] = MKC(1, 5);
    cb2[4] = MKC(1, 6);
    cb2[5] = MKC(1, 7);
    cb2[6] = MKC(2, 3);
    cb2[7] = MKC(2, 4);
    cb2[8] = h ? 0u : MKC(1, 1);
    cb2[9] = h ? 0u : MKC(2, 2);
    cb2[10] = h ? 0u : MKC(3, 3);
    cb2[11] = 0u;
    cb2[12] = 0u;
    cb2[13] = 0u;
    cb2[14] = 0u;
    cb2[15] = 0u;
#undef MKC
    sort16_desc(ca); sort16_desc(cb2); merge16_desc(ca, cb2);
    {
        unsigned oth[16];
#pragma unroll
        for (int i = 0; i < 16; ++i) oth[i] = (unsigned)__shfl_xor((int)ca[i], 32);
        merge16_desc(ca, oth);
    }
    float e[16]; float sum = 0.f; const float s0 = unmono_f(ca[0] & ~255u);
#pragma unroll
    for (int j = 0; j < 16; ++j) { e[j] = __expf(unmono_f(ca[j] & ~255u) - s0); sum += e[j]; }
    const float inv = 1.f / sum;
    const LAS unsigned char* lb = wl + col * 32;
    int ex[8]; float gx[8]; const unsigned hm = h ? 0xffffffffu : 0u;
#pragma unroll
    for (int jj = 0; jj < 8; ++jj) {
        const unsigned kj = ca[jj] ^ ((ca[jj] ^ ca[8 + jj]) & hm); const float ej = __uint_as_float(__float_as_uint(e[jj]) ^ ((__float_as_uint(e[jj]) ^ __float_as_uint(e[8 + jj])) & hm));
        const unsigned pos = 255u - (kj & 255u); const int i0 = lb[pos >> 4], i1 = lb[16 + (pos & 15u)];
        ex[jj] = i0 * 128 + i1; gx[jj] = ej * inv;
    }
    int* ep = eidx + (size_t)r * 128 + wave * 16 + 8 * h; float* gp = gwv + (size_t)r * 128 + wave * 16 + 8 * h;
    *(int4*)ep = make_int4(ex[0], ex[1], ex[2], ex[3]); *(int4*)(ep + 4) = make_int4(ex[4], ex[5], ex[6], ex[7]);
    *(float4*)gp = make_float4(gx[0], gx[1], gx[2], gx[3]); *(float4*)(gp + 4) = make_float4(gx[4], gx[5], gx[6], gx[7]);
}

DEVI void adaln_apply_1(const P& p, int l, int r, int lane, float (&v)[16]);
DEVI unsigned pk4fp8(float a, float b, float c, float d) { int w = 0; w = __builtin_amdgcn_cvt_pk_fp8_f32(a, b, w, false); w = __builtin_amdgcn_cvt_pk_fp8_f32(c, d, w, true); return (unsigned)w; }
DEVI void peer_tables_fp8(const P& p, int ll  , int rbeg, int rend, int gw, int NGW, int lane) {
    const float* us = inp(28) + (size_t)ll * NEXP * D; const float* vs = inp(29) + (size_t)ll * NEXP * D;
    for (int R0 = rbeg + gw * 4; R0 < rend; R0 += NGW * 4) {
        float4 v[4][4]; float am[4];
#pragma unroll
        for (int q = 0; q < 4; ++q) { const int R = R0 + q, tb = R >= NEXP, row = R - tb * NEXP;
            const float4* src = (const float4*)((tb ? vs : us) + (size_t)row * D) + lane;
#pragma unroll
            for (int j = 0; j < 4; ++j) v[q][j] = src[64 * j]; }
#pragma unroll
        for (int q = 0; q < 4; ++q) { float a_ = 0.f;
#pragma unroll
            for (int j = 0; j < 4; ++j) a_ = fmaxf(a_, fmaxf(fmaxf(fabsf(v[q][j].x), fabsf(v[q][j].y)), fmaxf(fabsf(v[q][j].z), fabsf(v[q][j].w))));
#pragma unroll
            for (int o = 1; o < 64; o <<= 1) a_ = fmaxf(a_, __shfl_xor(a_, o));
            am[q] = a_; }
#pragma unroll
        for (int q = 0; q < 4; ++q) { const int R = R0 + q, tb = R >= NEXP, row = ll * NEXP + (R - tb * NEXP);
            const float sc = am[q] > 0.f ? 440.f / am[q] : 1.f;
            unsigned* dst = (unsigned*)((tb ? p.v8() : p.u8()) + (size_t)row * D) + lane;
#pragma unroll
            for (int j = 0; j < 4; ++j) dst[64 * j] = pk4fp8(v[q][j].x * sc, v[q][j].y * sc, v[q][j].z * sc, v[q][j].w * sc);
            if (lane == 0) p.sinv()[(size_t)tb * DEPTH * NEXP + row] = am[q] > 0.f ? am[q] * (1.f / 440.f) : 1.f; }
    }
}

template <int NTL> DEVI void peer_gather_token_t(const P& p, int l, int tbase, int half, LAS float* xch, const unsigned char* u8, const unsigned char* v8, const float* su, const float* sv, const unsigned char* h8, const int* eidx, const float* gwv, float* x,
                            const float* gate2  , int r, int lane, LAS unsigned char* wl) {
    const int n16 = lane & 15, kq = lane >> 4;
    int e[NTL]; float g[NTL], s_u[NTL], s_v[NTL];
#pragma unroll
    for (int t = 0; t < NTL; ++t) { e[t] = eidx[(size_t)r * 128 + (tbase + t) * 16 + n16]; g[t] = gwv[(size_t)r * 128 + (tbase + t) * 16 + n16]; }
#pragma unroll
    for (int t = 0; t < NTL; ++t) { s_u[t] = su[e[t]]; s_v[t] = sv[e[t]]; }
    const unsigned char* up[NTL];
#pragma unroll
    for (int t = 0; t < NTL; ++t) up[t] = u8 + (size_t)e[t] * D + kq * 16;
    const unsigned char* hp = h8 + (n16 < 8 ? (size_t)0 : (size_t)M * D) + (size_t)r * D + kq * 16;
    f32x4_t acc[NTL];
#pragma unroll
    for (int t = 0; t < NTL; ++t) acc[t] = (f32x4_t){0.f, 0.f, 0.f, 0.f};
    u32x4_t b0[NTL], b1[NTL];
#pragma unroll
    for (int t = 0; t < NTL; ++t) { b0[t] = *(const u32x4_t*)(up[t]); b1[t] = *(const u32x4_t*)(up[t] + 64); }
#define FP8MM(av, bv, c) do { const long al_ = (long)(((unsigned long long)(av).y << 32) | (av).x), ah_ = (long)(((unsigned long long)(av).w << 32) | (av).z); \
        const long bl_ = (long)(((unsigned long long)(bv).y << 32) | (bv).x), bh_ = (long)(((unsigned long long)(bv).w << 32) | (bv).z); \
        c = __builtin_amdgcn_mfma_f32_16x16x32_fp8_fp8(al_, bl_, c, 0, 0, 0); c = __builtin_amdgcn_mfma_f32_16x16x32_fp8_fp8(ah_, bh_, c, 0, 0, 0); } while (0)
    for (int m = 0; m < 16; m += 2) {
        const u32x4_t a0 = *(const u32x4_t*)(hp + m * 64), a1 = *(const u32x4_t*)(hp + m * 64 + 64);
#pragma unroll
        for (int t = 0; t < NTL; ++t) FP8MM(a0, b0[t], acc[t]);
        if (m + 2 < 16) {
#pragma unroll
            for (int t = 0; t < NTL; ++t) b0[t] = *(const u32x4_t*)(up[t] + (m + 2) * 64);
        }
#pragma unroll
        for (int t = 0; t < NTL; ++t) FP8MM(a1, b1[t], acc[t]);
        if (m + 3 < 16) {
#pragma unroll
            for (int t = 0; t < NTL; ++t) b1[t] = *(const u32x4_t*)(up[t] + (m + 3) * 64);
        }
    }
#undef FP8MM
    LAS u32x2_t* pl = (LAS u32x2_t*)wl;
#pragma unroll
    for (int t = 0; t < NTL; ++t) { const float lo = __shfl_xor(acc[t][0], 32); const float dot = (acc[t][0] + lo * (1.f / 32.f)) * s_u[t];
        if (kq == 0) pl[t * 16 + n16] = (u32x2_t){(unsigned)e[t], __float_as_uint(g[t] * gelu_f(dot) * s_v[t])}; }
    float o[16];
#pragma unroll
    for (int i = 0; i < 16; ++i) o[i] = 0.f;
    for (int j0 = 0; j0 < NTL * 16; j0 += 16) {
        u32x4_t w[16]; float cj[16];
#pragma unroll
        for (int jj = 0; jj < 16; ++jj) { const u32x2_t pr = pl[j0 + jj]; const int ej = __builtin_amdgcn_readfirstlane((int)pr.x); cj[jj] = __uint_as_float(pr.y);
            w[jj] = *(const u32x4_t*)(v8 + (size_t)ej * D + 16 * lane); }
#pragma unroll
        for (int jj = 0; jj < 16; ++jj) { const float c = cj[jj];
#pragma unroll
            for (int q = 0; q < 4; ++q) { const f32x2_t lo = __builtin_amdgcn_cvt_pk_f32_fp8((int)w[jj][q], false), hi = __builtin_amdgcn_cvt_pk_f32_fp8((int)w[jj][q], true);
                o[4 * q] += c * lo[0]; o[4 * q + 1] += c * lo[1]; o[4 * q + 2] += c * hi[0]; o[4 * q + 3] += c * hi[1]; } }
    }
    if (NTL < 8) {
        if (half == 1) {
#pragma unroll
            for (int q = 0; q < 4; ++q) *(LAS f32x4_t*)(xch + lane * 16 + 4 * q) = (f32x4_t){o[4 * q], o[4 * q + 1], o[4 * q + 2], o[4 * q + 3]};
        }
        __syncthreads();
        if (half == 1) return;
#pragma unroll
        for (int q = 0; q < 4; ++q) { const f32x4_t t4 = *(const LAS f32x4_t*)(xch + lane * 16 + 4 * q); o[4 * q] += t4[0]; o[4 * q + 1] += t4[1]; o[4 * q + 2] += t4[2]; o[4 * q + 3] += t4[3]; }
    }
    const float* gp = gate2 + (size_t)row_seq(r) * 6144 + 16 * lane;
    float* xp = x + (size_t)r * D + 16 * lane;
#pragma unroll
    for (int q = 0; q < 4; ++q) {
        float4 xa = *(const float4*)(xp + 4 * q); const float4 ga = *(const float4*)(gp + 4 * q);
        xa.x += ga.x * o[4 * q]; xa.y += ga.y * o[4 * q + 1]; xa.z += ga.z * o[4 * q + 2]; xa.w += ga.w * o[4 * q + 3];
        *(float4*)(xp + 4 * q) = xa;
        o[4 * q] = xa.x; o[4 * q + 1] = xa.y; o[4 * q + 2] = xa.z; o[4 * q + 3] = xa.w;
    }
    __builtin_amdgcn_sched_barrier(0);
    if (l + 1 < DEPTH) adaln_apply_1(p, l + 1, r, lane, o);
}


DEVI float wave_sum(float v) {
#pragma unroll
    for (int o = 1; o < 64; o <<= 1) v += __shfl_xor(v, o);
    return v;
}
DEVI float wave_incl_scan(float v, int lane) {
#pragma unroll
    for (int o = 1; o < 64; o <<= 1) { const float t = __shfl_up(v, o); if (lane >= o) v += t; }
    return v;
}
template <int WHICH> DEVI void adaln_apply(const P& p, int l, int r, int lane_in, float (&v)[16]) {
    int lane = lane_in; asm volatile("" : "+v"(lane));
    const float* g = inp(WHICH == 1 ? 9 : 10) + (size_t)l * D + 16 * lane;
    const int osh = (WHICH == 1 ? 0 : 3) * D, osc = (WHICH == 1 ? 1 : 4) * D;
    float ss = 0.f;
#pragma unroll
    for (int i = 0; i < 16; ++i) ss += v[i] * v[i];
    const float rstd = rsqrtf(wave_sum(ss) * (1.f / D) + EPS);
    const float* md = p.mod() + ((size_t)l * NSEQ + row_seq(r)) * 6144 + 16 * lane;
#pragma unroll
    for (int q = 0; q < 4; ++q) {
        const float4 gg = *(const float4*)(g + 4 * q), sc = *(const float4*)(md + osc + 4 * q), sh = *(const float4*)(md + osh + 4 * q);
        v[4 * q] = v[4 * q] * rstd * gg.x * (1.f + sc.x) + sh.x; v[4 * q + 1] = v[4 * q + 1] * rstd * gg.y * (1.f + sc.y) + sh.y;
        v[4 * q + 2] = v[4 * q + 2] * rstd * gg.z * (1.f + sc.z) + sh.z; v[4 * q + 3] = v[4 * q + 3] * rstd * gg.w * (1.f + sc.w) + sh.w;
    }
    u32x4_t* ob = (u32x4_t*)(p.hb() + (size_t)r * D + 16 * lane);
    ob[0] = (u32x4_t){pk2bf(v[0], v[1]), pk2bf(v[2], v[3]), pk2bf(v[4], v[5]), pk2bf(v[6], v[7])};
    ob[1] = (u32x4_t){pk2bf(v[8], v[9]), pk2bf(v[10], v[11]), pk2bf(v[12], v[13]), pk2bf(v[14], v[15])};
    if constexpr (WHICH == 2) {
        unsigned hi8[4], lo8[4];
#pragma unroll
        for (int q = 0; q < 4; ++q) { hi8[q] = pk4fp8(v[4 * q], v[4 * q + 1], v[4 * q + 2], v[4 * q + 3]);
            const f32x2_t h01 = __builtin_amdgcn_cvt_pk_f32_fp8((int)hi8[q], false), h23 = __builtin_amdgcn_cvt_pk_f32_fp8((int)hi8[q], true);
            lo8[q] = pk4fp8((v[4 * q] - h01[0]) * 32.f, (v[4 * q + 1] - h01[1]) * 32.f, (v[4 * q + 2] - h23[0]) * 32.f, (v[4 * q + 3] - h23[1]) * 32.f); }
        *(u32x4_t*)(p.h8() + (size_t)r * D + 16 * lane) = (u32x4_t){hi8[0], hi8[1], hi8[2], hi8[3]};
        *(u32x4_t*)(p.h8() + (size_t)M * D + (size_t)r * D + 16 * lane) = (u32x4_t){lo8[0], lo8[1], lo8[2], lo8[3]};
    }
    if constexpr (WHICH == 1) {
        const float* dtb = inp(16) + l * 8; const float* fb = inp(22) + l * 4;
        const float* ws = p.wsmall() + (size_t)l * 12 * D + 16 * lane;
        float dot[12];
#pragma unroll
        for (int jj = 0; jj < 12; ++jj) { float a = 0.f;
#pragma unroll
            for (int q = 0; q < 4; ++q) { const float4 w = *(const float4*)(ws + (size_t)jj * D + 4 * q); a += v[4 * q] * w.x + v[4 * q + 1] * w.y + v[4 * q + 2] * w.z + v[4 * q + 3] * w.w; }
            dot[jj] = wave_sum(a); }
        if (lane < 8) {
            float d = dot[0];
#pragma unroll
            for (int jj = 1; jj < 8; ++jj) d = (lane == jj) ? dot[jj] : d;
            p.dt()[(size_t)r * 8 + lane] = softplus_f(d + dtb[lane]);
        } else if (lane < 12) {
            const int hd = lane - 8; float d = dot[8];
#pragma unroll
            for (int jj = 9; jj < 12; ++jj) d = (lane == jj) ? dot[jj] : d;
            const float lf = -softplus_f(-(d + fb[hd]));
            p.logf()[(size_t)r * 4 + hd] = lf;
            if (r < M_P) p.out[OUT_LFP + ((size_t)l * M_P + r) * 4 + hd] = lf; else p.out[OUT_LFS + ((size_t)l * M_S + (r - M_P)) * 4 + hd] = lf;
        }
    }
}
template <int WHICH> DEVI void adaln_rows(const P& p, int l, int gw, int NGW, int lane, bool from_inputs = false) {
    const float* xp_ = from_inputs ? inp(0) : p.x(); const float* xs_ = from_inputs ? inp(1) - (size_t)M_P * D : p.x();
    float4 nx[4];
    if (gw < M) {
#pragma unroll
        for (int q = 0; q < 4; ++q) nx[q] = ((const float4*)((gw < M_P ? xp_ : xs_) + (size_t)gw * D + 16 * lane))[q]; }
    for (int r = gw; r < M; r += NGW) {
        float v[16];
#pragma unroll
        for (int q = 0; q < 4; ++q) { v[4 * q] = nx[q].x; v[4 * q + 1] = nx[q].y; v[4 * q + 2] = nx[q].z; v[4 * q + 3] = nx[q].w; }
        if (r + NGW < M) { const int rn = r + NGW;
#pragma unroll
            for (int q = 0; q < 4; ++q) nx[q] = ((const float4*)((rn < M_P ? xp_ : xs_) + (size_t)rn * D + 16 * lane))[q]; }
        adaln_apply<WHICH>(p, l, r, lane, v);
    }
}
DEVI void scan_chunks(const P& p, int l, int gw, int NGW, int lane) {
    const float* alog = inp(17) + l * 8; const float* clf = inp(6) + (size_t)l * NB_S * PAST * 4;
    for (int ci = gw; ci < NCHUNK + NB_S * 64; ci += NGW) {
        if (ci < NCHUNK) {
            const size_t r = (size_t)ci * 64 + lane;
            const float4 d0 = *(const float4*)(p.dt() + r * 8), d1 = *(const float4*)(p.dt() + r * 8 + 4);
            float a[8] = {d0.x, d0.y, d0.z, d0.w, d1.x, d1.y, d1.z, d1.w};
#pragma unroll
            for (int hh = 0; hh < 8; ++hh) a[hh] = wave_incl_scan(a[hh] * -__expf(alog[hh]), lane);
            *(float4*)(p.acum() + r * 8) = make_float4(a[0], a[1], a[2], a[3]); *(float4*)(p.acum() + r * 8 + 4) = make_float4(a[4], a[5], a[6], a[7]);
            const float4 lf = *(const float4*)(p.logf() + r * 4);
            float f[4] = {lf.x, lf.y, lf.z, lf.w};
#pragma unroll
            for (int hd = 0; hd < 4; ++hd) f[hd] = wave_incl_scan(f[hd], lane);
            *(float4*)(p.Floc() + r * 4) = make_float4(f[0], f[1], f[2], f[3]);
            if (lane == 63) *(float4*)(p.csum() + (size_t)ci * 4) = make_float4(f[0], f[1], f[2], f[3]);
        } else {
            const int cc = ci - NCHUNK;
            const size_t pos = (size_t)cc * 64 + lane;
            const float4 lf = *(const float4*)(clf + pos * 4);
            float f[4] = {lf.x, lf.y, lf.z, lf.w};
#pragma unroll
            for (int hd = 0; hd < 4; ++hd) f[hd] = wave_incl_scan(f[hd], lane);
            const int b = cc / 64, pin = (cc % 64) * 64 + lane;
            *(float4*)(p.Fs() + ((size_t)b * FS_LEN + pin) * 4) = make_float4(f[0], f[1], f[2], f[3]);
            if (lane == 63) *(float4*)(p.csum() + (size_t)ci * 4) = make_float4(f[0], f[1], f[2], f[3]);
        }
    }
}
DEVI void scan_fix(const P& p, int gw, int NGW, int lane) {
    for (int ci = gw; ci < NB_P * NCH_P + NB_S * 65; ci += NGW) {
        float o[4] = {0.f, 0.f, 0.f, 0.f};
        if (ci < NB_P * NCH_P) {
            const int s = ci / NCH_P, c = ci % NCH_P;
#pragma unroll
            for (int q = 0; q < 2; ++q) { const int cc = lane + 64 * q; if (cc < c) { const float4 t = *(const float4*)(p.csum() + ((size_t)s * NCH_P + cc) * 4); o[0] += t.x; o[1] += t.y; o[2] += t.z; o[3] += t.w; } }
#pragma unroll
            for (int hd = 0; hd < 4; ++hd) o[hd] = wave_sum(o[hd]);
            const size_t r = (size_t)ci * 64 + lane; const float4 f = *(const float4*)(p.Floc() + r * 4);
            *(float4*)(p.Fp() + r * 4) = make_float4(f.x + o[0], f.y + o[1], f.z + o[2], f.w + o[3]);
        } else {
            const int cs = ci - NB_P * NCH_P; const int b = cs / 65, c = cs % 65;
            if (lane < c) { const float4 t = *(const float4*)(p.csum() + ((size_t)NCHUNK + b * 64 + lane) * 4); o[0] += t.x; o[1] += t.y; o[2] += t.z; o[3] += t.w; }
#pragma unroll
            for (int hd = 0; hd < 4; ++hd) o[hd] = wave_sum(o[hd]);
            float4* dst = (float4*)(p.Fs() + ((size_t)b * FS_LEN + c * 64 + lane) * 4);
            float4 f;
            if (c < 64) f = *dst; else f = *(const float4*)(p.Floc() + ((size_t)M_P + b * 64 + lane) * 4);
            *dst = make_float4(f.x + o[0], f.y + o[1], f.z + o[2], f.w + o[3]);
        }
    }
}

DEVI void adaln_apply_1(const P& p, int l, int r, int lane, float (&v)[16]) { adaln_apply<1>(p, l, r, lane, v); }


constexpr float LOG2E = 1.4426950408889634f;
constexpr int ATT_KP = 144, ATT_VP = 136;
constexpr int ATT_VOFF = 64 * ATT_KP, ATT_GOFF = ATT_VOFF + 64 * ATT_VP, ATT_BUF = 18432;
static_assert(ATT_GOFF + 256 <= ATT_BUF, "attention tile buffer");

template <bool DIAG> DEVI void attn_tile(const LAS unsigned char* buf, int t, int qpos, int qi, int g, float gq, const bf16x8_t (&qf)[2], float& m, float& lsum, f32x4_t (&O)[4]) {
    f32x4_t st[4];
#pragma unroll
            for (int kb = 0; kb < 4; ++kb) {
                const bf16x8_t a0 = *(const LAS bf16x8_t*)(buf + (kb * 16 + qi) * ATT_KP + 16 * g), a1 = *(const LAS bf16x8_t*)(buf + (kb * 16 + qi) * ATT_KP + 64 + 16 * g);
                const f32x4_t gk = *(const LAS f32x4_t*)(buf + ATT_GOFF + (kb * 16 + 4 * g) * 4);
                const f32x4_t bias = {gq - gk[0], gq - gk[1], gq - gk[2], gq - gk[3]};
                st[kb] = __builtin_amdgcn_mfma_f32_16x16x32_bf16(a0, qf[0], bias, 0, 0, 0);
                st[kb] = __builtin_amdgcn_mfma_f32_16x16x32_bf16(a1, qf[1], st[kb], 0, 0, 0);
            }
            float mx = -INFINITY;
#pragma unroll
            for (int kb = 0; kb < 4; ++kb) {
#pragma unroll
                for (int e = 0; e < 4; ++e) { float s = st[kb][e]; if (DIAG && (t * 64 + kb * 16 + 4 * g + e > qpos)) s = -INFINITY; st[kb][e] = s; mx = fmaxf(mx, s); } }
            mx = fmaxf(mx, __shfl_xor(mx, 16)); mx = fmaxf(mx, __shfl_xor(mx, 32));
            const float mn = fmaxf(m, mx), alpha = __builtin_amdgcn_exp2f(m - mn); m = mn;
            float ps = 0.f;
#pragma unroll
            for (int kb = 0; kb < 4; ++kb)
#pragma unroll
                for (int e = 0; e < 4; ++e) { const float pe = __builtin_amdgcn_exp2f(st[kb][e] - mn); st[kb][e] = pe; ps += pe; }
            lsum = lsum * alpha + ps;
#pragma unroll
            for (int dt = 0; dt < 4; ++dt) O[dt] *= alpha;
#pragma unroll
            for (int ks = 0; ks < 2; ++ks) {
                u32x4_t pw = {pk2bf(st[2 * ks][0], st[2 * ks][1]), pk2bf(st[2 * ks][2], st[2 * ks][3]), pk2bf(st[2 * ks + 1][0], st[2 * ks + 1][1]), pk2bf(st[2 * ks + 1][2], st[2 * ks + 1][3])};
                const bf16x8_t pf = __builtin_bit_cast(bf16x8_t, pw);
#pragma unroll
                for (int dt = 0; dt < 4; ++dt) {
                    const LAS unsigned char* vp = buf + ATT_VOFF + (dt * 16 + qi) * ATT_VP + (32 * ks + 4 * g) * 2;
                    const u32x2_t lo = *(const LAS u32x2_t*)vp, hi = *(const LAS u32x2_t*)(vp + 32);
                    const u32x4_t aw = {lo.x, lo.y, hi.x, hi.y};
                    O[dt] = __builtin_amdgcn_mfma_f32_16x16x32_bf16(__builtin_bit_cast(bf16x8_t, aw), pf, O[dt], 0, 0, 0);
                }
            }
}
template <bool DIAG, bool FIX, int NQ> DEVI void attn_pair(const LAS unsigned char* buf, int tA, const int (&qpos)[NQ], int qi, int g, const float (&gq)[NQ], const bf16x8_t (&qf)[NQ][2], float (&m)[NQ], float (&lsum)[NQ], f32x4_t (&O)[NQ][4], f32x4_t (&OL)[NQ]) {
#pragma unroll
    for (int hf = 0; hf < 2; ++hf) {
        const LAS unsigned char* tbuf = buf + hf * ATT_BUF; const int k0 = (tA - hf) * 64;
        f32x4_t st[NQ][4];
#pragma unroll
        for (int kb = 0; kb < 4; ++kb) {
            const LAS unsigned char* tb = tbuf + (kb * 16 + qi) * ATT_KP;
            const bf16x8_t a0 = *(const LAS bf16x8_t*)(tb + 16 * g), a1 = *(const LAS bf16x8_t*)(tb + 64 + 16 * g);
            const f32x4_t gk = *(const LAS f32x4_t*)(tbuf + ATT_GOFF + (kb * 16 + 4 * g) * 4);
#pragma unroll
            for (int j = 0; j < NQ; ++j) {
                const f32x4_t bias = {gq[j] - gk[0], gq[j] - gk[1], gq[j] - gk[2], gq[j] - gk[3]};
                st[j][kb] = __builtin_amdgcn_mfma_f32_16x16x32_bf16(a0, qf[j][0], bias, 0, 0, 0);
                st[j][kb] = __builtin_amdgcn_mfma_f32_16x16x32_bf16(a1, qf[j][1], st[j][kb], 0, 0, 0);
            }
            if (NQ > 1) __builtin_amdgcn_sched_barrier(0);
        }
#pragma unroll
        for (int j = 0; j < NQ; ++j) {
            if (NQ > 1) __builtin_amdgcn_sched_barrier(0);
            if (FIX) {
#pragma unroll
                for (int kb = 0; kb < 4; ++kb)
#pragma unroll
                    for (int e = 0; e < 4; ++e) { float s = st[j][kb][e]; if (DIAG && (k0 + kb * 16 + 4 * g + e > qpos[j])) s = -INFINITY; st[j][kb][e] = __builtin_amdgcn_exp2f(s); }
            } else {
                float mx = -INFINITY;
#pragma unroll
                for (int kb = 0; kb < 4; ++kb) {
#pragma unroll
                    for (int e = 0; e < 4; ++e) { float s = st[j][kb][e]; if (DIAG && (k0 + kb * 16 + 4 * g + e > qpos[j])) s = -INFINITY; st[j][kb][e] = s; mx = fmaxf(mx, s); } }
                mx = fmaxf(mx, __shfl_xor(mx, 16)); mx = fmaxf(mx, __shfl_xor(mx, 32));
                const float mn = fmaxf(m[j], mx);
                if (mn == -INFINITY) {
#pragma unroll
                    for (int kb = 0; kb < 4; ++kb) st[j][kb] = (f32x4_t){0.f, 0.f, 0.f, 0.f};
                } else {
                    const float alpha = __builtin_amdgcn_exp2f(m[j] - mn); m[j] = mn;
                    float ps = 0.f;
#pragma unroll
                    for (int kb = 0; kb < 4; ++kb)
#pragma unroll
                        for (int e = 0; e < 4; ++e) { const float pe = __builtin_amdgcn_exp2f(st[j][kb][e] - mn); st[j][kb][e] = pe; ps += pe; }
                    lsum[j] = lsum[j] * alpha + ps;
#pragma unroll
                    for (int dt = 0; dt < 4; ++dt) O[j][dt] *= alpha;
                }
            }
        }
#pragma unroll
        for (int ks = 0; ks < 2; ++ks) {
            bf16x8_t pf[NQ];
#pragma unroll
            for (int j = 0; j < NQ; ++j) {
                u32x4_t pw = {pk2bf_c(st[j][2 * ks][0], st[j][2 * ks][1]), pk2bf_c(st[j][2 * ks][2], st[j][2 * ks][3]), pk2bf_c(st[j][2 * ks + 1][0], st[j][2 * ks + 1][1]), pk2bf_c(st[j][2 * ks + 1][2], st[j][2 * ks + 1][3])};
                pf[j] = __builtin_bit_cast(bf16x8_t, pw);
                if (FIX) { const unsigned o2 = qi == 0 ? 0x3f803f80u : 0u; const u32x4_t ow = {o2, o2, o2, o2}; OL[j] = __builtin_amdgcn_mfma_f32_16x16x32_bf16(__builtin_bit_cast(bf16x8_t, ow), pf[j], OL[j], 0, 0, 0); }
            }
#pragma unroll
            for (int dt = 0; dt < 4; ++dt) {
                const LAS unsigned char* vp = tbuf + ATT_VOFF + (dt * 16 + qi) * ATT_VP + (32 * ks + 4 * g) * 2;
                const u32x2_t lo = *(const LAS u32x2_t*)vp, hi = *(const LAS u32x2_t*)(vp + 32);
                const u32x4_t aw = {lo.x, lo.y, hi.x, hi.y};
#pragma unroll
                for (int j = 0; j < NQ; ++j) O[j][dt] = __builtin_amdgcn_mfma_f32_16x16x32_bf16(__builtin_bit_cast(bf16x8_t, aw), pf[j], O[j][dt], 0, 0, 0);
            }
            if (NQ > 1) __builtin_amdgcn_sched_barrier(0);
        }
        __builtin_amdgcn_sched_barrier(0);
    }
}
template <bool SAMPLE> DEVI void attn_unit(const P& p, int l, int b, int h, int qb_or_sp, float sbound2  , LAS unsigned char* lds, int tid, int wave, int lane, int part = -1) {
    asm volatile("" : "+v"(lane), "+v"(tid), "+s"(wave));
    const int qi = lane & 15, g = lane >> 4;
    const bf16_t* Qb = p.qb(); const bf16_t* Kb = p.kb(); const bf16_t* Vb = p.vb();
    constexpr int NQ = SAMPLE ? 1 : 2;
    int t0, t1, nwav, qlo; int qpos[NQ]; size_t qrow[NQ];
    const float* Fk;
    if constexpr (!SAMPLE) { const int q0 = qb_or_sp * 256; t0 = 0; t1 = (q0 + 256) / 64; qlo = q0 + 32 * wave; nwav = 8; Fk = p.Fp() + (size_t)b * T_P * 4;
#pragma unroll
        for (int j = 0; j < NQ; ++j) { qpos[j] = qlo + 16 * j + qi; qrow[j] = (size_t)b * T_P + qpos[j]; }
        if (part == 0) t0 = t1 / 2; else if (part == 1) t1 = t1 / 2; }
    else { const int sp = qb_or_sp; t0 = sp * 16; t1 = sp == 3 ? 66 : sp * 16 + 16;        qlo = PAST + 16 * (wave & 3); qpos[0] = qlo + qi; qrow[0] = (size_t)M_P + b * T_S + 16 * (wave & 3) + qi; nwav = 4; Fk = p.Fs() + (size_t)b * FS_LEN * 4; }
    const float* ck = inp(4) + ((size_t)l * NB_S + b) * PAST * 256; const float* cv = inp(5) + ((size_t)l * NB_S + b) * PAST * 256;
    const bool active = wave < nwav;
    const bool fix = sbound2 < 96.f;
    bf16x8_t qf[NQ][2]; float gqx[NQ], m[NQ], lsum[NQ]; f32x4_t O[NQ][4], OL[NQ];
#pragma unroll
    for (int j = 0; j < NQ; ++j) {
        qf[j][0] = *(const bf16x8_t*)(Qb + qrow[j] * 256 + h * 64 + 8 * g); qf[j][1] = *(const bf16x8_t*)(Qb + qrow[j] * 256 + h * 64 + 32 + 8 * g);
        const float gq = Fk[(size_t)qpos[j] * 4 + h] * LOG2E;
        gqx[j] = fix ? gq - 0.5f * sbound2 : gq; m[j] = fix ? 0.f : -INFINITY; lsum[j] = 0.f; OL[j] = (f32x4_t){0.f, 0.f, 0.f, 0.f};
#pragma unroll
        for (int dt = 0; dt < 4; ++dt) O[j][dt] = (f32x4_t){0.f, 0.f, 0.f, 0.f};
    }
    u32x4_t kreg0, vreg0, kreg1, vreg1; float greg0 = 0.f, greg1 = 0.f;
    int kkey = tid >> 3, kpc = tid & 7, vkey = tid & 63, vdg = tid >> 6;
#define ATT_LOAD(t, kreg, vreg, greg) do { const int k0_ = (t) * 64; \
        if (SAMPLE && (t) < 64) { \
            const float* ks_ = ck + ((size_t)(k0_ + kkey) * 4 + h) * 64 + kpc * 8; const float4 a_ = *(const float4*)ks_, b_ = *(const float4*)(ks_ + 4); \
            kreg = (u32x4_t){pk2bf(a_.x, a_.y), pk2bf(a_.z, a_.w), pk2bf(b_.x, b_.y), pk2bf(b_.z, b_.w)}; \
            const float* vs_ = cv + ((size_t)(k0_ + vkey) * 4 + h) * 64 + vdg * 8; const float4 c_ = *(const float4*)vs_, d_ = *(const float4*)(vs_ + 4); \
            vreg = (u32x4_t){pk2bf(c_.x, c_.y), pk2bf(c_.z, c_.w), pk2bf(d_.x, d_.y), pk2bf(d_.z, d_.w)}; \
        } else { const size_t rb_ = SAMPLE ? (size_t)M_P + b * T_S : (size_t)b * T_P + k0_; \
            kreg = *(const u32x4_t*)(Kb + (rb_ + kkey) * 256 + h * 64 + kpc * 8); vreg = *(const u32x4_t*)(Vb + (rb_ + vkey) * 256 + h * 64 + vdg * 8); } \
        if (tid < 64) greg = Fk[(size_t)(k0_ + tid) * 4 + h] * LOG2E; } while (0)
#define ATT_STORE(buf, kreg, vreg, greg) do { \
        *(LAS u32x4_t*)((buf) + kkey * ATT_KP + kpc * 16) = kreg; \
        { LAS unsigned short* vt = (LAS unsigned short*)((buf) + ATT_VOFF) + (vdg * 8) * (ATT_VP / 2) + vkey; \
          _Pragma("unroll") for (int i = 0; i < 4; ++i) { vt[(2 * i) * (ATT_VP / 2)] = (unsigned short)(vreg[i] & 0xffffu); vt[(2 * i + 1) * (ATT_VP / 2)] = (unsigned short)(vreg[i] >> 16); } } \
        if (tid < 64) ((LAS float*)((buf) + ATT_GOFF))[tid] = greg; } while (0)
    ATT_LOAD(t1 - 1, kreg0, vreg0, greg0); ATT_LOAD(t1 - 2, kreg1, vreg1, greg1);
    int cur = 0;
    for (int t = t1 - 1; t >= t0; t -= 2) {
        { int tl = tid; asm volatile("" : "+v"(tl)); kkey = tl >> 3; kpc = tl & 7; vkey = tl & 63; vdg = tl >> 6; }
        if (!SAMPLE && (Fk[(size_t)qb_or_sp * 256 * 4 + h] - Fk[(size_t)(t * 64 + 63) * 4 + h]) * LOG2E + sbound2 < -152.f) break;
        LAS unsigned char* buf = lds + cur * (2 * ATT_BUF);
        ATT_STORE(buf, kreg0, vreg0, greg0); ATT_STORE(buf + ATT_BUF, kreg1, vreg1, greg1);
        __syncthreads();
        if (t - 2 >= t0) { ATT_LOAD(t - 2, kreg0, vreg0, greg0); ATT_LOAD(t - 3, kreg1, vreg1, greg1); }
        if (active && (SAMPLE || (t - 1) * 64 <= qlo + 31)) {
            const bool dg = t * 64 + 63 > qlo;
            if (fix) { if (dg) attn_pair<true, true, NQ>(buf, t, qpos, qi, g, gqx, qf, m, lsum, O, OL); else attn_pair<false, true, NQ>(buf, t, qpos, qi, g, gqx, qf, m, lsum, O, OL); }
            else { if (dg) attn_pair<true, false, NQ>(buf, t, qpos, qi, g, gqx, qf, m, lsum, O, OL); else attn_pair<false, false, NQ>(buf, t, qpos, qi, g, gqx, qf, m, lsum, O, OL); } }
        cur ^= 1;
    }
#undef ATT_STORE
#undef ATT_LOAD
    if (active) {
#pragma unroll
        for (int j = 0; j < NQ; ++j) {
            float ls = lsum[j];
            if (fix) ls = __shfl(OL[j][0], qi);
            else { ls += __shfl_xor(ls, 16); ls += __shfl_xor(ls, 32); }
            if constexpr (!SAMPLE) {
                if (part >= 0) {
                    const size_t u = ((size_t)(((b * 4 + h) * (32 - APS_QB0) + (qb_or_sp - APS_QB0)) * 2 + part)) * 256 + 32 * wave + 16 * j + qi;
                    float* op = p.ppart() + u * 64 + 4 * g;
#pragma unroll
                    for (int dt = 0; dt < 4; ++dt) *(float4*)(op + 16 * dt) = make_float4(O[j][dt][0], O[j][dt][1], O[j][dt][2], O[j][dt][3]);
                    if (g == 0) { p.pml()[u * 2] = m[j]; p.pml()[u * 2 + 1] = ls; }
                    continue;
                }
                const float inv = 1.f / ls; bf16_t* op = p.mix() + qrow[j] * D + 512 + h * 64 + 4 * g;
#pragma unroll
                for (int dt = 0; dt < 4; ++dt) { uint2 o; o.x = pk2bf(O[j][dt][0] * inv, O[j][dt][1] * inv); o.y = pk2bf(O[j][dt][2] * inv, O[j][dt][3] * inv); *(uint2*)(op + 16 * dt) = o; }
            } else {
                const size_t u = ((size_t)(b * 4 + h) * 4 + qb_or_sp) * 64 + 16 * (wave & 3) + qi;
                float* op = p.apart() + u * 64 + 4 * g;
#pragma unroll
                for (int dt = 0; dt < 4; ++dt) *(float4*)(op + 16 * dt) = make_float4(O[j][dt][0], O[j][dt][1], O[j][dt][2], O[j][dt][3]);
                if (g == 0) { p.aml()[u * 2] = m[j]; p.aml()[u * 2 + 1] = ls; }
            }
        }
    }
    __syncthreads();
}
DEVI void attn_sample_combine(const P& p, long gtid, long gsz) {
    for (long i = gtid; i < (long)NB_S * 4 * 64 * 16; i += gsz) {
        const int d4 = (int)(i % 16), q = (int)((i / 16) % 64), bh = (int)(i / 1024);
        float mm = -INFINITY; float ms[4], ls[4];
#pragma unroll
        for (int s = 0; s < 4; ++s) { const size_t u = ((size_t)bh * 4 + s) * 64 + q; ms[s] = p.aml()[u * 2]; ls[s] = p.aml()[u * 2 + 1]; mm = fmaxf(mm, ms[s]); }
        float L = 0.f; float4 o = make_float4(0.f, 0.f, 0.f, 0.f);
#pragma unroll
        for (int s = 0; s < 4; ++s) { const float w = __builtin_amdgcn_exp2f(ms[s] - mm); L += w * ls[s]; const float4 a = *(const float4*)(p.apart() + (((size_t)bh * 4 + s) * 64 + q) * 64 + d4 * 4);
            o.x += w * a.x; o.y += w * a.y; o.z += w * a.z; o.w += w * a.w; }
        const float inv = 1.f / L; const int b = bh / 4, h = bh % 4;
        uint2 w2; w2.x = pk2bf(o.x * inv, o.y * inv); w2.y = pk2bf(o.z * inv, o.w * inv);
        *(uint2*)(p.mix() + ((size_t)M_P + b * T_S + q) * D + 512 + h * 64 + d4 * 4) = w2;
    }
}

DEVI void attn_prompt_combine(const P& p, long gtid, long gsz) {
    for (long i = gtid; i < (long)NB_P * 4 * (32 - APS_QB0) * 256 * 16; i += gsz) {
        const int d4 = (int)(i % 16), r = (int)((i / 16) % 256), un = (int)(i / 4096);
        const size_t u0 = ((size_t)un * 2) * 256 + r, u1 = u0 + 256;
        const float m0 = p.pml()[u0 * 2], l0 = p.pml()[u0 * 2 + 1], m1 = p.pml()[u1 * 2], l1 = p.pml()[u1 * 2 + 1];
        const float mm = fmaxf(m0, m1);
        const float w0 = __builtin_amdgcn_exp2f(m0 - mm), w1 = __builtin_amdgcn_exp2f(m1 - mm);
        const float4 a = *(const float4*)(p.ppart() + u0 * 64 + d4 * 4), c = *(const float4*)(p.ppart() + u1 * 64 + d4 * 4);
        const float inv = 1.f / (w0 * l0 + w1 * l1);
        const int qb = APS_QB0 + un % (32 - APS_QB0), bh = un / (32 - APS_QB0), b = bh / 4, h = bh % 4;
        uint2 w2; w2.x = pk2bf((w0 * a.x + w1 * c.x) * inv, (w0 * a.y + w1 * c.y) * inv); w2.y = pk2bf((w0 * a.z + w1 * c.z) * inv, (w0 * a.w + w1 * c.w) * inv);
        *(uint2*)(p.mix() + ((size_t)b * T_P + qb * 256 + r) * D + 512 + h * 64 + d4 * 4) = w2;
    }
}
constexpr int SSD_BCP = 528;
constexpr int SSD_BFRAG = 64 * SSD_BCP;
constexpr int SSD_SC = SSD_BFRAG + 16384;
constexpr int SSD_RAW = SSD_SC + 3 * 2048;
constexpr int SSD_RAWW = 67 * 128;
constexpr int SSD_LDS = SSD_RAW + 8 * SSD_RAWW;
static_assert(SSD_LDS <= 147456 - 64, "SSD chunk LDS");
DEVI float silu_fast(float x) { return x / (1.f + __expf(-x)); }

template <int NC16> DEVI void stage_raw(const bf16_t* proj, int r0, int col0, const float* hist, int hcol0, bool first_chunk, LAS unsigned char* rawb, int lane) {
    constexpr int RPI = 64 / NC16;
#pragma unroll
    for (int i = 0; i * RPI < 67; ++i) {
        const int row = i * RPI + lane / NC16, pc = lane % NC16;
        if (row < 67) { const int s = row - 3; u32x4_t v = {0u, 0u, 0u, 0u};
            if (s >= 0 || !first_chunk) v = *(const u32x4_t*)(proj + (size_t)(r0 + s) * NP + col0 + pc * 8);
            else if (hist) { const float* hp = hist + (3 + s) * CONVC + hcol0 + pc * 8; v = (u32x4_t){pk2bf(hp[0], hp[1]), pk2bf(hp[2], hp[3]), pk2bf(hp[4], hp[5]), pk2bf(hp[6], hp[7])}; }
            *(LAS u32x4_t*)(rawb + row * 128 + pc * 16) = v; }
    }
}
DEVI void conv_block(const LAS unsigned short* raw, float w0, float w1, float w2, float w3, float bs, int hh, float (&out)[32]) {
    const LAS unsigned short* rb = raw + (4 * hh) * 64;
#pragma unroll
    for (int j = 0; j < 8; ++j) {
        float rw[7];
#pragma unroll
        for (int i = 0; i < 7; ++i) rw[i] = bf2f(rb[(8 * j + i) * 64]);
#pragma unroll
        for (int e = 0; e < 4; ++e) out[4 * j + e] = silu_fast(bs + w0 * rw[e] + w1 * rw[e + 1] + w2 * rw[e + 2] + w3 * rw[e + 3]);
    }
}
DEVI bf16x8_t pack8(float a0, float a1, float a2, float a3, float a4, float a5, float a6, float a7) {
    const u32x4_t w = {pk2bf_c(a0, a1), pk2bf_c(a2, a3), pk2bf_c(a4, a5), pk2bf_c(a6, a7)}; return __builtin_bit_cast(bf16x8_t, w);
}

DEVI void ssd_chunk_unit(const P& p, int l, int ci, LAS unsigned char* lds, int tid, int wave, int lane) {
    const int c32 = lane & 31, hh = lane >> 5, r0 = ci * 64, g = wave >> 2;
    const int seq = ci < NB_P * NCH_P ? ci / NCH_P : NB_P + (ci - NB_P * NCH_P);
    const bool first_chunk = ci >= NB_P * NCH_P || (ci % NCH_P) == 0;
    const float* hist = seq >= NB_P ? inp(8) + ((size_t)l * NB_S + (seq - NB_P)) * 3 * CONVC : nullptr;
    const float* cw = inp(14) + (size_t)l * 4 * CONVC; const float* cbias = inp(15) + (size_t)l * CONVC;
    LAS float* acumL = (LAS float*)(lds + SSD_SC); LAS float* dtL = acumL + 512; LAS float* wgtL = dtL + 512;
    {
        const float dtv = p.dt()[(size_t)(r0 + lane) * 8 + wave]; const float A = -__expf(inp(17)[l * 8 + wave]);
        const float ac = wave_incl_scan(dtv * A, lane); const float alast = __shfl(ac, 63);
        p.acum()[(size_t)(r0 + lane) * 8 + wave] = ac;
        acumL[wave * 64 + lane] = ac; dtL[wave * 64 + lane] = dtv; wgtL[wave * 64 + lane] = dtv * __expf(alast - ac);
    }
    {
        float v[32];
        LAS unsigned char* rawb = lds + SSD_RAW + wave * SSD_RAWW;
        stage_raw<4>(p.proj(), r0, O_XBC + 512 + 32 * wave, hist, 512 + 32 * wave, first_chunk, rawb, lane);
        { const int ch = 512 + 32 * wave + c32; conv_block((const LAS unsigned short*)rawb + c32, cw[ch], cw[CONVC + ch], cw[2 * CONVC + ch], cw[3 * CONVC + ch], cbias[ch], hh, v); }
        LAS unsigned short* rowimg = (LAS unsigned short*)lds;
#pragma unroll
        for (int j = 0; j < 8; ++j)
#pragma unroll
            for (int e = 0; e < 4; ++e) rowimg[(8 * j + 4 * hh + e) * (SSD_BCP / 2) + 32 * wave + c32] = f2bf(v[4 * j + e]);
        if (wave < 4) {
#pragma unroll
            for (int ks = 0; ks < 4; ++ks)
                *(LAS bf16x8_t*)(lds + SSD_BFRAG + ((wave * 4 + ks) * 64 + lane) * 16) = pack8(v[8 * ks], v[8 * ks + 1], v[8 * ks + 2], v[8 * ks + 3], v[8 * ks + 4], v[8 * ks + 5], v[8 * ks + 6], v[8 * ks + 7]);
        }
    }
    bf16x8_t xf[2][4];
    __syncthreads();
    const f32x16_t z16 = {0.f, 0.f, 0.f, 0.f, 0.f, 0.f, 0.f, 0.f, 0.f, 0.f, 0.f, 0.f, 0.f, 0.f, 0.f, 0.f};
    stage_raw<8>(p.proj(), r0, O_XBC + 64 * wave, hist, 64 * wave, first_chunk, lds + SSD_RAW + wave * SSD_RAWW, lane);
#pragma unroll
    for (int pb = 0; pb < 2; ++pb) {
        bf16x8_t xs[4];
        {
            float v[32];
            { const int ch = 64 * wave + 32 * pb + c32; conv_block((const LAS unsigned short*)(lds + SSD_RAW + wave * SSD_RAWW) + 32 * pb + c32, cw[ch], cw[CONVC + ch], cw[2 * CONVC + ch], cw[3 * CONVC + ch], cbias[ch], hh, v); }
#pragma unroll
            for (int ks = 0; ks < 4; ++ks) {
                xf[pb][ks] = pack8(v[8 * ks], v[8 * ks + 1], v[8 * ks + 2], v[8 * ks + 3], v[8 * ks + 4], v[8 * ks + 5], v[8 * ks + 6], v[8 * ks + 7]);
                const f32x4_t wa = *(const LAS f32x4_t*)(wgtL + wave * 64 + 16 * ks + 4 * hh), wb = *(const LAS f32x4_t*)(wgtL + wave * 64 + 16 * ks + 8 + 4 * hh);
                xs[ks] = pack8(v[8 * ks] * wa[0], v[8 * ks + 1] * wa[1], v[8 * ks + 2] * wa[2], v[8 * ks + 3] * wa[3], v[8 * ks + 4] * wb[0], v[8 * ks + 5] * wb[1], v[8 * ks + 6] * wb[2], v[8 * ks + 7] * wb[3]);
            }
        }
        __builtin_amdgcn_sched_barrier(0);
#pragma unroll
        for (int nb = 0; nb < 2; ++nb) {
            f32x16_t Z = z16;
#pragma unroll
            for (int ks = 0; ks < 4; ++ks) { const bf16x8_t bfr = *(const LAS bf16x8_t*)(lds + SSD_BFRAG + (((g * 2 + nb) * 4 + ks) * 64 + lane) * 16); Z = __builtin_amdgcn_mfma_f32_32x32x16_bf16(xs[ks], bfr, Z, 0, 0, 0); }
            float* sp = p.states() + ((size_t)(ci * 8 + wave) * 64 + 32 * pb) * 64 + 32 * nb + c32;
#pragma unroll
            for (int e = 0; e < 16; ++e) sp[(size_t)(8 * (e >> 2) + 4 * hh + (e & 3)) * 64] = Z[e];
        }
        __builtin_amdgcn_sched_barrier(0);
    }
    for (int i = tid; i < 64 * 16; i += 512) { const int s = i >> 4, pc = i & 15; *(u32x4_t*)(p.cact() + (size_t)(r0 + s) * 128 + pc * 8) = *(const LAS u32x4_t*)(lds + s * SSD_BCP + 256 + pc * 16); }
    const float dskip = inp(18)[l * 8 + wave];
#pragma unroll
    for (int tb = 0; tb < 2; ++tb) {
        const int t = 32 * tb + c32; const float at = acumL[wave * 64 + t];
        bf16x8_t LT[2][2];
#pragma unroll
        for (int sb = 0; sb <= tb; ++sb) {
            f32x16_t D1 = z16;
#pragma unroll
            for (int kk = 0; kk < 4; ++kk) {
                const bf16x8_t a = *(const LAS bf16x8_t*)(lds + (32 * sb + c32) * SSD_BCP + (g * 64 + 16 * kk + 8 * hh) * 2);
                const bf16x8_t b = *(const LAS bf16x8_t*)(lds + (32 * tb + c32) * SSD_BCP + 256 + (g * 64 + 16 * kk + 8 * hh) * 2);
                D1 = __builtin_amdgcn_mfma_f32_32x32x16_bf16(a, b, D1, 0, 0, 0);
            }
            float lv[16];
#pragma unroll
            for (int q = 0; q < 4; ++q) { const int sq = 32 * sb + 8 * q + 4 * hh;
                const f32x4_t as = *(const LAS f32x4_t*)(acumL + wave * 64 + sq), ds = *(const LAS f32x4_t*)(dtL + wave * 64 + sq);
#pragma unroll
                for (int e = 0; e < 4; ++e) { const int s = sq + e; float val = D1[4 * q + e] * __expf(at - as[e]) * ds[e]; val = (s <= t) ? val : 0.f; val = (s == t) ? val + dskip : val; lv[4 * q + e] = val; } }
            LT[sb][0] = pack8(lv[0], lv[1], lv[2], lv[3], lv[4], lv[5], lv[6], lv[7]); LT[sb][1] = pack8(lv[8], lv[9], lv[10], lv[11], lv[12], lv[13], lv[14], lv[15]);
        }
#pragma unroll
        for (int pb = 0; pb < 2; ++pb) {
            f32x16_t Y = z16;
#pragma unroll
            for (int sb = 0; sb <= tb; ++sb)
#pragma unroll
                for (int kk = 0; kk < 2; ++kk) Y = __builtin_amdgcn_mfma_f32_32x32x16_bf16(xf[pb][2 * sb + kk], LT[sb][kk], Y, 0, 0, 0);
            float* yp = p.ydg() + (size_t)(r0 + t) * 512 + wave * 64 + 32 * pb + 4 * hh;
#pragma unroll
            for (int q = 0; q < 4; ++q) *(float4*)(yp + 8 * q) = make_float4(Y[4 * q], Y[4 * q + 1], Y[4 * q + 2], Y[4 * q + 3]);
        }
    }
    __syncthreads();
}

DEVI void ssd_scan(const P& p, int l, long gtid, long gsz) {
    const float* s0 = inp(7) + (size_t)l * NB_S * 32768;
    for (long i = gtid; i < (long)NB_P * 32768; i += gsz) {
        const int e = (int)(i % 32768), s = (int)(i / 32768); const int hh = e / 4096;
        if (s < NB_P) { float st = 0.f;
            for (int c0 = 0; c0 < NCH_P; c0 += 16) {
                float v[16], dc[16];
#pragma unroll
                for (int k = 0; k < 16; ++k) { const size_t ci = (size_t)s * NCH_P + c0 + k; v[k] = p.states()[ci * 32768 + e]; dc[k] = p.acum()[(ci * 64 + 63) * 8 + hh]; }
#pragma unroll
                for (int k = 0; k < 16; ++k) { const size_t ci = (size_t)s * NCH_P + c0 + k; p.prevb()[ci * 32768 + e] = f2bf(st); st = st * __expf(dc[k]) + v[k]; }
            }
            p.out[OUT_SSMP + ((size_t)l * NB_P + s) * 32768 + e] = st;
        } else { const int b = s - NB_P; const size_t ci = (size_t)NB_P * NCH_P + b; float st = s0[(size_t)b * 32768 + e];
            p.prevb()[ci * 32768 + e] = f2bf(st); st = st * __expf(p.acum()[(ci * 64 + 63) * 8 + hh]) + p.states()[ci * 32768 + e];
            p.out[OUT_SSMS + ((size_t)l * NB_S + b) * 32768 + e] = st; }
    }
}

DEVI void ssd_scan_sample(const P& p, int l, int b, int tid) {
    const float* s0 = inp(7) + ((size_t)l * NB_S + b) * 32768;
    const size_t ci = (size_t)NB_P * NCH_P + b;
#pragma unroll 4
    for (int e = tid * 4; e < 32768; e += 512 * 4) {
        const float4 s = *(const float4*)(s0 + e), v = *(const float4*)(p.states() + ci * 32768 + e);
        const float dc = __expf(p.acum()[(ci * 64 + 63) * 8 + e / 4096]);
        uint2 o; o.x = pk2bf(s.x, s.y); o.y = pk2bf(s.z, s.w); *(uint2*)(p.prevb() + ci * 32768 + e) = o;
        float4 f; f.x = s.x * dc + v.x; f.y = s.y * dc + v.y; f.z = s.z * dc + v.z; f.w = s.w * dc + v.w;
        *(float4*)(p.out + OUT_SSMS + ((size_t)l * NB_S + b) * 32768 + e) = f;
    }
}

DEVI void ssd_y_unit(const P& p, int l, int ci, LAS unsigned char* lds, int tid, int wave, int lane) {
    const int c32 = lane & 31, hh = lane >> 5, r0 = ci * 64, g = wave >> 2;
    LAS float* part = (LAS float*)lds;
    const f32x16_t z16 = {0.f, 0.f, 0.f, 0.f, 0.f, 0.f, 0.f, 0.f, 0.f, 0.f, 0.f, 0.f, 0.f, 0.f, 0.f, 0.f};
    float y[2][2][16];
#pragma unroll
    for (int tb = 0; tb < 2; ++tb) {
        const size_t r = (size_t)r0 + 32 * tb + c32; const float eat = __expf(p.acum()[r * 8 + wave]); float ssq = 0.f;
#pragma unroll
        for (int pb = 0; pb < 2; ++pb) {
            f32x16_t YO = z16;
#pragma unroll
            for (int kk = 0; kk < 4; ++kk) {
                const bf16x8_t a = *(const bf16x8_t*)(p.prevb() + ((size_t)(ci * 8 + wave) * 64 + 32 * pb + c32) * 64 + 16 * kk + 8 * hh);
                const bf16x8_t b = *(const bf16x8_t*)(p.cact() + r * 128 + g * 64 + 16 * kk + 8 * hh);
                YO = __builtin_amdgcn_mfma_f32_32x32x16_bf16(a, b, YO, 0, 0, 0);
            }
#pragma unroll
            for (int q = 0; q < 4; ++q) { const int p0 = wave * 64 + 32 * pb + 8 * q + 4 * hh;
                const float4 yd = *(const float4*)(p.ydg() + r * 512 + p0); const uint2 zz = *(const uint2*)(p.proj() + r * NP + O_Z + p0);
                const float z0 = __uint_as_float(zz.x << 16), z1 = __uint_as_float(zz.x & 0xffff0000u), z2 = __uint_as_float(zz.y << 16), z3 = __uint_as_float(zz.y & 0xffff0000u);
                const float v0 = (yd.x + YO[4 * q] * eat) * silu_fast(z0), v1 = (yd.y + YO[4 * q + 1] * eat) * silu_fast(z1), v2 = (yd.z + YO[4 * q + 2] * eat) * silu_fast(z2), v3 = (yd.w + YO[4 * q + 3] * eat) * silu_fast(z3);
                y[tb][pb][4 * q] = v0; y[tb][pb][4 * q + 1] = v1; y[tb][pb][4 * q + 2] = v2; y[tb][pb][4 * q + 3] = v3; ssq += v0 * v0 + v1 * v1 + v2 * v2 + v3 * v3; }
        }
        ssq += __shfl_xor(ssq, 32);
        if (hh == 0) part[wave * 64 + 32 * tb + c32] = ssq;
    }
    __syncthreads();
    const float* gn = inp(19) + (size_t)l * 512;
#pragma unroll
    for (int tb = 0; tb < 2; ++tb) {
        const int t = 32 * tb + c32; float tot = 0.f;
#pragma unroll
        for (int w = 0; w < 8; ++w) tot += part[w * 64 + t];
        const float rstd = rsqrtf(tot * (1.f / 512) + EPS); const size_t r = (size_t)r0 + t;
#pragma unroll
        for (int pb = 0; pb < 2; ++pb)
#pragma unroll
            for (int q = 0; q < 4; ++q) { const int p0 = wave * 64 + 32 * pb + 8 * q + 4 * hh; const float4 gg = *(const float4*)(gn + p0);
                uint2 o; o.x = pk2bf(y[tb][pb][4 * q] * rstd * gg.x, y[tb][pb][4 * q + 1] * rstd * gg.y); o.y = pk2bf(y[tb][pb][4 * q + 2] * rstd * gg.z, y[tb][pb][4 * q + 3] * rstd * gg.w);
                *(uint2*)(p.mix() + r * D + p0) = o; }
    }
    __syncthreads();
}

DEVI float sum8(float v) { v += __shfl_xor(v, 1); v += __shfl_xor(v, 2); v += __shfl_xor(v, 4); return v; }
DEVI void unpack8(const u32x4_t w, float (&f)[8]) {
    f[0] = __uint_as_float(w.x << 16); f[1] = __uint_as_float(w.x & 0xffff0000u); f[2] = __uint_as_float(w.y << 16); f[3] = __uint_as_float(w.y & 0xffff0000u);
    f[4] = __uint_as_float(w.z << 16); f[5] = __uint_as_float(w.z & 0xffff0000u); f[6] = __uint_as_float(w.w << 16); f[7] = __uint_as_float(w.w & 0xffff0000u);
}
DEVI void rows_qkv(const P& p, int l, int gw, int NGW, int lane) {
    const int hi = lane >> 5, l32 = lane & 31;
    const float* gq = inp(20) + l * 64; const float* gk = inp(21) + l * 64;
    float gain[8];
#pragma unroll
    for (int i = 0; i < 8; ++i) gain[i] = (hi ? gk : gq)[(l32 & 7) * 8 + i] * (hi ? 1.f : 0.125f * LOG2E);
    u32x4_t nwa = {0u, 0u, 0u, 0u}, nwb = {0u, 0u, 0u, 0u};
    if (gw < M) { const bf16_t* pr = p.proj() + (size_t)gw * NP; nwa = *(const u32x4_t*)(pr + O_Q + 8 * lane); nwb = *(const u32x4_t*)(pr + (hi ? O_VM : O_V) + 8 * l32); }
    for (int r = gw; r < M; r += NGW) {
        const u32x4_t wa = nwa;
        const u32x4_t wb = nwb;
        if (r + NGW < M) { const bf16_t* pr = p.proj() + (size_t)(r + NGW) * NP; nwa = *(const u32x4_t*)(pr + O_Q + 8 * lane); nwb = *(const u32x4_t*)(pr + (hi ? O_VM : O_V) + 8 * l32); }
        float a[8], b[8]; unpack8(wa, a); unpack8(wb, b);
        float ss = 0.f;
#pragma unroll
        for (int i = 0; i < 8; ++i) ss += a[i] * a[i];
        const float rs = rsqrtf(sum8(ss) * (1.f / 64) + EPS);
        float o[8];
#pragma unroll
        for (int i = 0; i < 8; ++i) o[i] = a[i] * rs * gain[i];
        const u32x4_t ow = {pk2bf(o[0], o[1]), pk2bf(o[2], o[3]), pk2bf(o[4], o[5]), pk2bf(o[6], o[7])};
        if (hi == 0) *(u32x4_t*)(p.qb() + (size_t)r * 256 + 8 * l32) = ow;
        else { *(u32x4_t*)(p.kb() + (size_t)r * 256 + 8 * l32) = ow;
            float* ko = r < M_P ? p.out + OUT_KP + ((size_t)l * M_P + r) * 256 + 8 * l32 : p.out + OUT_KS + ((size_t)l * M_S + (r - M_P)) * 256 + 8 * l32;
            *(float4*)ko = make_float4(o[0], o[1], o[2], o[3]); *(float4*)(ko + 4) = make_float4(o[4], o[5], o[6], o[7]); }
        float ge[8]; float s1 = 0.f;
#pragma unroll
        for (int i = 0; i < 8; ++i) { ge[i] = gelu_f(b[i]); s1 += ge[i]; }
        const float mu = sum8(s1) * (1.f / 64); float s2 = 0.f;
#pragma unroll
        for (int i = 0; i < 8; ++i) { ge[i] -= mu; s2 += ge[i] * ge[i]; }
        const float rv = rsqrtf(sum8(s2) * (1.f / 64) + EPS);
        if (hi == 0) { *(u32x4_t*)(p.vb() + (size_t)r * 256 + 8 * l32) = wb;
            float* vo = r < M_P ? p.out + OUT_VP + ((size_t)l * M_P + r) * 256 + 8 * l32 : p.out + OUT_VS + ((size_t)l * M_S + (r - M_P)) * 256 + 8 * l32;
            *(float4*)vo = make_float4(b[0], b[1], b[2], b[3]); *(float4*)(vo + 4) = make_float4(b[4], b[5], b[6], b[7]);
        } else {
#pragma unroll
            for (int i = 0; i < 8; ++i) ge[i] *= rv;
            *(u32x4_t*)(p.vnb() + (size_t)r * 256 + 8 * l32) = (u32x4_t){pk2bf(ge[0], ge[1]), pk2bf(ge[2], ge[3]), pk2bf(ge[4], ge[5]), pk2bf(ge[6], ge[7])};
            if (r >= M_P) { float* mo = p.out + OUT_MLPV + ((size_t)l * M_S + (r - M_P)) * 256 + 8 * l32;
                *(float4*)mo = make_float4(ge[0], ge[1], ge[2], ge[3]); *(float4*)(mo + 4) = make_float4(ge[4], ge[5], ge[6], ge[7]); }
        }
    }
}

DEVI void mlp_unit(const P& p, int l, int u, int wave, int lane) {
    const int c32 = lane & 31, hh = lane >> 5, g = wave >> 1, db = wave & 1;
    const int L = u < 128 ? 128 : 64; const int r0 = u < 128 ? u * 128 : M_P + (u - 128) * 64;
    const int col = g * 64 + 32 * db + c32;
    const float* W = inp(23) + ((size_t)l * 4 + g) * 128 * 128; const float* bsv = inp(24) + ((size_t)l * 4 + g) * 128;
    const int NKS = L / 16;
    bf16x8_t vf[8];
#pragma unroll
    for (int ks = 0; ks < 8; ++ks) {
        if (ks < NKS) { const bf16_t* vp = p.vnb() + (size_t)(r0 + 16 * ks + 8 * hh) * 256 + col;
            unsigned short e[8];
#pragma unroll
            for (int j = 0; j < 8; ++j) e[j] = vp[(size_t)j * 256];
            const u32x4_t w = {(unsigned)e[0] | ((unsigned)e[1] << 16), (unsigned)e[2] | ((unsigned)e[3] << 16), (unsigned)e[4] | ((unsigned)e[5] << 16), (unsigned)e[6] | ((unsigned)e[7] << 16)};
            vf[ks] = __builtin_bit_cast(bf16x8_t, w); }
    }
    const f32x16_t z16 = {0.f, 0.f, 0.f, 0.f, 0.f, 0.f, 0.f, 0.f, 0.f, 0.f, 0.f, 0.f, 0.f, 0.f, 0.f, 0.f};
#pragma unroll
    for (int tb = 0; tb < 4; ++tb) {
        if (32 * tb < L) {
            const int t = 32 * tb + c32; f32x16_t Dv = z16;
#pragma unroll
            for (int ks = 0; ks < 2 * tb + 2; ++ks) {
                const float* wp = W + (size_t)t * 128 + 16 * ks + 8 * hh; const float4 w0 = *(const float4*)wp, w1 = *(const float4*)(wp + 4); const int sb = 16 * ks + 8 * hh;
                const bf16x8_t a = pack8(sb <= t ? w0.x : 0.f, sb + 1 <= t ? w0.y : 0.f, sb + 2 <= t ? w0.z : 0.f, sb + 3 <= t ? w0.w : 0.f, sb + 4 <= t ? w1.x : 0.f, sb + 5 <= t ? w1.y : 0.f, sb + 6 <= t ? w1.z : 0.f, sb + 7 <= t ? w1.w : 0.f);
                Dv = __builtin_amdgcn_mfma_f32_32x32x16_bf16(a, vf[ks], Dv, 0, 0, 0);
            }
#pragma unroll
            for (int e = 0; e < 16; ++e) { const int tt = 32 * tb + 8 * (e >> 2) + 4 * hh + (e & 3); const size_t r = (size_t)r0 + tt;
                const float uu = bf2f(p.proj()[r * NP + O_U + col]);
                p.mix()[r * D + 768 + col] = f2bf(gelu_f(uu) * (Dv[e] + bsv[tt])); }
        }
    }
}


DEVI void mod_phase(const P& p, LAS unsigned char* lds, int bid, int nblk, int tid, int wave, int lane) {
    LAS float* sc = (LAS float*)lds;
    LAS float* red = sc + NSEQ * D;
    const float* cp = inp(2); const float* cs = inp(3); const float* w_ada = inp(11); const float* b_ada = inp(12);
    for (int i = tid; i < NSEQ * D; i += 512) { const int s = i / D, k = i % D; const float c = s < NB_P ? cp[(size_t)s * D + k] : cs[(size_t)(s - NB_P) * D + k]; sc[i] = silu_f(c); }
    __syncthreads();
    for (int it = bid; it < DEPTH * 96; it += nblk) {
        const int ll = it / 96, j0 = (it % 96) * 64;
        const float* wp = w_ada + ((size_t)ll * D + 128 * wave) * 6144 + j0 + lane;
        float acc[NSEQ];
#pragma unroll
        for (int s = 0; s < NSEQ; ++s) acc[s] = 0.f;
        for (int k4 = 0; k4 < 32; ++k4) {
            const float w0 = wp[(size_t)(4 * k4) * 6144], w1 = wp[(size_t)(4 * k4 + 1) * 6144], w2 = wp[(size_t)(4 * k4 + 2) * 6144], w3 = wp[(size_t)(4 * k4 + 3) * 6144];
#pragma unroll
            for (int s = 0; s < NSEQ; ++s) { const f32x4_t c4 = *(const LAS f32x4_t*)(sc + s * D + 128 * wave + 4 * k4); acc[s] += c4[0] * w0 + c4[1] * w1 + c4[2] * w2 + c4[3] * w3; }
        }
#pragma unroll
        for (int s = 0; s < NSEQ; ++s) red[(wave * NSEQ + s) * 64 + lane] = acc[s];
        __syncthreads();
        for (int o = tid; o < NSEQ * 64; o += 512) { const int s = o >> 6, j = o & 63; float t = b_ada[(size_t)ll * 6144 + j0 + j];
#pragma unroll
            for (int w = 0; w < 8; ++w) t += red[(w * NSEQ + s) * 64 + j];
            p.mod()[((size_t)ll * NSEQ + s) * 6144 + j0 + j] = t; }
        __syncthreads();
    }
}

template <int MODE> DEVI void light_gemm_tile(const bf16_t* A, const bf16_t* Bt, int row0, int col0, bf16_t* Obf, int ldo, float* X, const float* Xin, const float* gate, LAS unsigned char* lds, int tid, int wave, int lane) {
    const int r32 = lane & 31, h = lane >> 5;
    bf16x8_t af[2][8], bfr[2][8];
#pragma unroll
    for (int rb = 0; rb < 2; ++rb)
#pragma unroll
        for (int ks = 0; ks < 8; ++ks) {
            af[rb][ks] = *(const bf16x8_t*)(A + (size_t)(row0 + 32 * rb + r32) * D + 128 * wave + 16 * ks + 8 * h);
            bfr[rb][ks] = *(const bf16x8_t*)(Bt + (size_t)(col0 + 32 * rb + r32) * D + 128 * wave + 16 * ks + 8 * h);
        }
    LAS float* part = (LAS float*)lds;
#pragma unroll
    for (int rb = 0; rb < 2; ++rb)
#pragma unroll
        for (int cb = 0; cb < 2; ++cb) {
            f32x16_t acc = {0.f, 0.f, 0.f, 0.f, 0.f, 0.f, 0.f, 0.f, 0.f, 0.f, 0.f, 0.f, 0.f, 0.f, 0.f, 0.f};
#pragma unroll
            for (int ks = 0; ks < 8; ++ks) acc = __builtin_amdgcn_mfma_f32_32x32x16_bf16(af[rb][ks], bfr[cb][ks], acc, 0, 0, 0);
#pragma unroll
            for (int g = 0; g < 16; ++g) part[((wave * 4 + rb * 2 + cb) * 16 + g) * 64 + lane] = acc[g];
        }
    __syncthreads();
#pragma unroll
    for (int i = 0; i < 8; ++i) {
        const int o = tid + 512 * i; const int ln = o & 63, g = (o >> 6) & 15, t4 = o >> 10;
        float v = 0.f;
#pragma unroll
        for (int w = 0; w < 8; ++w) v += part[((w * 4 + t4) * 16 + g) * 64 + ln];
        const int row = row0 + 32 * (t4 >> 1) + (g & 3) + 8 * (g >> 2) + 4 * (ln >> 5), col = col0 + 32 * (t4 & 1) + (ln & 31);
        if (MODE == 0) Obf[(size_t)row * ldo + col] = f2bf(v);
        else X[(size_t)row * D + col] = Xin[(size_t)row * D + col] + gate[(size_t)row_seq(row) * 6144 + col] * v;
    }
    __syncthreads();
}
constexpr int NTHR = 512;
constexpr int CONV_TOPK_ROWS = 19456, CONV_Q_ITEMS = (2 * NEXP - CONV_TOPK_ROWS) / 128;
constexpr int Q_PROMPT = 8 * 2 * (32 - APS_QB0) + 8 * APS_QB0;
constexpr int Q_ATT = Q_PROMPT + 256;
constexpr int QEND = ((Q_ATT - 1) / 4) * 5 + ((Q_ATT - 1) % 4) + 1;
static_assert(CONV_TOPK_ROWS % 4 == 0 && CONV_TOPK_ROWS < 2 * NEXP && 5 * (CONV_Q_ITEMS - 1) + 4 < QEND && (2 * NEXP - CONV_TOPK_ROWS) % 128 == 0, "every conversion item needs a queue slot");
constexpr int LDS_BYTES = 147456;

struct Args { P p; unsigned* bar; };

DEVI void tr_item(const float* W, int ldw, int K, bf16_t* WT, int dst_row0, int src_col0, int k0, LAS float* scr, int lane) {
#pragma unroll 8
    for (int i = 0; i < 32; ++i) { const int kk = 2 * i + (lane >> 5); scr[kk * 33 + (lane & 31)] = W[(size_t)(k0 + kk) * ldw + src_col0 + (lane & 31)]; }
    asm volatile("s_waitcnt lgkmcnt(0)" ::: "memory");
    const int c = lane & 7;
#pragma unroll
    for (int j = 0; j < 4; ++j) { const int n = (lane >> 3) + 8 * j; const LAS float* s = scr + (8 * c) * 33 + n;
        uint4 o; o.x = (unsigned)f2bf(s[0 * 33]) | ((unsigned)f2bf(s[1 * 33]) << 16); o.y = (unsigned)f2bf(s[2 * 33]) | ((unsigned)f2bf(s[3 * 33]) << 16);
        o.z = (unsigned)f2bf(s[4 * 33]) | ((unsigned)f2bf(s[5 * 33]) << 16); o.w = (unsigned)f2bf(s[6 * 33]) | ((unsigned)f2bf(s[7 * 33]) << 16);
        *(uint4*)(WT + (size_t)(dst_row0 + n) * K + k0 + 8 * c) = o; }
    asm volatile("s_waitcnt lgkmcnt(0)" ::: "memory");
}

__global__ void __launch_bounds__(NTHR, 2) mega_fwd(Args a) {
    extern __shared__ __attribute__((aligned(16))) unsigned char lds[];
    LAS unsigned* ctl = (LAS unsigned*)(lds + LDS_BYTES - 64);
    if (threadIdx.x < 16) ctl[threadIdx.x] = 0u;
    __syncthreads();
    const unsigned bar_x = (unsigned)__builtin_amdgcn_readfirstlane((int)xcd_barrier_post(a.bar, (volatile LAS unsigned*)ctl).x);
    const long gsz = (long)gridDim.x * NTHR;
    const int lane = threadIdx.x & 63, wave = __builtin_amdgcn_readfirstlane(threadIdx.x >> 6);
    const int gw = blockIdx.x * 8 + wave, NGW = gridDim.x * 8;
#define LPQ() P q_; { __attribute__((address_space(1))) float* go_ = (__attribute__((address_space(1))) float*)a.p.out; __attribute__((address_space(1))) unsigned char* gw2_ = (__attribute__((address_space(1))) unsigned char*)a.p.ws; asm volatile("" : "+s"(go_), "+s"(gw2_)); q_.out = (float*)go_; q_.ws = (unsigned char*)gw2_; }
#define RUN(PH) do { LPQ(); int t_ = threadIdx.x, b_ = blockIdx.x, lr_ = l; asm volatile("" : "+v"(t_), "+s"(b_), "+s"(lr_)); const long g_ = (long)b_ * NTHR + t_; run_phase<PH>(q_, lr_, g_, gsz); } while (0)
#define LAUNDER() LPQ(); int l_ = l, gw_ = gw, lane_ = lane, bid_ = (int)blockIdx.x; asm volatile("" : "+s"(l_), "+s"(gw_), "+v"(lane_), "+s"(bid_)); (void)l_; (void)gw_; (void)lane_; (void)bid_
#define BAR() do { XcdBarrier bb_; bb_.bar = a.bar; asm volatile("" : "+s"(bb_.bar)); unsigned bx_ = bar_x; asm volatile("" : "+s"(bx_)); bb_.x = bx_; bb_.st = (volatile LAS unsigned*)(lds + LDS_BYTES - 64); xcd_barrier(bb_); } while (0)
    { LPQ(); int t_ = threadIdx.x, b_ = blockIdx.x; asm volatile("" : "+v"(t_), "+s"(b_)); mod_phase(q_, (LAS unsigned char*)lds, b_, (int)gridDim.x, t_, __builtin_amdgcn_readfirstlane(t_ >> 6), t_ & 63); }
    { const int l = 0; RUN(PH_PRO_SMALL); RUN(PH_PRO_TAB); }
    { LPQ(); const P& p = q_;
        LAS float* scr = (LAS float*)(lds + wave * 16384);
        constexpr int I_IN = (NP / 32) * 16, I_OUT = (D / 32) * 16, I_Q = (2048 / 32) * 16, I_L = I_IN + I_OUT + I_Q;
        for (int it = gw; it < DEPTH * I_L; it += NGW) {
            const int ll = it / I_L; int r = it % I_L;
            if (r < I_IN) { const int nb = r / 16, kb = r % 16; const int n0 = nb * 32; const int src = n0 < 1280 ? n0 : (n0 < 2048 ? n0 + 8 : n0 + 12);
                tr_item(inp(13) + (size_t)ll * D * DPROJ, DPROJ, D, p.w_in_t() + (size_t)ll * NP * D, n0, src, kb * 64, scr, lane); continue; }
            r -= I_IN;
            if (r < I_OUT) { const int nb = r / 16, kb = r % 16; tr_item(inp(25) + (size_t)ll * D * D, D, D, p.w_out_t() + (size_t)ll * D * D, nb * 32, nb * 32, kb * 64, scr, lane); continue; }
            r -= I_OUT;
            { const int nb = r / 16, kb = r % 16; tr_item(inp(26) + (size_t)ll * D * 2048, 2048, D, p.wq_t() + (size_t)ll * 2048 * D, nb * 32, nb * 32, kb * 64, scr, lane); }
        }
    }
    BAR();
    for (int l = 0; l < DEPTH; ++l) {
        if (l == 0) { { LAUNDER(); adaln_rows<1>(q_, l_, gw_, NGW, lane_, true); } BAR(); }
        { LAUNDER(); pg8::Gemm g{q_.hb(), q_.w_in_t() + (size_t)l_ * NP * D, M, NP, D}; pg8::StaticOrder S; S.init(M, NP, (int)gridDim.x, bid_);
          pg8::EpiBf16 E{q_.proj(), NP};
          pg8::gemm_phase<pg8::EpiBf16, pg8::StaticOrder, true, true>((PG8_LAS unsigned char*)lds, g, S, E); }
        { LAUNDER(); const int rem_ = ((M / 256) * (NP / 256)) % (int)gridDim.x;
          if (rem_ > 0 && ((int)gridDim.x - rem_) * 4 >= (int)gridDim.x) { if (bid_ >= rem_) scan_chunks(q_, l_, gw_ - rem_ * 8, NGW - rem_ * 8, lane_); }
          else scan_chunks(q_, l_, gw_, NGW, lane_);
        }
        BAR();
        { LAUNDER(); int tid_ = threadIdx.x; asm volatile("" : "+v"(tid_)); const int wv_ = __builtin_amdgcn_readfirstlane(tid_ >> 6);
          for (int ci = bid_; ci < NB_P * NCH_P; ci += (int)gridDim.x) ssd_chunk_unit(q_, l_, ci, (LAS unsigned char*)lds, tid_, wv_, tid_ & 63); }
        RUN(PH_CONVSTATE);
        { LAUNDER(); const int nx_ = NB_P * NCH_P - (int)gridDim.x;
          if (nx_ > 0 && nx_ * 2 < (int)gridDim.x) { if (bid_ >= nx_) { rows_qkv(q_, l_, gw_ - nx_ * 8, NGW - nx_ * 8, lane_); scan_fix(q_, gw_ - nx_ * 8, NGW - nx_ * 8, lane_); } }
          else { rows_qkv(q_, l_, gw_, NGW, lane_); scan_fix(q_, gw_, NGW, lane_); } }
        BAR();
        { LAUNDER(); for (int u = bid_; u < 144; u += (int)gridDim.x) mlp_unit(q_, l_, u, wave, lane_); }
        { LPQ(); int t_ = threadIdx.x, b_ = blockIdx.x, lr_ = l; asm volatile("" : "+v"(t_), "+s"(b_), "+s"(lr_)); const long g_ = (long)b_ * NTHR + t_; ssd_scan(q_, lr_, g_, gsz); }
        { LAUNDER(); int tid_ = threadIdx.x; asm volatile("" : "+v"(tid_)); const int wv_ = __builtin_amdgcn_readfirstlane(tid_ >> 6);
          const int sb_ = bid_ - ((int)gridDim.x - NB_S);
          if (sb_ >= 0 && (int)gridDim.x >= NB_S) {
              const int ci = NB_P * NCH_P + sb_;
              ssd_chunk_unit(q_, l_, ci, (LAS unsigned char*)lds, tid_, wv_, tid_ & 63);
              asm volatile("s_waitcnt vmcnt(0)" ::: "memory"); __syncthreads();
              ssd_scan_sample(q_, l_, sb_, tid_);
              asm volatile("s_waitcnt vmcnt(0)" ::: "memory"); __syncthreads();
              ssd_y_unit(q_, l_, ci, (LAS unsigned char*)lds, tid_, wv_, tid_ & 63);
              __syncthreads();
          } }
        { LAUNDER(); int tid_ = threadIdx.x; asm volatile("" : "+v"(tid_)); const int wv_ = __builtin_amdgcn_readfirstlane(tid_ >> 6);
          float mq = fabsf(inp(20)[l_ * 64 + lane_]), mk = fabsf(inp(21)[l_ * 64 + lane_]);
#pragma unroll
          for (int o = 1; o < 64; o <<= 1) { mq = fmaxf(mq, __shfl_xor(mq, o)); mk = fmaxf(mk, __shfl_xor(mk, o)); }
          const float sb2 = 2.02f * 64.f * 0.125f * LOG2E * mq * mk;
          unsigned* qctr = a.bar + 3600 + l_; asm volatile("" : "+s"(qctr));
          LAS int* qslot = (LAS int*)(lds + 81920);
          for (;;) {
              if (tid_ == 0) *qslot = (int)__hip_atomic_fetch_add(qctr, 1u, __ATOMIC_RELAXED, __HIP_MEMORY_SCOPE_AGENT);
              __syncthreads();
              const int it0 = __builtin_amdgcn_readfirstlane(*qslot);
              if (it0 >= QEND) break;
              const int qc = it0 / 5, qr = it0 - 5 * qc;
              if (qr == 4) {
                  if (qc < CONV_Q_ITEMS) peer_tables_fp8(q_, l_, CONV_TOPK_ROWS + qc * 128, CONV_TOPK_ROWS + (qc + 1) * 128, wv_, 8, tid_ & 63);
                  __syncthreads(); continue; }
              const int it = qc * 4 + qr;
              if (it < Q_PROMPT) {
                  static_assert(APS_QB0 == 16, "queue order below assumes 16 split + 16 whole row blocks");
                  const int r_ = it / 24, k_ = it - 24 * r_;
                  if (k_ < 16) { const int bh = k_ >> 1; attn_unit<false>(q_, l_, bh >> 2, bh & 3, 31 - r_, sb2, (LAS unsigned char*)lds, tid_, wv_, tid_ & 63, k_ & 1); }
                  else { const int bh = k_ - 16; attn_unit<false>(q_, l_, bh >> 2, bh & 3, 15 - r_, sb2, (LAS unsigned char*)lds, tid_, wv_, tid_ & 63, -1); } }
              else { const int si = it - Q_PROMPT; attn_unit<true>(q_, l_, si >> 4, (si >> 2) & 3, si & 3, sb2, (LAS unsigned char*)lds, tid_, wv_, tid_ & 63); }
          } }
        BAR();
        { LAUNDER(); int tid_ = threadIdx.x; asm volatile("" : "+v"(tid_)); const int wv_ = __builtin_amdgcn_readfirstlane(tid_ >> 6);
          for (int ci = bid_; ci < NB_P * NCH_P; ci += (int)gridDim.x) ssd_y_unit(q_, l_, ci, (LAS unsigned char*)lds, tid_, wv_, tid_ & 63); }
        { LPQ(); int t_ = threadIdx.x, b_ = blockIdx.x; asm volatile("" : "+v"(t_), "+s"(b_)); const int nx_ = NB_P * NCH_P - (int)gridDim.x;
          if (nx_ > 0 && nx_ * 2 < (int)gridDim.x) { if (b_ >= nx_) attn_sample_combine(q_, (long)(b_ - nx_) * NTHR + t_, gsz - (long)nx_ * NTHR); }
          else attn_sample_combine(q_, (long)b_ * NTHR + t_, gsz);
          attn_prompt_combine(q_, (long)b_ * NTHR + t_, gsz); }
        BAR();
        { LAUNDER(); pg8::Gemm g{q_.mix(), q_.w_out_t() + (size_t)l_ * D * D, M_P, D, D}; pg8::StaticOrder S; S.init(M_P, D, (int)gridDim.x, bid_);
          pg8::EpiResid E{q_.x(), q_.mod() + (size_t)l_ * NSEQ * 6144 + 2 * D, l_ == 0 ? inp(0) : (const float*)q_.x()};
          pg8::gemm_phase<pg8::EpiResid, pg8::StaticOrder, true, true>((PG8_LAS unsigned char*)lds, g, S, E); }
        { LAUNDER(); int tid_ = threadIdx.x; asm volatile("" : "+v"(tid_));
          for (int t = bid_; t < (M_S / 64) * (D / 64); t += (int)gridDim.x)
              light_gemm_tile<1>(q_.mix(), q_.w_out_t() + (size_t)l_ * D * D, M_P + 64 * (t / (D / 64)), 64 * (t % (D / 64)), (bf16_t*)nullptr, 0, q_.x(), l_ == 0 ? inp(1) - (size_t)M_P * D : (const float*)q_.x(), q_.mod() + (size_t)l_ * NSEQ * 6144 + 2 * D, (LAS unsigned char*)lds, tid_, wave, tid_ & 63); }
        BAR();
        { LAUNDER(); adaln_rows<2>(q_, l_, gw_, NGW, lane_); }
        BAR();
        { LAUNDER(); pg8::Gemm g{q_.hb(), q_.wq_t() + (size_t)l_ * 2048 * D, M_P, 2048, D}; pg8::StaticOrder S; S.init(M_P, 2048, (int)gridDim.x, bid_);
          pg8::EpiBf16 E{q_.pq(), 2048};
          pg8::gemm_phase<pg8::EpiBf16, pg8::StaticOrder, true, true>((PG8_LAS unsigned char*)lds, g, S, E); }
        { LAUNDER(); int tid_ = threadIdx.x; asm volatile("" : "+v"(tid_));
          for (int t = bid_; t < (M_S / 64) * (2048 / 64); t += (int)gridDim.x)
              light_gemm_tile<0>(q_.hb(), q_.wq_t() + (size_t)l_ * 2048 * D, M_P + 64 * (t / 32), 64 * (t % 32), q_.pq(), 2048, (float*)nullptr, (const float*)nullptr, (const float*)nullptr, (LAS unsigned char*)lds, tid_, wave, tid_ & 63); }
        BAR();
        { LAUNDER();
          for (int u = bid_; u < M / 32; u += (int)gridDim.x)
              peer_topk_unit(q_.pq(), q_.keysb() + (size_t)l_ * 16 * 128 * 128, q_.eidx(), q_.gw(), u * 32, wave, lane_, (LAS unsigned char*)lds + wave * 1024); }
        { LAUNDER(); const int rem_ = (M / 32) % (int)gridDim.x;
          if (rem_ > 0 && ((int)gridDim.x - rem_) * 2 >= (int)gridDim.x) { if (bid_ >= rem_) peer_tables_fp8(q_, l_, 0, CONV_TOPK_ROWS, gw_ - rem_ * 8, NGW - rem_ * 8, lane_); }
          else peer_tables_fp8(q_, l_, 0, CONV_TOPK_ROWS, gw_, NGW, lane_); }
        BAR();
        { LAUNDER();
          for (int tok = gw_; tok < M_P; tok += NGW)
              peer_gather_token_t<8>(q_, l_, 0, -1, (LAS float*)nullptr, q_.u8() + (size_t)l_ * NEXP * D, q_.v8() + (size_t)l_ * NEXP * D, q_.sinv() + (size_t)l_ * NEXP, q_.sinv() + (size_t)(DEPTH + l_) * NEXP, q_.h8(), q_.eidx(), q_.gw(), q_.x(), q_.mod() + (size_t)l_ * NSEQ * 6144 + 5 * D, tok, lane_, (LAS unsigned char*)lds + wave * 1024);
          for (int j = bid_; j < M_S / 4; j += (int)gridDim.x)
              peer_gather_token_t<4>(q_, l_, 4 * (wave >> 2), wave >> 2, (LAS float*)(lds + 8192) + (wave & 3) * 1024, q_.u8() + (size_t)l_ * NEXP * D, q_.v8() + (size_t)l_ * NEXP * D, q_.sinv() + (size_t)l_ * NEXP, q_.sinv() + (size_t)(DEPTH + l_) * NEXP, q_.h8(), q_.eidx(), q_.gw(), q_.x(), q_.mod() + (size_t)l_ * NSEQ * 6144 + 5 * D, M_P + 4 * j + (wave & 3), lane_, (LAS unsigned char*)lds + wave * 1024);
        }
        BAR();
    }
#undef RUN
#undef BAR
}

extern "C" void kernel_launch(void* const* d_in, const int* in_sizes, int n_in, void* d_out, int out_size, void* d_ws, size_t ws_size, hipStream_t stream) {
    static int grid = 0;
    if (grid == 0) {
        int dev = 0, cus = 0;
        (void)hipGetDevice(&dev); (void)hipDeviceGetAttribute(&cus, hipDeviceAttributeMultiprocessorCount, dev);
        (void)hipFuncSetAttribute((const void*)mega_fwd, hipFuncAttributeMaxDynamicSharedMemorySize, LDS_BYTES);
        (void)hipGetLastError();
        grid = cus > 0 ? cus : 256;
    }
    if (ws_size < WS_END || n_in < 30) return;
    Args a{};
    P& p = a.p;
    for (int i = 0; i < 30; ++i) p.in[i] = (const float*)d_in[i];
    p.out = (float*)d_out;
    p.ws = (unsigned char*)d_ws; a.bar = (unsigned*)d_ws;
    (void)hipMemsetAsync(d_ws, 0, 16384, stream);
    hipLaunchKernelGGL(mega_fwd, dim3(grid), dim3(NTHR), LDS_BYTES, stream, a);
}
```

```cpp
#include <hip/hip_runtime.h>
#include <stdint.h>
#include <math.h>

#define DEVI __device__ __forceinline__

constexpr int D = 1024, NB_P = 2, T_P = 8192, NB_S = 16, T_S = 64, PAST = 4096, DEPTH = 4;
constexpr int M_P = NB_P * T_P, M_S = NB_S * T_S, M = M_P + M_S, NSEQ = NB_P + NB_S;
constexpr int DPROJ = 2572, CONVC = 768;
constexpr int S_DT = 1280, S_F = 2056;
constexpr int NP = 2560;
constexpr int O_Z = 0, O_XBC = 512, O_Q = 1280, O_K = 1536, O_V = 1792, O_U = 2048, O_VM = 2304;
constexpr int NCH_P = T_P / 64, NCHUNK = NB_P * NCH_P + NB_S;
constexpr int NEXP = 16384;
constexpr int APS_QB0 = 16;
constexpr int FS_LEN = PAST + T_S;
constexpr float EPS = 1e-6f;

constexpr size_t OUT_Y = 0;
constexpr size_t OUT_KP = (size_t)M * D;
constexpr size_t OUT_VP = OUT_KP + (size_t)DEPTH * M_P * 256;
constexpr size_t OUT_LFP = OUT_VP + (size_t)DEPTH * M_P * 256;
constexpr size_t OUT_SSMP = OUT_LFP + (size_t)DEPTH * M_P * 4;
constexpr size_t OUT_CONVP = OUT_SSMP + (size_t)DEPTH * NB_P * 8 * 64 * 64;
constexpr size_t OUT_KS = OUT_CONVP + (size_t)DEPTH * NB_P * 3 * CONVC;
constexpr size_t OUT_VS = OUT_KS + (size_t)DEPTH * M_S * 256;
constexpr size_t OUT_LFS = OUT_VS + (size_t)DEPTH * M_S * 256;
constexpr size_t OUT_SSMS = OUT_LFS + (size_t)DEPTH * M_S * 4;
constexpr size_t OUT_CONVS = OUT_SSMS + (size_t)DEPTH * NB_S * 8 * 64 * 64;
constexpr size_t OUT_MLPV = OUT_CONVS + (size_t)DEPTH * NB_S * 3 * CONVC;
constexpr size_t OUT_TOTAL = OUT_MLPV + (size_t)DEPTH * M_S * 256;
static_assert(OUT_TOTAL == 57329664, "output size");

typedef unsigned short bf16_t;
DEVI float bf2f(bf16_t v) { return __uint_as_float((unsigned)v << 16); }
DEVI bf16_t f2bf(float f) { unsigned u = __float_as_uint(f); return (bf16_t)((u + 0x7fffu + ((u >> 16) & 1u)) >> 16); }


constexpr size_t al256(size_t x) { return (x + 255) & ~(size_t)255; }
constexpr size_t WS_BAR = 0;
constexpr size_t WS_MOD = 16384;
constexpr size_t WS_RSTD = WS_MOD + al256((size_t)DEPTH * NSEQ * 6144 * 4);
constexpr size_t WS_H = WS_RSTD + al256((size_t)M * 4);
constexpr size_t WS_FLOC = WS_H;
constexpr size_t WS_CSUM = WS_FLOC + al256((size_t)M * 4 * 4);
constexpr size_t WS_HB = WS_CSUM + al256((size_t)(NCHUNK + NB_S * 64) * 4 * 4);
constexpr size_t WS_PROJ = WS_HB + al256((size_t)M * D * 2);
constexpr size_t WS_DTF = WS_PROJ + al256((size_t)M * NP * 2);
constexpr size_t WS_XBC = WS_DTF + al256((size_t)M * 12 * 4);
constexpr size_t WS_DT = WS_XBC + al256((size_t)M * CONVC * 4);
constexpr size_t WS_ACUM = WS_DT + al256((size_t)M * 8 * 4);
constexpr size_t WS_QN = WS_ACUM + al256((size_t)M * 8 * 4);
constexpr size_t WS_QB = WS_QN;
constexpr size_t WS_KB = WS_QB + al256((size_t)M * 256 * 2);
constexpr size_t WS_VB = WS_KB + al256((size_t)M * 256 * 2);
constexpr size_t WS_APART = WS_VB + al256((size_t)M * 256 * 2);
constexpr size_t WS_AML = WS_APART + al256((size_t)NB_S * 16 * 64 * 64 * 4);
constexpr size_t WS_LOGF = WS_AML + al256((size_t)NB_S * 16 * 64 * 2 * 4);
constexpr size_t WS_FP = WS_LOGF + al256((size_t)M * 4 * 4);
constexpr size_t WS_FS = WS_FP + al256((size_t)M_P * 4 * 4);
constexpr size_t WS_VN = WS_FS + al256((size_t)NB_S * FS_LEN * 4 * 4);
constexpr size_t WS_MIX = WS_VN + al256((size_t)M * 256 * 4);
constexpr size_t WS_CB = WS_MIX + al256((size_t)M * D * 2);
constexpr size_t WS_STATES = WS_CB + al256((size_t)NCHUNK * 8192 * 4);
constexpr size_t WS_YZ = WS_STATES + al256((size_t)NCHUNK * 32768 * 4);
constexpr size_t WS_PQ = WS_YZ + al256((size_t)M * 512 * 4);
constexpr size_t WS_TS = WS_PQ + al256((size_t)M * 2048 * 2);
constexpr size_t WS_TI = WS_TS + al256((size_t)M * 256 * 4);
constexpr size_t WS_EIDX = WS_TI + al256((size_t)M * 256 * 4);
constexpr size_t WS_GW = WS_EIDX + al256((size_t)M * 128 * 4);
constexpr size_t WS_COEF = WS_GW + al256((size_t)M * 128 * 4);
constexpr size_t WS_WIN = WS_COEF + al256((size_t)M * 128 * 4);
constexpr size_t WS_WOUT = WS_WIN + al256((size_t)DEPTH * NP * D * 2);
constexpr size_t WS_WQ = WS_WOUT + al256((size_t)DEPTH * D * D * 2);
constexpr size_t WS_WSMALL = WS_WQ + al256((size_t)DEPTH * 2048 * D * 2);
constexpr size_t WS_KEYSB = WS_WSMALL + al256((size_t)DEPTH * 12 * D * 4);
constexpr size_t WS_UT = WS_KEYSB + al256((size_t)DEPTH * 16 * 128 * 128 * 2);
constexpr size_t WS_VT = WS_UT + al256((size_t)DEPTH * NEXP * D * 2);
constexpr size_t WS_SINV = WS_VT + al256((size_t)DEPTH * NEXP * D * 2);
constexpr size_t WS_H8 = WS_SINV + al256((size_t)2 * DEPTH * NEXP * 4);
constexpr size_t WS_END = WS_H8 + al256((size_t)2 * M * D);

struct P {
    const float* in[30];
    float* out;
    unsigned char* ws;
    DEVI float* x() const { return out; }
    DEVI float* mod() const { return (float*)(ws + WS_MOD); }
    DEVI float* rstd() const { return (float*)(ws + WS_RSTD); }
    DEVI float* Floc() const { return (float*)(ws + WS_FLOC); }
    DEVI float* csum() const { return (float*)(ws + WS_CSUM); }
    DEVI bf16_t* hb() const { return (bf16_t*)(ws + WS_HB); }
    DEVI bf16_t* proj() const { return (bf16_t*)(ws + WS_PROJ); }
    DEVI float* dtf() const { return (float*)(ws + WS_DTF); }
    DEVI bf16_t* prevb() const { return (bf16_t*)(ws + WS_XBC); }
    DEVI float* dt() const { return (float*)(ws + WS_DT); }
    DEVI float* acum() const { return (float*)(ws + WS_ACUM); }
    DEVI bf16_t* qb() const { return (bf16_t*)(ws + WS_QB); }
    DEVI bf16_t* kb() const { return (bf16_t*)(ws + WS_KB); }
    DEVI bf16_t* vb() const { return (bf16_t*)(ws + WS_VB); }
    DEVI float* apart() const { return (float*)(ws + WS_APART); }
    DEVI float* aml() const { return (float*)(ws + WS_AML); }
    DEVI float* logf() const { return (float*)(ws + WS_LOGF); }
    DEVI float* Fp() const { return (float*)(ws + WS_FP); }
    DEVI float* Fs() const { return (float*)(ws + WS_FS); }
    DEVI bf16_t* vnb() const { return (bf16_t*)(ws + WS_VN); }
    DEVI bf16_t* mix() const { return (bf16_t*)(ws + WS_MIX); }
    DEVI bf16_t* cact() const { return (bf16_t*)(ws + WS_CB); }
    DEVI float* states() const { return (float*)(ws + WS_STATES); }
    DEVI float* ydg() const { return (float*)(ws + WS_YZ); }
    DEVI bf16_t* pq() const { return (bf16_t*)(ws + WS_PQ); }
    DEVI float* ppart() const { return (float*)(ws + WS_PQ); }
    DEVI float* pml() const { return (float*)(ws + WS_PQ + (size_t)NB_P * 4 * (32 - APS_QB0) * 2 * 256 * 64 * 4); }
    DEVI float* ts() const { return (float*)(ws + WS_TS); }
    DEVI int* ti() const { return (int*)(ws + WS_TI); }
    DEVI int* eidx() const { return (int*)(ws + WS_EIDX); }
    DEVI float* gw() const { return (float*)(ws + WS_GW); }
    DEVI float* coef() const { return (float*)(ws + WS_COEF); }
    DEVI bf16_t* w_in_t() const { return (bf16_t*)(ws + WS_WIN); }
    DEVI bf16_t* w_out_t() const { return (bf16_t*)(ws + WS_WOUT); }
    DEVI bf16_t* wq_t() const { return (bf16_t*)(ws + WS_WQ); }
    DEVI float* wsmall() const { return (float*)(ws + WS_WSMALL); }
    DEVI bf16_t* keysb() const { return (bf16_t*)(ws + WS_KEYSB); }
    DEVI unsigned char* u8() const { return ws + WS_UT; }
    DEVI unsigned char* v8() const { return ws + WS_VT; }
    DEVI float* sinv() const { return (float*)(ws + WS_SINV); }
    DEVI unsigned char* h8() const { return ws + WS_H8; }
};

typedef const float* cfp_t;
#define AS_GLOBAL(T, ptr) ((T*)((__attribute__((address_space(1))) T*)(ptr)))
DEVI cfp_t inp(int i) { const __attribute__((address_space(4))) cfp_t* k = (const __attribute__((address_space(4))) cfp_t*)__builtin_amdgcn_kernarg_segment_ptr(); typedef const __attribute__((address_space(1))) float* gcfp_t; const gcfp_t r = *(const volatile __attribute__((address_space(4))) gcfp_t*)(k + i); return (cfp_t)r; }
DEVI int row_seq(int r) { return r < M_P ? r / T_P : NB_P + (r - M_P) / T_S; }
DEVI int row_t(int r) { return r < M_P ? r % T_P : (r - M_P) % T_S; }
DEVI float silu_f(float x) { return x / (1.f + expf(-x)); }
DEVI float softplus_f(float x) { return x > 20.f ? x : log1pf(expf(x)); }
DEVI float gelu_f(float x) { const float u = 0.7978845608028654f * (x + 0.044715f * x * x * x); return x * __builtin_amdgcn_rcpf(1.f + __expf(-2.f * u)); }
DEVI unsigned pk2bf(float lo, float hi) { unsigned r; asm volatile("v_cvt_pk_bf16_f32 %0, %1, %2" : "=v"(r) : "v"(lo), "v"(hi)); return r; }
typedef float f32x2c_t __attribute__((ext_vector_type(2)));
typedef __bf16 bf16x2c_t __attribute__((ext_vector_type(2)));
DEVI unsigned pk2bf_c(float lo, float hi) { const f32x2c_t v = {lo, hi}; const bf16x2c_t r = __builtin_convertvector(v, bf16x2c_t); return __builtin_bit_cast(unsigned, r); }
#define PROJ(r, c) bf2f(p.proj()[(size_t)(r) * NP + (c)])

namespace pg8 {
#define PG8_LAS __attribute__((address_space(3)))

typedef short bf16x8 __attribute__((ext_vector_type(8)));
typedef float f32x4 __attribute__((ext_vector_type(4)));
typedef unsigned u32x4 __attribute__((ext_vector_type(4)));
constexpr int BM = 256, BK = 64, HALF = 128, HTB = HALF * BK * 2  , STAGE_BYTES = 8 * HTB, NXCD = 8, WGM = 8;

__host__ __device__ __forceinline__ int lds_byte(int r, int c) { const int st = (r >> 4) * 2 + (c >> 5), rr = r & 15, cc = c & 31, ob = rr * 64 + cc * 2; return st * 1024 + (ob ^ (((ob >> 9) & 1) << 5)); }
__host__ __device__ __forceinline__ void stage_rc(int b, int& R, int& C) { const int st = b / 1024, sb = b % 1024, swz = sb ^ (((sb >> 9) & 1) << 5); R = (st >> 1) * 16 + swz / 64; C = (st & 1) * 32 + (swz % 64) / 2; }
__host__ __device__ __forceinline__ int perm32(int rho) { const int n = rho >> 4, i = rho & 15; return 8 * (i >> 2) + 4 * n + (i & 3); }

struct Unit { int pm, pn; };
struct Gemm { const bf16_t* A; const bf16_t* Bt; int M, N, K; };

struct StaticOrder {
    int nM, nN, nwg, G, c;
    __host__ __device__ void init(int M, int N, int G_, int c_) { nM = M / BM; nN = N / BM; nwg = nM * nN; G = G_; c = c_; }
    __host__ __device__ bool next(int i, Unit& u) const {
        const long L = (long)i * G + c; if (L >= nwg) return false;
        int wgid = (int)L; { const int q = nwg / NXCD, r = nwg % NXCD, xcd = wgid % NXCD, off = wgid / NXCD; wgid = (xcd < r ? xcd * (q + 1) : r * (q + 1) + (xcd - r) * q) + off; }
        const int nig = WGM * nN, gid = wgid / nig, fm = gid * WGM, gsz = (nM - fm) < WGM ? (nM - fm) : WGM;
        u.pm = fm + ((wgid % nig) % gsz); u.pn = (wgid % nig) / gsz; return true;
    }
    __device__ __forceinline__ void a_ready(const Unit&) const {}
    __device__ __forceinline__ void done(const Unit&) const {}
};

__device__ __forceinline__ unsigned cvt_pk_bf16(float lo, float hi) { unsigned r; asm volatile("v_cvt_pk_bf16_f32 %0, %1, %2" : "=v"(r) : "v"(lo), "v"(hi)); return r; }
struct EpiBf16 {
    static constexpr bool PERM = true, AFTER_DRAIN = false;
    bf16_t* O; int ldc;
    __device__ __forceinline__ void operator()(const f32x4 (&acc)[2][2][4][2], const Unit& u, int wr, int wc, int fr, int fq) const {
        const int row0 = u.pm * BM + wr * 64 + fr; const int col0 = u.pn * BM + wc * 32 + 8 * fq;
#pragma unroll
        for (int ai = 0; ai < 2; ++ai)
#pragma unroll
            for (int m = 0; m < 4; ++m) { bf16_t* rowp = O + (size_t)(row0 + ai * HALF + m * 16) * ldc + col0;
#pragma unroll
                for (int bj = 0; bj < 2; ++bj) { const f32x4 v0 = acc[ai][bj][m][0], v1 = acc[ai][bj][m][1];
                    u32x4 w; w.x = cvt_pk_bf16(v0[0], v0[1]); w.y = cvt_pk_bf16(v0[2], v0[3]); w.z = cvt_pk_bf16(v1[0], v1[1]); w.w = cvt_pk_bf16(v1[2], v1[3]);
                    *(u32x4*)(rowp + bj * HALF) = w; } }
    }
};
struct EpiResid {
    static constexpr bool PERM = true, AFTER_DRAIN = false;
    float* X; const float* gate; const float* Xin;
    __device__ __forceinline__ void operator()(const f32x4 (&acc)[2][2][4][2], const Unit& u, int wr, int wc, int fr, int fq) const {
        const int row0 = u.pm * BM + wr * 64 + fr; const int col0 = u.pn * BM + wc * 32 + 8 * fq;
#pragma unroll
        for (int ai = 0; ai < 2; ++ai) {
            const int rb = u.pm * BM + ai * HALF + wr * 64;
            const int s = rb < 16384 ? rb / 8192 : 2 + (rb - 16384) / 64;
            const float* gp = gate + (size_t)s * 6144 + col0;
#pragma unroll
            for (int bj = 0; bj < 2; ++bj) { const f32x4 g0 = *(const f32x4*)(gp + bj * HALF), g1 = *(const f32x4*)(gp + bj * HALF + 4);
#pragma unroll
                for (int m = 0; m < 4; ++m) { const size_t xo = (size_t)(row0 + ai * HALF + m * 16) * 1024 + col0 + bj * HALF; float* xp = X + xo; const float* xi = Xin + xo;
                    f32x4 x0 = *(const f32x4*)xi, x1 = *(const f32x4*)(xi + 4);
                    x0 += g0 * acc[ai][bj][m][0]; x1 += g1 * acc[ai][bj][m][1];
                    *(f32x4*)xp = x0; *(f32x4*)(xp + 4) = x1; } }
        }
    }
};

template <class Epi, class Sched, bool ALIGN_EPI = false, bool SP2 = false>
__device__ __forceinline__ void gemm_phase(PG8_LAS unsigned char* lds, const Gemm g, const Sched& S, const Epi& E) {
    int tid_ = threadIdx.x; asm volatile("" : "+v"(tid_));
    const int tid = tid_, wid = __builtin_amdgcn_readfirstlane(tid >> 6), lane = tid & 63, wr = wid >> 2, wc = wid & 3, fr = lane & 15, fq = lane >> 4;
    const int K = g.K, nt = K / BK;
    unsigned voffA[2], voffB[2];
#pragma unroll
    for (int i = 0; i < 2; ++i) { int R, C; stage_rc(tid * 16 + i * 8192, R, C); const int Rb = Epi::PERM ? ((R & ~31) + perm32(R & 31)) : R;
        voffA[i] = (unsigned)(R * K + C) * 2u; voffB[i] = (unsigned)(Rb * K + C) * 2u; }
    const size_t kstep = (size_t)(BK * 2);
    const size_t hstep = (size_t)HALF * K * 2;
    const size_t tstep = 2 * hstep;
    const unsigned ldsw = (unsigned)wid * 1024u;
    const int aoff = lds_byte(wr * 64 + fr, fq * 8), boff = lds_byte(wc * 32 + fr, fq * 8);
#define PG8_SA(b, h) (((b) * 2 + (h)) * HTB)
#define PG8_SB(b, h) ((4 + (b) * 2 + (h)) * HTB)
#define PG8_STAGE(bufoff, gbase, voff) do { _Pragma("unroll") for (int _i = 0; _i < 2; ++_i) \
        __builtin_amdgcn_global_load_lds((const unsigned*)((const char*)(gbase) + (voff)[_i]), (PG8_LAS unsigned*)(lds + (bufoff) + ldsw + _i * 8192), 16, 0, 0); } while (0)
#define PG8_LDA(dst, b, h) do { _Pragma("unroll") for (int m = 0; m < 4; ++m) _Pragma("unroll") for (int k = 0; k < 2; ++k) dst[m][k] = *(const PG8_LAS bf16x8*)(lds + PG8_SA(b, h) + aoff + m * 2048 + k * 1024); } while (0)
#define PG8_LDB(dst, b, h) do { _Pragma("unroll") for (int n = 0; n < 2; ++n) _Pragma("unroll") for (int k = 0; k < 2; ++k) dst[n][k] = *(const PG8_LAS bf16x8*)(lds + PG8_SB(b, h) + boff + n * 2048 + k * 1024); } while (0)
#define PG8_MMA(ai, bj, At, Bt) do { __builtin_amdgcn_s_setprio(1); _Pragma("unroll") for (int m = 0; m < 4; ++m) _Pragma("unroll") for (int n = 0; n < 2; ++n) _Pragma("unroll") for (int k = 0; k < 2; ++k) \
        acc[ai][bj][m][n] = __builtin_amdgcn_mfma_f32_16x16x32_bf16(Bt[n][k], At[m][k], acc[ai][bj][m][n], 0, 0, 0); __builtin_amdgcn_s_setprio(0); } while (0)
#define PG8_WAIT_V(n) asm volatile("s_waitcnt vmcnt(" #n ")" ::: "memory")
#define PG8_WAIT_L(n) asm volatile("s_waitcnt lgkmcnt(" #n ")" ::: "memory")
#define PG8_BAR __builtin_amdgcn_s_barrier()
#define PG8_SCHED __builtin_amdgcn_sched_barrier(0)
    Unit cur, nxt; int ui = 0;
    if (!S.next(0, cur)) return;
    f32x4 acc[2][2][4][2];
#pragma unroll
    for (int a = 0; a < 2; ++a)
#pragma unroll
        for (int b = 0; b < 2; ++b)
#pragma unroll
            for (int m = 0; m < 4; ++m)
#pragma unroll
                for (int n = 0; n < 2; ++n) acc[a][b][m][n] = (f32x4){0.f, 0.f, 0.f, 0.f};
    bf16x8 At[4][2], B0[2][2], B1[2][2];
    const char* cA = (const char*)g.A + (size_t)cur.pm * tstep; const char* cB = (const char*)g.Bt + (size_t)cur.pn * tstep;
    S.a_ready(cur);
    if constexpr (SP2) {
        PG8_STAGE(PG8_SB(0, 0), cB, voffB); PG8_STAGE(PG8_SB(0, 1), cB + hstep, voffB); PG8_STAGE(PG8_SA(0, 0), cA, voffA); PG8_STAGE(PG8_SA(0, 1), cA + hstep, voffA);
        if (wr == 1) PG8_BAR;
        PG8_WAIT_V(2); PG8_BAR;
        PG8_STAGE(PG8_SB(1, 0), cB + kstep, voffB); PG8_STAGE(PG8_SA(1, 0), cA + kstep, voffA); PG8_STAGE(PG8_SB(1, 1), cB + hstep + kstep, voffB);
        PG8_WAIT_V(6); PG8_BAR;
    } else {
        PG8_STAGE(PG8_SB(0, 0), cB, voffB); PG8_STAGE(PG8_SA(0, 0), cA, voffA); PG8_STAGE(PG8_SB(0, 1), cB + hstep, voffB); PG8_STAGE(PG8_SA(0, 1), cA + hstep, voffA);
        if (wr == 1) PG8_BAR;
        PG8_WAIT_V(4); PG8_BAR;
        PG8_STAGE(PG8_SB(1, 0), cB + kstep, voffB); PG8_STAGE(PG8_SA(1, 0), cA + kstep, voffA); PG8_STAGE(PG8_SB(1, 1), cB + hstep + kstep, voffB);
        PG8_WAIT_V(6); PG8_BAR;
    }
    for (;;) {
        const bool has_next = S.next(ui + 1, nxt);
        const char* nA = has_next ? (const char*)g.A + (size_t)nxt.pm * tstep : cA; const char* nB = has_next ? (const char*)g.Bt + (size_t)nxt.pn * tstep : cB;
        for (int t = 0; t < nt; t += 2) {
            const bool last = (t == nt - 2);
            const char* a1 = cA + (size_t)(t + 1) * kstep;
            const char* a2 = last ? nA : cA + (size_t)(t + 2) * kstep; const char* b2 = last ? nB : cB + (size_t)(t + 2) * kstep;
            const char* a3 = a2 + kstep; const char* b3 = b2 + kstep;
            if (last && has_next) S.a_ready(nxt);
            if constexpr (SP2) {
            PG8_LDB(B0, 0, 0); PG8_LDB(B1, 0, 1); PG8_SCHED; PG8_LDA(At, 0, 0); PG8_STAGE(PG8_SA(1, 1), a1 + hstep, voffA);
            PG8_WAIT_V(8); PG8_WAIT_L(0); PG8_BAR; PG8_MMA(0, 0, At, B0); PG8_MMA(0, 1, At, B1); PG8_BAR; PG8_SCHED;
            PG8_LDA(At, 0, 1); PG8_STAGE(PG8_SB(0, 0), b2, voffB); PG8_STAGE(PG8_SB(0, 1), b2 + hstep, voffB); PG8_STAGE(PG8_SA(0, 0), a2, voffA);
            PG8_WAIT_V(8); PG8_WAIT_L(0); PG8_BAR; PG8_MMA(1, 0, At, B0); PG8_MMA(1, 1, At, B1); PG8_BAR; PG8_SCHED;
            PG8_LDB(B0, 1, 0); PG8_LDB(B1, 1, 1); PG8_SCHED; PG8_LDA(At, 1, 0); PG8_STAGE(PG8_SA(0, 1), a2 + hstep, voffA);
            PG8_WAIT_V(8); PG8_WAIT_L(0); PG8_BAR; PG8_MMA(0, 0, At, B0); PG8_MMA(0, 1, At, B1); PG8_BAR; PG8_SCHED;
            PG8_LDA(At, 1, 1); PG8_STAGE(PG8_SB(1, 0), b3, voffB); PG8_STAGE(PG8_SB(1, 1), b3 + hstep, voffB); PG8_STAGE(PG8_SA(1, 0), a3, voffA);
            PG8_WAIT_V(8); PG8_WAIT_L(0); PG8_BAR; PG8_MMA(1, 0, At, B0); PG8_MMA(1, 1, At, B1); PG8_BAR; PG8_SCHED;
            } else {
            PG8_LDB(B0, 0, 0); PG8_SCHED; PG8_LDA(At, 0, 0); PG8_STAGE(PG8_SA(1, 1), a1 + hstep, voffA);
            PG8_WAIT_L(8); PG8_BAR; PG8_WAIT_L(0); PG8_MMA(0, 0, At, B0); PG8_BAR; PG8_SCHED;
            PG8_LDB(B1, 0, 1); PG8_STAGE(PG8_SB(0, 0), b2, voffB);
            PG8_BAR; PG8_WAIT_L(0); PG8_MMA(0, 1, At, B1); PG8_BAR;
            PG8_LDA(At, 0, 1); PG8_STAGE(PG8_SA(0, 0), a2, voffA);
            PG8_BAR; PG8_WAIT_L(0); PG8_MMA(1, 0, At, B0); PG8_BAR; PG8_SCHED;
            PG8_STAGE(PG8_SB(0, 1), b2 + hstep, voffB);
            PG8_WAIT_V(6); PG8_BAR; PG8_MMA(1, 1, At, B1); PG8_BAR;
            PG8_LDB(B0, 1, 0); PG8_SCHED; PG8_LDA(At, 1, 0); PG8_STAGE(PG8_SA(0, 1), a2 + hstep, voffA);
            PG8_WAIT_L(8); PG8_BAR; PG8_WAIT_L(0); PG8_MMA(0, 0, At, B0); PG8_BAR; PG8_SCHED;
            PG8_LDB(B1, 1, 1); PG8_STAGE(PG8_SB(1, 0), b3, voffB);
            PG8_BAR; PG8_WAIT_L(0); PG8_MMA(0, 1, At, B1); PG8_BAR;
            PG8_LDA(At, 1, 1); PG8_STAGE(PG8_SA(1, 0), a3, voffA);
            PG8_BAR; PG8_WAIT_L(0); PG8_MMA(1, 0, At, B0); PG8_BAR; PG8_SCHED;
            PG8_STAGE(PG8_SB(1, 1), b3 + hstep, voffB);
            PG8_WAIT_V(6); PG8_BAR; PG8_MMA(1, 1, At, B1); PG8_BAR;
            }
        }
        if constexpr (ALIGN_EPI) { if (wr == 0) PG8_BAR; }
        if constexpr (!Epi::AFTER_DRAIN) { E(acc, cur, wr, wc, fr, fq); S.done(cur); }
        if (!has_next) break;
#pragma unroll
        for (int a = 0; a < 2; ++a)
#pragma unroll
            for (int b = 0; b < 2; ++b)
#pragma unroll
                for (int m = 0; m < 4; ++m)
#pragma unroll
                    for (int n = 0; n < 2; ++n) acc[a][b][m][n] = (f32x4){0.f, 0.f, 0.f, 0.f};
        cur = nxt; cA = nA; cB = nB; ++ui;
        if constexpr (ALIGN_EPI) { if (wr == 1) PG8_BAR; }
    }
    PG8_WAIT_V(0);
    if constexpr (!ALIGN_EPI) { if (wr == 0) PG8_BAR; }
    PG8_BAR;
    if constexpr (Epi::AFTER_DRAIN) { E.fused(acc, cur, wr, wc, fr, fq, lds, wid, lane); S.done(cur); }
#undef PG8_SA
#undef PG8_SB
#undef PG8_STAGE
#undef PG8_LDA
#undef PG8_LDB
#undef PG8_MMA
#undef PG8_WAIT_V
#undef PG8_WAIT_L
#undef PG8_BAR
#undef PG8_SCHED
}
}


enum { PH_MOD, PH_PRO_SMALL, PH_CONVSTATE, PH_PRO_TAB };

template <int PH> DEVI void run_phase(const P& p, int l, long gtid, long gsz) {
    if constexpr (PH == PH_MOD) {
    } else if constexpr (PH == PH_PRO_SMALL) {
        for (long i = gtid; i < (long)DEPTH * 12 * D; i += gsz) {
            const int k = (int)(i % D), j = (int)((i / D) % 12), ll = (int)(i / (12 * D));
            p.wsmall()[i] = inp(13)[((size_t)ll * D + k) * DPROJ + (j < 8 ? S_DT + j : S_F + (j - 8))];
        }
    } else if constexpr (PH == PH_CONVSTATE) {
        for (long i = gtid; i < (long)NSEQ * 3 * CONVC; i += gsz) {
            const int c = (int)(i % CONVC), j = (int)((i / CONVC) % 3), s = (int)(i / (3 * CONVC));
            const int rlast = s < NB_P ? (s + 1) * T_P - 1 : M_P + (s - NB_P + 1) * T_S - 1;
            const float v = PROJ(rlast - 2 + j, O_XBC + c);
            if (s < NB_P) p.out[OUT_CONVP + (((size_t)l * NB_P + s) * 3 + j) * CONVC + c] = v;
            else p.out[OUT_CONVS + (((size_t)l * NB_S + (s - NB_P)) * 3 + j) * CONVC + c] = v;
        }
    } else if constexpr (PH == PH_PRO_TAB) {
        const float* ks = inp(27); uint4* kd = (uint4*)p.keysb();
        const long NK = (long)DEPTH * 16 * 128 * 128 / 8;
        for (long i = gtid; i < NK; i += gsz) {
            const float* src = ks + i * 8;
            const float4 a = *(const float4*)src, b = *(const float4*)(src + 4);
            uint4 o; o.x = (unsigned)f2bf(a.x) | ((unsigned)f2bf(a.y) << 16); o.y = (unsigned)f2bf(a.z) | ((unsigned)f2bf(a.w) << 16);
            o.z = (unsigned)f2bf(b.x) | ((unsigned)f2bf(b.y) << 16); o.w = (unsigned)f2bf(b.z) | ((unsigned)f2bf(b.w) << 16);
            kd[i] = o;
        }
    }
}
#define XB_TMO      128
#define XB_XCNT(j)  (256  + 64 * (j))
#define XB_XSUB(j)  (1280 + 64 * (j))
#define XB_XGEN(j)  (2304 + 64 * (j))
#define XB_TOP      3328
#define XB_TOPGEN   3392
#define XCD_BAR_WORDS 3456
#define XB_SPIN_CAP (1u << 18)
#define LAS __attribute__((address_space(3)))

__device__ __forceinline__ unsigned xb_ld(unsigned* p)              { return __hip_atomic_load(p, __ATOMIC_RELAXED, __HIP_MEMORY_SCOPE_AGENT); }
__device__ __forceinline__ unsigned xb_add(unsigned* p, unsigned v) { return __hip_atomic_fetch_add(p, v, __ATOMIC_RELAXED, __HIP_MEMORY_SCOPE_AGENT); }
__device__ __forceinline__ unsigned xb_xcc_id() { return (unsigned)__builtin_amdgcn_s_getreg((3 << 11) | 20) & 0xFu; }
#define XB_SPIN(cond, bar) do { unsigned _sp = 0; while (cond) { __builtin_amdgcn_s_sleep(1); \
    if ((++_sp & 255u) == 0u) { if (xb_ld(&(bar)[XB_TMO])) break; if (_sp > XB_SPIN_CAP) { atomicAdd(&(bar)[XB_TMO], 1u); break; } } } } while (0)

struct XcdBarrier { unsigned* bar; unsigned x; volatile LAS unsigned* st; };

__device__ __forceinline__ XcdBarrier xcd_barrier_post(unsigned* bar, volatile LAS unsigned* st) {
    XcdBarrier b; b.bar = bar; b.x = xb_xcc_id(); b.st = st;
    if (threadIdx.x == 0) (void)xb_add(&bar[XB_XCNT(b.x)], 1u);
    return b;
}
__device__ __forceinline__ void xcd_barrier_complete(unsigned* bar, unsigned x, unsigned& nloc, unsigned& nx) {
    const unsigned G = gridDim.x * gridDim.y * gridDim.z;
    unsigned sum, cnt, mine, sp = 0u;
    for (;;) {
        sum = 0u; cnt = 0u; mine = 0u;
#pragma unroll
        for (unsigned j = 0; j < 16; ++j) { const unsigned c = xb_ld(&bar[XB_XCNT(j)]); sum += c; cnt += (c > 0u) ? 1u : 0u; mine = (j == x) ? c : mine; }
        if (sum == G) break;
        __builtin_amdgcn_s_sleep(1);
        if ((++sp & 255u) == 0u) { if (xb_ld(&bar[XB_TMO])) break; if (sp > XB_SPIN_CAP) { atomicAdd(&bar[XB_TMO], 1u); break; } }
    }
    nloc = mine > 0u ? mine : 1u; nx = cnt > 0u ? cnt : 1u;
}
__device__ __forceinline__ void xcd_barrier(const XcdBarrier& b) {
    asm volatile("s_waitcnt vmcnt(0)" ::: "memory");
    __syncthreads();
    if (threadIdx.x == 0) {
        unsigned* bar = b.bar;
        __builtin_amdgcn_s_waitcnt(0);
        unsigned nloc = b.st[0], nx = b.st[1];
        if (nloc == 0u) { xcd_barrier_complete(bar, b.x, nloc, nx); b.st[0] = nloc; b.st[1] = nx; }
        const unsigned old = xb_add(&bar[XB_XSUB(b.x)], 1u);
        const unsigned gen = old / nloc;
        if (old + 1u == (gen + 1u) * nloc) {
            __builtin_amdgcn_fence(__ATOMIC_RELEASE, "agent");
            asm volatile("s_waitcnt vmcnt(0)" ::: "memory");
            const unsigned og = xb_add(&bar[XB_TOP], 1u);
            const unsigned tg = og / nx;
            if (og + 1u == (tg + 1u) * nx) xb_add(&bar[XB_TOPGEN], 1u);
            else XB_SPIN(xb_ld(&bar[XB_TOPGEN]) == tg, bar);
            __builtin_amdgcn_fence(__ATOMIC_ACQUIRE, "agent");
            xb_add(&bar[XB_XGEN(b.x)], 1u);
            asm volatile("s_waitcnt vmcnt(0)" ::: "memory");
        } else {
            XB_SPIN(xb_ld(&bar[XB_XGEN(b.x)]) == gen, bar);
            __builtin_amdgcn_fence(__ATOMIC_ACQUIRE, "agent");
            asm volatile("s_waitcnt vmcnt(0)" ::: "memory");
        }
    }
    __syncthreads();
}

typedef short bf16x8_t __attribute__((ext_vector_type(8)));
typedef float f32x4_t __attribute__((ext_vector_type(4)));
typedef float f32x16_t __attribute__((ext_vector_type(16)));
typedef unsigned u32x4_t __attribute__((ext_vector_type(4)));
typedef unsigned u32x2_t __attribute__((ext_vector_type(2)));
typedef float f32x2_t __attribute__((ext_vector_type(2)));

DEVI unsigned mono_u(float f) { const unsigned u = __float_as_uint(f); return u ^ ((unsigned)((int)u >> 31) | 0x80000000u); }
DEVI float unmono_f(unsigned m) { return __uint_as_float((m & 0x80000000u) ? (m ^ 0x80000000u) : ~m); }
DEVI unsigned umax_(unsigned a, unsigned b) { return a > b ? a : b; }
DEVI unsigned umin_(unsigned a, unsigned b) { return a < b ? a : b; }

#define CE_(x_, y_) do { const unsigned mx_ = umax_(x_, y_), mn_ = umin_(x_, y_); x_ = mx_; y_ = mn_; } while (0)
DEVI void sort16_desc(unsigned (&v)[16]) {
    CE_(v[0], v[1]); CE_(v[3], v[2]); CE_(v[4], v[5]); CE_(v[7], v[6]); CE_(v[8], v[9]); CE_(v[11], v[10]); CE_(v[12], v[13]); CE_(v[15], v[14]);
    CE_(v[0], v[2]); CE_(v[1], v[3]); CE_(v[6], v[4]); CE_(v[7], v[5]); CE_(v[8], v[10]); CE_(v[9], v[11]); CE_(v[14], v[12]); CE_(v[15], v[13]);
    CE_(v[0], v[1]); CE_(v[2], v[3]); CE_(v[5], v[4]); CE_(v[7], v[6]); CE_(v[8], v[9]); CE_(v[10], v[11]); CE_(v[13], v[12]); CE_(v[15], v[14]);
    CE_(v[0], v[4]); CE_(v[1], v[5]); CE_(v[2], v[6]); CE_(v[3], v[7]); CE_(v[12], v[8]); CE_(v[13], v[9]); CE_(v[14], v[10]); CE_(v[15], v[11]);
    CE_(v[0], v[2]); CE_(v[1], v[3]); CE_(v[4], v[6]); CE_(v[5], v[7]); CE_(v[10], v[8]); CE_(v[11], v[9]); CE_(v[14], v[12]); CE_(v[15], v[13]);
    CE_(v[0], v[1]); CE_(v[2], v[3]); CE_(v[4], v[5]); CE_(v[6], v[7]); CE_(v[9], v[8]); CE_(v[11], v[10]); CE_(v[13], v[12]); CE_(v[15], v[14]);
    CE_(v[0], v[8]); CE_(v[1], v[9]); CE_(v[2], v[10]); CE_(v[3], v[11]); CE_(v[4], v[12]); CE_(v[5], v[13]); CE_(v[6], v[14]); CE_(v[7], v[15]);
    CE_(v[0], v[4]); CE_(v[1], v[5]); CE_(v[2], v[6]); CE_(v[3], v[7]); CE_(v[8], v[12]); CE_(v[9], v[13]); CE_(v[10], v[14]); CE_(v[11], v[15]);
    CE_(v[0], v[2]); CE_(v[1], v[3]); CE_(v[4], v[6]); CE_(v[5], v[7]); CE_(v[8], v[10]); CE_(v[9], v[11]); CE_(v[12], v[14]); CE_(v[13], v[15]);
    CE_(v[0], v[1]); CE_(v[2], v[3]); CE_(v[4], v[5]); CE_(v[6], v[7]); CE_(v[8], v[9]); CE_(v[10], v[11]); CE_(v[12], v[13]); CE_(v[14], v[15]);
}
DEVI void merge16_desc(unsigned (&a)[16], const unsigned (&b)[16]) {
    a[0] = umax_(a[0], b[15]); a[1] = umax_(a[1], b[14]); a[2] = umax_(a[2], b[13]); a[3] = umax_(a[3], b[12]); a[4] = umax_(a[4], b[11]); a[5] = umax_(a[5], b[10]); a[6] = umax_(a[6], b[9]); a[7] = umax_(a[7], b[8]); a[8] = umax_(a[8], b[7]); a[9] = umax_(a[9], b[6]); a[10] = umax_(a[10], b[5]); a[11] = umax_(a[11], b[4]); a[12] = umax_(a[12], b[3]); a[13] = umax_(a[13], b[2]); a[14] = umax_(a[14], b[1]); a[15] = umax_(a[15], b[0]);
    CE_(a[0], a[8]); CE_(a[1], a[9]); CE_(a[2], a[10]); CE_(a[3], a[11]); CE_(a[4], a[12]); CE_(a[5], a[13]); CE_(a[6], a[14]); CE_(a[7], a[15]);
    CE_(a[0], a[4]); CE_(a[1], a[5]); CE_(a[2], a[6]); CE_(a[3], a[7]); CE_(a[8], a[12]); CE_(a[9], a[13]); CE_(a[10], a[14]); CE_(a[11], a[15]);
    CE_(a[0], a[2]); CE_(a[1], a[3]); CE_(a[4], a[6]); CE_(a[5], a[7]); CE_(a[8], a[10]); CE_(a[9], a[11]); CE_(a[12], a[14]); CE_(a[13], a[15]);
    CE_(a[0], a[1]); CE_(a[2], a[3]); CE_(a[4], a[5]); CE_(a[6], a[7]); CE_(a[8], a[9]); CE_(a[10], a[11]); CE_(a[12], a[13]); CE_(a[14], a[15]);
}

DEVI void peer_topk_unit(const bf16_t* pq, const bf16_t* keysb, int* eidx, float* gwv, int r0, int wave, int lane, LAS unsigned char* wl  ) {
    const int col = lane & 31, h = lane >> 5; const int r = r0 + col;
    unsigned S[2][16];
    bf16x8_t bq[8], acur[8], anxt[8];
    { const bf16_t* qp = pq + (size_t)r * 2048 + (wave * 2) * 128 + 8 * h;
#pragma unroll
      for (int s = 0; s < 8; ++s) bq[s] = *(const bf16x8_t*)(qp + s * 16);
      const bf16_t* kp = keysb + ((size_t)((wave * 2) * 128 + col) * 128 + 8 * h);
#pragma unroll
      for (int s = 0; s < 8; ++s) acur[s] = *(const bf16x8_t*)(kp + s * 16); }
    unsigned run[16];
#pragma unroll
    for (int blkid = 0; blkid < 8; ++blkid) {
        const int half = blkid >> 2, kb = blkid & 3, hh2 = wave * 2 + half;
        if (blkid + 1 < 8) { const int nh = (blkid + 1) >> 2, nkb = (blkid + 1) & 3; const bf16_t* kp = keysb + ((size_t)((wave * 2 + nh) * 128 + nkb * 32 + col) * 128 + 8 * h);
#pragma unroll
            for (int s = 0; s < 8; ++s) anxt[s] = *(const bf16x8_t*)(kp + s * 16); }
        f32x16_t d = {0.f, 0.f, 0.f, 0.f, 0.f, 0.f, 0.f, 0.f, 0.f, 0.f, 0.f, 0.f, 0.f, 0.f, 0.f, 0.f};
#pragma unroll
        for (int s = 0; s < 8; ++s) d = __builtin_amdgcn_mfma_f32_32x32x16_bf16(acur[s], bq[s], d, 0, 0, 0);
        if (blkid == 3) { const bf16_t* qp = pq + (size_t)r * 2048 + (wave * 2 + 1) * 128 + 8 * h;
#pragma unroll
            for (int s = 0; s < 8; ++s) bq[s] = *(const bf16x8_t*)(qp + s * 16); }
        unsigned blk[16];
#pragma unroll
        for (int g = 0; g < 16; ++g) { const int kidx = kb * 32 + (g & 3) + 8 * (g >> 2) + 4 * h; blk[g] = (mono_u(d[g]) & ~127u) | (unsigned)(127 - kidx); }
        sort16_desc(blk);
        if (kb == 0) {
#pragma unroll
            for (int i = 0; i < 16; ++i) run[i] = blk[i];
        } else merge16_desc(run, blk);
        if (kb == 3) {
            unsigned oth[16];
#pragma unroll
            for (int i = 0; i < 16; ++i) oth[i] = (unsigned)__shfl_xor((int)run[i], 32);
            merge16_desc(run, oth);
#pragma unroll
            for (int i = 0; i < 16; ++i) S[half][i] = run[i];
        }
#pragma unroll
        for (int s = 0; s < 8; ++s) acur[s] = anxt[s];
        __builtin_amdgcn_sched_barrier(0);
        (void)hh2;
    }
    {
        unsigned w0[4], w1[4];
#pragma unroll
        for (int q = 0; q < 4; ++q) { w0[q] = 0u; w1[q] = 0u;
#pragma unroll
            for (int b = 0; b < 4; ++b) { w0[q] |= (127u - (S[0][q * 4 + b] & 127u)) << (8 * b); w1[q] |= (127u - (S[1][q * 4 + b] & 127u)) << (8 * b); } }
        if (h == 0) { LAS u32x4_t* dst = (LAS u32x4_t*)(wl + col * 32); dst[0] = (u32x4_t){w0[0], w0[1], w0[2], w0[3]}; dst[1] = (u32x4_t){w1[0], w1[1], w1[2], w1[3]}; }
    }
    __builtin_amdgcn_sched_barrier(0);
    float T0[16], T1[16];
#pragma unroll
    for (int i = 0; i < 16; ++i) { const unsigned u0 = S[0][i] & ~127u, u1 = S[1][i] & ~127u; T0[i] = unmono_f(h ? u1 : u0); T1[i] = unmono_f(h ? u0 : u1); }
    __builtin_amdgcn_sched_barrier(0);
    unsigned ca[16], cb2[16];
#define MKC(a_, b_) ((mono_u(T0[a_] + T1[b_]) & ~255u) | (255u - (h ? (unsigned)((b_) * 16 + (a_)) : (unsigned)((a_) * 16 + (b_)))))
    ca[0] = MKC(0, 1);
    ca[1] = MKC(0, 2);
    ca[2] = MKC(0, 3);
    ca[3] = MKC(0, 4);
    ca[4] = MKC(0, 5);
    ca[5] = MKC(0, 6);
    ca[6] = MKC(0, 7);
    ca[7] = MKC(0, 8);
    ca[8] = MKC(0, 9);
    ca[9] = MKC(0, 10);
    ca[10] = MKC(0, 11);
    ca[11] = MKC(0, 12);
    ca[12] = MKC(0, 13);
    ca[13] = MKC(0, 14);
    ca[14] = MKC(0, 15);
    ca[15] = h ? 0u : MKC(0, 0);
    cb2[0] = MKC(1, 2);
    cb2[1] = MKC(1, 3);
    cb2[2] = MKC(1, 4);
    cb2[3] = MKC(1, 5);
    cb2[4] = MKC(1, 6);
    cb2[5] = MKC(1, 7);
    cb2[6] = MKC(2, 3);
    cb2[7] = MKC(2, 4);
    cb2[8] = h ? 0u : MKC(1, 1);
    cb2[9] = h ? 0u : MKC(2, 2);
    cb2[10] = h ? 0u : MKC(3, 3);
    cb2[11] = 0u;
    cb2[12] = 0u;
    cb2[13] = 0u;
    cb2[14] = 0u;
    cb2[15] = 0u;
#undef MKC
    sort16_desc(ca); sort16_desc(cb2); merge16_desc(ca, cb2);
    {
        unsigned oth[16];
#pragma unroll
        for (int i = 0; i < 16; ++i) oth[i] = (unsigned)__shfl_xor((int)ca[i], 32);
        merge16_desc(ca, oth);
    }
    float e[16]; float sum = 0.f; const float s0 = unmono_f(ca[0] & ~255u);
#pragma unroll
    for (int j = 0; j < 16; ++j) { e[j] = __expf(unmono_f(ca[j] & ~255u) - s0); sum += e[j]; }
    const float inv = 1.f / sum;
    const LAS unsigned char* lb = wl + col * 32;
    int ex[8]; float gx[8]; const unsigned hm = h ? 0xffffffffu : 0u;
#pragma unroll
    for (int jj = 0; jj < 8; ++jj) {
        const unsigned kj = ca[jj] ^ ((ca[jj] ^ ca[8 + jj]) & hm); const float ej = __uint_as_float(__float_as_uint(e[jj]) ^ ((__float_as_uint(e[jj]) ^ __float_as_uint(e[8 + jj])) & hm));
        const unsigned pos = 255u - (kj & 255u); const int i0 = lb[pos >> 4], i1 = lb[16 + (pos & 15u)];
        ex[jj] = i0 * 128 + i1; gx[jj] = ej * inv;
    }
    int* ep = eidx + (size_t)r * 128 + wave * 16 + 8 * h; float* gp = gwv + (size_t)r * 128 + wave * 16 + 8 * h;
    *(int4*)ep = make_int4(ex[0], ex[1], ex[2], ex[3]); *(int4*)(ep + 4) = make_int4(ex[4], ex[5], ex[6], ex[7]);
    *(float4*)gp = make_float4(gx[0], gx[1], gx[2], gx[3]); *(float4*)(gp + 4) = make_float4(gx[4], gx[5], gx[6], gx[7]);
}

DEVI void adaln_apply_1(const P& p, int l, int r, int lane, float (&v)[16]);
DEVI unsigned pk4fp8(float a, float b, float c, float d) { int w = 0; w = __builtin_amdgcn_cvt_pk_fp8_f32(a, b, w, false); w = __builtin_amdgcn_cvt_pk_fp8_f32(c, d, w, true); return (unsigned)w; }
DEVI void peer_tables_fp8(const P& p, int ll  , int rbeg, int rend, int gw, int NGW, int lane) {
    const float* us = inp(28) + (size_t)ll * NEXP * D; const float* vs = inp(29) + (size_t)ll * NEXP * D;
    for (int R0 = rbeg + gw * 4; R0 < rend; R0 += NGW * 4) {
        float4 v[4][4]; float am[4];
#pragma unroll
        for (int q = 0; q < 4; ++q) { const int R = R0 + q, tb = R >= NEXP, row = R - tb * NEXP;
            const float4* src = (const float4*)((tb ? vs : us) + (size_t)row * D) + lane;
#pragma unroll
            for (int j = 0; j < 4; ++j) v[q][j] = src[64 * j]; }
#pragma unroll
        for (int q = 0; q < 4; ++q) { float a_ = 0.f;
#pragma unroll
            for (int j = 0; j < 4; ++j) a_ = fmaxf(a_, fmaxf(fmaxf(fabsf(v[q][j].x), fabsf(v[q][j].y)), fmaxf(fabsf(v[q][j].z), fabsf(v[q][j].w))));
#pragma unroll
            for (int o = 1; o < 64; o <<= 1) a_ = fmaxf(a_, __shfl_xor(a_, o));
            am[q] = a_; }
#pragma unroll
        for (int q = 0; q < 4; ++q) { const int R = R0 + q, tb = R >= NEXP, row = ll * NEXP + (R - tb * NEXP);
            const float sc = am[q] > 0.f ? 440.f / am[q] : 1.f;
            unsigned* dst = (unsigned*)((tb ? p.v8() : p.u8()) + (size_t)row * D) + lane;
#pragma unroll
            for (int j = 0; j < 4; ++j) dst[64 * j] = pk4fp8(v[q][j].x * sc, v[q][j].y * sc, v[q][j].z * sc, v[q][j].w * sc);
            if (lane == 0) p.sinv()[(size_t)tb * DEPTH * NEXP + row] = am[q] > 0.f ? am[q] * (1.f / 440.f) : 1.f; }
    }
}

template <int NTL, int PART = 0> DEVI void peer_gather_token_t(const P& p, int l, int tbase, int half, LAS float* xch, const unsigned char* u8, const unsigned char* v8, const float* su, const float* sv, const unsigned char* h8, const int* eidx, const float* gwv, float* x,
                            const float* gate2  , int r, int lane, LAS unsigned char* wl) {
    const int n16 = lane & 15, kq = lane >> 4;
    LAS u32x2_t* pl = (LAS u32x2_t*)wl;
    if (PART != 2) {
    int e[NTL]; float g[NTL], s_u[NTL], s_v[NTL];
#pragma unroll
    for (int t = 0; t < NTL; ++t) { e[t] = eidx[(size_t)r * 128 + (tbase + t) * 16 + n16]; g[t] = gwv[(size_t)r * 128 + (tbase + t) * 16 + n16]; }
#pragma unroll
    for (int t = 0; t < NTL; ++t) { s_u[t] = su[e[t]]; s_v[t] = sv[e[t]]; }
    const unsigned char* up[NTL];
#pragma unroll
    for (int t = 0; t < NTL; ++t) up[t] = u8 + (size_t)e[t] * D + kq * 16;
    const unsigned char* hp = h8 + (n16 < 8 ? (size_t)0 : (size_t)M * D) + (size_t)r * D + kq * 16;
    f32x4_t acc[NTL];
#pragma unroll
    for (int t = 0; t < NTL; ++t) acc[t] = (f32x4_t){0.f, 0.f, 0.f, 0.f};
    u32x4_t b0[NTL], b1[NTL];
#pragma unroll
    for (int t = 0; t < NTL; ++t) { b0[t] = *(const u32x4_t*)(up[t]); b1[t] = *(const u32x4_t*)(up[t] + 64); }
#define FP8MM(av, bv, c) do { const long al_ = (long)(((unsigned long long)(av).y << 32) | (av).x), ah_ = (long)(((unsigned long long)(av).w << 32) | (av).z); \
        const long bl_ = (long)(((unsigned long long)(bv).y << 32) | (bv).x), bh_ = (long)(((unsigned long long)(bv).w << 32) | (bv).z); \
        c = __builtin_amdgcn_mfma_f32_16x16x32_fp8_fp8(al_, bl_, c, 0, 0, 0); c = __builtin_amdgcn_mfma_f32_16x16x32_fp8_fp8(ah_, bh_, c, 0, 0, 0); } while (0)
    for (int m = 0; m < 16; m += 2) {
        const u32x4_t a0 = *(const u32x4_t*)(hp + m * 64), a1 = *(const u32x4_t*)(hp + m * 64 + 64);
#pragma unroll
        for (int t = 0; t < NTL; ++t) FP8MM(a0, b0[t], acc[t]);
        if (m + 2 < 16) {
#pragma unroll
            for (int t = 0; t < NTL; ++t) b0[t] = *(const u32x4_t*)(up[t] + (m + 2) * 64);
        }
#pragma unroll
        for (int t = 0; t < NTL; ++t) FP8MM(a1, b1[t], acc[t]);
        if (m + 3 < 16) {
#pragma unroll
            for (int t = 0; t < NTL; ++t) b1[t] = *(const u32x4_t*)(up[t] + (m + 3) * 64);
        }
    }
#undef FP8MM
#pragma unroll
    for (int t = 0; t < NTL; ++t) { const float lo = __shfl_xor(acc[t][0], 32); const float dot = (acc[t][0] + lo * (1.f / 32.f)) * s_u[t];
        if (kq == 0) pl[t * 16 + n16] = (u32x2_t){(unsigned)e[t], __float_as_uint(g[t] * gelu_f(dot) * s_v[t])}; }
    }
    if (PART == 1) return;
    float o[16];
#pragma unroll
    for (int i = 0; i < 16; ++i) o[i] = 0.f;
    for (int j0 = 0; j0 < NTL * 16; j0 += 16) {
        u32x4_t w[16]; float cj[16];
#pragma unroll
        for (int jj = 0; jj < 16; ++jj) { const u32x2_t pr = pl[j0 + jj]; const int ej = __builtin_amdgcn_readfirstlane((int)pr.x); cj[jj] = __uint_as_float(pr.y);
            w[jj] = *(const u32x4_t*)(v8 + (size_t)ej * D + 16 * lane); }
#pragma unroll
        for (int jj = 0; jj < 16; ++jj) { const float c = cj[jj];
#pragma unroll
            for (int q = 0; q < 4; ++q) { const f32x2_t lo = __builtin_amdgcn_cvt_pk_f32_fp8((int)w[jj][q], false), hi = __builtin_amdgcn_cvt_pk_f32_fp8((int)w[jj][q], true);
                o[4 * q] += c * lo[0]; o[4 * q + 1] += c * lo[1]; o[4 * q + 2] += c * hi[0]; o[4 * q + 3] += c * hi[1]; } }
    }
    if (NTL < 8) {
        if (half == 1) {
#pragma unroll
            for (int q = 0; q < 4; ++q) *(LAS f32x4_t*)(xch + lane * 16 + 4 * q) = (f32x4_t){o[4 * q], o[4 * q + 1], o[4 * q + 2], o[4 * q + 3]};
        }
        __syncthreads();
        if (half == 1) return;
#pragma unroll
        for (int q = 0; q < 4; ++q) { const f32x4_t t4 = *(const LAS f32x4_t*)(xch + lane * 16 + 4 * q); o[4 * q] += t4[0]; o[4 * q + 1] += t4[1]; o[4 * q + 2] += t4[2]; o[4 * q + 3] += t4[3]; }
    }
    const float* gp = gate2 + (size_t)row_seq(r) * 6144 + 16 * lane;
    float* xp = x + (size_t)r * D + 16 * lane;
#pragma unroll
    for (int q = 0; q < 4; ++q) {
        float4 xa = *(const float4*)(xp + 4 * q); const float4 ga = *(const float4*)(gp + 4 * q);
        xa.x += ga.x * o[4 * q]; xa.y += ga.y * o[4 * q + 1]; xa.z += ga.z * o[4 * q + 2]; xa.w += ga.w * o[4 * q + 3];
        *(float4*)(xp + 4 * q) = xa;
        o[4 * q] = xa.x; o[4 * q + 1] = xa.y; o[4 * q + 2] = xa.z; o[4 * q + 3] = xa.w;
    }
    __builtin_amdgcn_sched_barrier(0);
    if (l + 1 < DEPTH) adaln_apply_1(p, l + 1, r, lane, o);
}


DEVI float wave_sum(float v) {
#pragma unroll
    for (int o = 1; o < 64; o <<= 1) v += __shfl_xor(v, o);
    return v;
}
DEVI float wave_incl_scan(float v, int lane) {
#pragma unroll
    for (int o = 1; o < 64; o <<= 1) { const float t = __shfl_up(v, o); if (lane >= o) v += t; }
    return v;
}
template <int WHICH> DEVI void adaln_apply(const P& p, int l, int r, int lane_in, float (&v)[16]) {
    int lane = lane_in; asm volatile("" : "+v"(lane));
    const float* g = inp(WHICH == 1 ? 9 : 10) + (size_t)l * D + 16 * lane;
    const int osh = (WHICH == 1 ? 0 : 3) * D, osc = (WHICH == 1 ? 1 : 4) * D;
    float ss = 0.f;
#pragma unroll
    for (int i = 0; i < 16; ++i) ss += v[i] * v[i];
    const float rstd = rsqrtf(wave_sum(ss) * (1.f / D) + EPS);
    const float* md = p.mod() + ((size_t)l * NSEQ + row_seq(r)) * 6144 + 16 * lane;
#pragma unroll
    for (int q = 0; q < 4; ++q) {
        const float4 gg = *(const float4*)(g + 4 * q), sc = *(const float4*)(md + osc + 4 * q), sh = *(const float4*)(md + osh + 4 * q);
        v[4 * q] = v[4 * q] * rstd * gg.x * (1.f + sc.x) + sh.x; v[4 * q + 1] = v[4 * q + 1] * rstd * gg.y * (1.f + sc.y) + sh.y;
        v[4 * q + 2] = v[4 * q + 2] * rstd * gg.z * (1.f + sc.z) + sh.z; v[4 * q + 3] = v[4 * q + 3] * rstd * gg.w * (1.f + sc.w) + sh.w;
    }
    u32x4_t* ob = (u32x4_t*)(p.hb() + (size_t)r * D + 16 * lane);
    ob[0] = (u32x4_t){pk2bf(v[0], v[1]), pk2bf(v[2], v[3]), pk2bf(v[4], v[5]), pk2bf(v[6], v[7])};
    ob[1] = (u32x4_t){pk2bf(v[8], v[9]), pk2bf(v[10], v[11]), pk2bf(v[12], v[13]), pk2bf(v[14], v[15])};
    if constexpr (WHICH == 2) {
        unsigned hi8[4], lo8[4];
#pragma unroll
        for (int q = 0; q < 4; ++q) { hi8[q] = pk4fp8(v[4 * q], v[4 * q + 1], v[4 * q + 2], v[4 * q + 3]);
            const f32x2_t h01 = __builtin_amdgcn_cvt_pk_f32_fp8((int)hi8[q], false), h23 = __builtin_amdgcn_cvt_pk_f32_fp8((int)hi8[q], true);
            lo8[q] = pk4fp8((v[4 * q] - h01[0]) * 32.f, (v[4 * q + 1] - h01[1]) * 32.f, (v[4 * q + 2] - h23[0]) * 32.f, (v[4 * q + 3] - h23[1]) * 32.f); }
        *(u32x4_t*)(p.h8() + (size_t)r * D + 16 * lane) = (u32x4_t){hi8[0], hi8[1], hi8[2], hi8[3]};
        *(u32x4_t*)(p.h8() + (size_t)M * D + (size_t)r * D + 16 * lane) = (u32x4_t){lo8[0], lo8[1], lo8[2], lo8[3]};
    }
    if constexpr (WHICH == 1) {
        const float* dtb = inp(16) + l * 8; const float* fb = inp(22) + l * 4;
        const float* ws = p.wsmall() + (size_t)l * 12 * D + 16 * lane;
        float dot[12];
#pragma unroll
        for (int jj = 0; jj < 12; ++jj) { float a = 0.f;
#pragma unroll
            for (int q = 0; q < 4; ++q) { const float4 w = *(const float4*)(ws + (size_t)jj * D + 4 * q); a += v[4 * q] * w.x + v[4 * q + 1] * w.y + v[4 * q + 2] * w.z + v[4 * q + 3] * w.w; }
            dot[jj] = wave_sum(a); }
        if (lane < 8) {
            float d = dot[0];
#pragma unroll
            for (int jj = 1; jj < 8; ++jj) d = (lane == jj) ? dot[jj] : d;
            p.dt()[(size_t)r * 8 + lane] = softplus_f(d + dtb[lane]);
        } else if (lane < 12) {
            const int hd = lane - 8; float d = dot[8];
#pragma unroll
            for (int jj = 9; jj < 12; ++jj) d = (lane == jj) ? dot[jj] : d;
            const float lf = -softplus_f(-(d + fb[hd]));
            p.logf()[(size_t)r * 4 + hd] = lf;
            if (r < M_P) p.out[OUT_LFP + ((size_t)l * M_P + r) * 4 + hd] = lf; else p.out[OUT_LFS + ((size_t)l * M_S + (r - M_P)) * 4 + hd] = lf;
        }
    }
}
template <int WHICH> DEVI void adaln_rows(const P& p, int l, int gw, int NGW, int lane, bool from_inputs = false) {
    const float* xp_ = from_inputs ? inp(0) : p.x(); const float* xs_ = from_inputs ? inp(1) - (size_t)M_P * D : p.x();
    float4 nx[4];
    if (gw < M) {
#pragma unroll
        for (int q = 0; q < 4; ++q) nx[q] = ((const float4*)((gw < M_P ? xp_ : xs_) + (size_t)gw * D + 16 * lane))[q]; }
    for (int r = gw; r < M; r += NGW) {
        float v[16];
#pragma unroll
        for (int q = 0; q < 4; ++q) { v[4 * q] = nx[q].x; v[4 * q + 1] = nx[q].y; v[4 * q + 2] = nx[q].z; v[4 * q + 3] = nx[q].w; }
        if (r + NGW < M) { const int rn = r + NGW;
#pragma unroll
            for (int q = 0; q < 4; ++q) nx[q] = ((const float4*)((rn < M_P ? xp_ : xs_) + (size_t)rn * D + 16 * lane))[q]; }
        adaln_apply<WHICH>(p, l, r, lane, v);
    }
}
DEVI void scan_chunks(const P& p, int l, int gw, int NGW, int lane) {
    const float* alog = inp(17) + l * 8; const float* clf = inp(6) + (size_t)l * NB_S * PAST * 4;
    for (int ci = gw; ci < NCHUNK + NB_S * 64; ci += NGW) {
        if (ci < NCHUNK) {
            const size_t r = (size_t)ci * 64 + lane;
            const float4 d0 = *(const float4*)(p.dt() + r * 8), d1 = *(const float4*)(p.dt() + r * 8 + 4);
            float a[8] = {d0.x, d0.y, d0.z, d0.w, d1.x, d1.y, d1.z, d1.w};
#pragma unroll
            for (int hh = 0; hh < 8; ++hh) a[hh] = wave_incl_scan(a[hh] * -__expf(alog[hh]), lane);
            *(float4*)(p.acum() + r * 8) = make_float4(a[0], a[1], a[2], a[3]); *(float4*)(p.acum() + r * 8 + 4) = make_float4(a[4], a[5], a[6], a[7]);
            const float4 lf = *(const float4*)(p.logf() + r * 4);
            float f[4] = {lf.x, lf.y, lf.z, lf.w};
#pragma unroll
            for (int hd = 0; hd < 4; ++hd) f[hd] = wave_incl_scan(f[hd], lane);
            *(float4*)(p.Floc() + r * 4) = make_float4(f[0], f[1], f[2], f[3]);
            if (lane == 63) *(float4*)(p.csum() + (size_t)ci * 4) = make_float4(f[0], f[1], f[2], f[3]);
        } else {
            const int cc = ci - NCHUNK;
            const size_t pos = (size_t)cc * 64 + lane;
            const float4 lf = *(const float4*)(clf + pos * 4);
            float f[4] = {lf.x, lf.y, lf.z, lf.w};
#pragma unroll
            for (int hd = 0; hd < 4; ++hd) f[hd] = wave_incl_scan(f[hd], lane);
            const int b = cc / 64, pin = (cc % 64) * 64 + lane;
            *(float4*)(p.Fs() + ((size_t)b * FS_LEN + pin) * 4) = make_float4(f[0], f[1], f[2], f[3]);
            if (lane == 63) *(float4*)(p.csum() + (size_t)ci * 4) = make_float4(f[0], f[1], f[2], f[3]);
        }
    }
}
DEVI void scan_fix(const P& p, int gw, int NGW, int lane) {
    for (int ci = gw; ci < NB_P * NCH_P + NB_S * 65; ci += NGW) {
        float o[4] = {0.f, 0.f, 0.f, 0.f};
        if (ci < NB_P * NCH_P) {
            const int s = ci / NCH_P, c = ci % NCH_P;
#pragma unroll
            for (int q = 0; q < 2; ++q) { const int cc = lane + 64 * q; if (cc < c) { const float4 t = *(const float4*)(p.csum() + ((size_t)s * NCH_P + cc) * 4); o[0] += t.x; o[1] += t.y; o[2] += t.z; o[3] += t.w; } }
#pragma unroll
            for (int hd = 0; hd < 4; ++hd) o[hd] = wave_sum(o[hd]);
            const size_t r = (size_t)ci * 64 + lane; const float4 f = *(const float4*)(p.Floc() + r * 4);
            *(float4*)(p.Fp() + r * 4) = make_float4(f.x + o[0], f.y + o[1], f.z + o[2], f.w + o[3]);
        } else {
            const int cs = ci - NB_P * NCH_P; const int b = cs / 65, c = cs % 65;
            if (lane < c) { const float4 t = *(const float4*)(p.csum() + ((size_t)NCHUNK + b * 64 + lane) * 4); o[0] += t.x; o[1] += t.y; o[2] += t.z; o[3] += t.w; }
#pragma unroll
            for (int hd = 0; hd < 4; ++hd) o[hd] = wave_sum(o[hd]);
            float4* dst = (float4*)(p.Fs() + ((size_t)b * FS_LEN + c * 64 + lane) * 4);
            float4 f;
            if (c < 64) f = *dst; else f = *(const float4*)(p.Floc() + ((size_t)M_P + b * 64 + lane) * 4);
            *dst = make_float4(f.x + o[0], f.y + o[1], f.z + o[2], f.w + o[3]);
        }
    }
}

DEVI void adaln_apply_1(const P& p, int l, int r, int lane, float (&v)[16]) { adaln_apply<1>(p, l, r, lane, v); }


constexpr float LOG2E = 1.4426950408889634f;
constexpr int ATT_KP = 144, ATT_VP = 136;
constexpr int ATT_VOFF = 64 * ATT_KP, ATT_GOFF = ATT_VOFF + 64 * ATT_VP, ATT_BUF = 18432;
static_assert(ATT_GOFF + 256 <= ATT_BUF, "attention tile buffer");

template <bool DIAG> DEVI void attn_tile(const LAS unsigned char* buf, int t, int qpos, int qi, int g, float gq, const bf16x8_t (&qf)[2], float& m, float& lsum, f32x4_t (&O)[4]) {
    f32x4_t st[4];
#pragma unroll
            for (int kb = 0; kb < 4; ++kb) {
                const bf16x8_t a0 = *(const LAS bf16x8_t*)(buf + (kb * 16 + qi) * ATT_KP + 16 * g), a1 = *(const LAS bf16x8_t*)(buf + (kb * 16 + qi) * ATT_KP + 64 + 16 * g);
                const f32x4_t gk = *(const LAS f32x4_t*)(buf + ATT_GOFF + (kb * 16 + 4 * g) * 4);
                const f32x4_t bias = {gq - gk[0], gq - gk[1], gq - gk[2], gq - gk[3]};
                st[kb] = __builtin_amdgcn_mfma_f32_16x16x32_bf16(a0, qf[0], bias, 0, 0, 0);
                st[kb] = __builtin_amdgcn_mfma_f32_16x16x32_bf16(a1, qf[1], st[kb], 0, 0, 0);
            }
            float mx = -INFINITY;
#pragma unroll
            for (int kb = 0; kb < 4; ++kb) {
#pragma unroll
                for (int e = 0; e < 4; ++e) { float s = st[kb][e]; if (DIAG && (t * 64 + kb * 16 + 4 * g + e > qpos)) s = -INFINITY; st[kb][e] = s; mx = fmaxf(mx, s); } }
            mx = fmaxf(mx, __shfl_xor(mx, 16)); mx = fmaxf(mx, __shfl_xor(mx, 32));
            const float mn = fmaxf(m, mx), alpha = __builtin_amdgcn_exp2f(m - mn); m = mn;
            float ps = 0.f;
#pragma unroll
            for (int kb = 0; kb < 4; ++kb)
#pragma unroll
                for (int e = 0; e < 4; ++e) { const float pe = __builtin_amdgcn_exp2f(st[kb][e] - mn); st[kb][e] = pe; ps += pe; }
            lsum = lsum * alpha + ps;
#pragma unroll
            for (int dt = 0; dt < 4; ++dt) O[dt] *= alpha;
#pragma unroll
            for (int ks = 0; ks < 2; ++ks) {
                u32x4_t pw = {pk2bf(st[2 * ks][0], st[2 * ks][1]), pk2bf(st[2 * ks][2], st[2 * ks][3]), pk2bf(st[2 * ks + 1][0], st[2 * ks + 1][1]), pk2bf(st[2 * ks + 1][2], st[2 * ks + 1][3])};
                const bf16x8_t pf = __builtin_bit_cast(bf16x8_t, pw);
#pragma unroll
                for (int dt = 0; dt < 4; ++dt) {
                    const LAS unsigned char* vp = buf + ATT_VOFF + (dt * 16 + qi) * ATT_VP + (32 * ks + 4 * g) * 2;
                    const u32x2_t lo = *(const LAS u32x2_t*)vp, hi = *(const LAS u32x2_t*)(vp + 32);
                    const u32x4_t aw = {lo.x, lo.y, hi.x, hi.y};
                    O[dt] = __builtin_amdgcn_mfma_f32_16x16x32_bf16(__builtin_bit_cast(bf16x8_t, aw), pf, O[dt], 0, 0, 0);
                }
            }
}
template <bool DIAG, bool FIX, int NQ> DEVI void attn_pair(const LAS unsigned char* buf, int tA, const int (&qpos)[NQ], int qi, int g, const float (&gq)[NQ], const bf16x8_t (&qf)[NQ][2], float (&m)[NQ], float (&lsum)[NQ], f32x4_t (&O)[NQ][4], f32x4_t (&OL)[NQ]) {
#pragma unroll
    for (int hf = 0; hf < 2; ++hf) {
        const LAS unsigned char* tbuf = buf + hf * ATT_BUF; const int k0 = (tA - hf) * 64;
        f32x4_t st[NQ][4];
#pragma unroll
        for (int kb = 0; kb < 4; ++kb) {
            const LAS unsigned char* tb = tbuf + (kb * 16 + qi) * ATT_KP;
            const bf16x8_t a0 = *(const LAS bf16x8_t*)(tb + 16 * g), a1 = *(const LAS bf16x8_t*)(tb + 64 + 16 * g);
            const f32x4_t gk = *(const LAS f32x4_t*)(tbuf + ATT_GOFF + (kb * 16 + 4 * g) * 4);
#pragma unroll
            for (int j = 0; j < NQ; ++j) {
                const f32x4_t bias = {gq[j] - gk[0], gq[j] - gk[1], gq[j] - gk[2], gq[j] - gk[3]};
                st[j][kb] = __builtin_amdgcn_mfma_f32_16x16x32_bf16(a0, qf[j][0], bias, 0, 0, 0);
                st[j][kb] = __builtin_amdgcn_mfma_f32_16x16x32_bf16(a1, qf[j][1], st[j][kb], 0, 0, 0);
            }
            if (NQ > 1) __builtin_amdgcn_sched_barrier(0);
        }
#pragma unroll
        for (int j = 0; j < NQ; ++j) {
            if (NQ > 1) __builtin_amdgcn_sched_barrier(0);
            if (FIX) {
#pragma unroll
                for (int kb = 0; kb < 4; ++kb)
#pragma unroll
                    for (int e = 0; e < 4; ++e) { float s = st[j][kb][e]; if (DIAG && (k0 + kb * 16 + 4 * g + e > qpos[j])) s = -INFINITY; st[j][kb][e] = __builtin_amdgcn_exp2f(s); }
            } else {
                float mx = -INFINITY;
#pragma unroll
                for (int kb = 0; kb < 4; ++kb) {
#pragma unroll
                    for (int e = 0; e < 4; ++e) { float s = st[j][kb][e]; if (DIAG && (k0 + kb * 16 + 4 * g + e > qpos[j])) s = -INFINITY; st[j][kb][e] = s; mx = fmaxf(mx, s); } }
                mx = fmaxf(mx, __shfl_xor(mx, 16)); mx = fmaxf(mx, __shfl_xor(mx, 32));
                const float mn = fmaxf(m[j], mx);
                if (mn == -INFINITY) {
#pragma unroll
                    for (int kb = 0; kb < 4; ++kb) st[j][kb] = (f32x4_t){0.f, 0.f, 0.f, 0.f};
                } else {
                    const float alpha = __builtin_amdgcn_exp2f(m[j] - mn); m[j] = mn;
                    float ps = 0.f;
#pragma unroll
                    for (int kb = 0; kb < 4; ++kb)
#pragma unroll
                        for (int e = 0; e < 4; ++e) { const float pe = __builtin_amdgcn_exp2f(st[j][kb][e] - mn); st[j][kb][e] = pe; ps += pe; }
                    lsum[j] = lsum[j] * alpha + ps;
#pragma unroll
                    for (int dt = 0; dt < 4; ++dt) O[j][dt] *= alpha;
                }
            }
        }
#pragma unroll
        for (int ks = 0; ks < 2; ++ks) {
            bf16x8_t pf[NQ];
#pragma unroll
            for (int j = 0; j < NQ; ++j) {
                u32x4_t pw = {pk2bf_c(st[j][2 * ks][0], st[j][2 * ks][1]), pk2bf_c(st[j][2 * ks][2], st[j][2 * ks][3]), pk2bf_c(st[j][2 * ks + 1][0], st[j][2 * ks + 1][1]), pk2bf_c(st[j][2 * ks + 1][2], st[j][2 * ks + 1][3])};
                pf[j] = __builtin_bit_cast(bf16x8_t, pw);
                if (FIX) { const unsigned o2 = qi == 0 ? 0x3f803f80u : 0u; const u32x4_t ow = {o2, o2, o2, o2}; OL[j] = __builtin_amdgcn_mfma_f32_16x16x32_bf16(__builtin_bit_cast(bf16x8_t, ow), pf[j], OL[j], 0, 0, 0); }
            }
#pragma unroll
            for (int dt = 0; dt < 4; ++dt) {
                const LAS unsigned char* vp = tbuf + ATT_VOFF + (dt * 16 + qi) * ATT_VP + (32 * ks + 4 * g) * 2;
                const u32x2_t lo = *(const LAS u32x2_t*)vp, hi = *(const LAS u32x2_t*)(vp + 32);
                const u32x4_t aw = {lo.x, lo.y, hi.x, hi.y};
#pragma unroll
                for (int j = 0; j < NQ; ++j) O[j][dt] = __builtin_amdgcn_mfma_f32_16x16x32_bf16(__builtin_bit_cast(bf16x8_t, aw), pf[j], O[j][dt], 0, 0, 0);
            }
            if (NQ > 1) __builtin_amdgcn_sched_barrier(0);
        }
        __builtin_amdgcn_sched_barrier(0);
    }
}
template <bool SAMPLE> DEVI void attn_unit(const P& p, int l, int b, int h, int qb_or_sp, float sbound2  , LAS unsigned char* lds, int tid, int wave, int lane, int part = -1) {
    asm volatile("" : "+v"(lane), "+v"(tid), "+s"(wave));
    const int qi = lane & 15, g = lane >> 4;
    const bf16_t* Qb = p.qb(); const bf16_t* Kb = p.kb(); const bf16_t* Vb = p.vb();
    constexpr int NQ = SAMPLE ? 1 : 2;
    int t0, t1, nwav, qlo; int qpos[NQ]; size_t qrow[NQ];
    const float* Fk;
    if constexpr (!SAMPLE) { const int q0 = qb_or_sp * 256; t0 = 0; t1 = (q0 + 256) / 64; qlo = q0 + 32 * wave; nwav = 8; Fk = p.Fp() + (size_t)b * T_P * 4;
#pragma unroll
        for (int j = 0; j < NQ; ++j) { qpos[j] = qlo + 16 * j + qi; qrow[j] = (size_t)b * T_P + qpos[j]; }
        if (part == 0) t0 = t1 / 2; else if (part == 1) t1 = t1 / 2; }
    else { const int sp = qb_or_sp; t0 = sp * 16; t1 = sp == 3 ? 66 : sp * 16 + 16;        qlo = PAST + 16 * (wave & 3); qpos[0] = qlo + qi; qrow[0] = (size_t)M_P + b * T_S + 16 * (wave & 3) + qi; nwav = 4; Fk = p.Fs() + (size_t)b * FS_LEN * 4; }
    const float* ck = inp(4) + ((size_t)l * NB_S + b) * PAST * 256; const float* cv = inp(5) + ((size_t)l * NB_S + b) * PAST * 256;
    const bool active = wave < nwav;
    const bool fix = sbound2 < 96.f;
    bf16x8_t qf[NQ][2]; float gqx[NQ], m[NQ], lsum[NQ]; f32x4_t O[NQ][4], OL[NQ];
#pragma unroll
    for (int j = 0; j < NQ; ++j) {
        qf[j][0] = *(const bf16x8_t*)(Qb + qrow[j] * 256 + h * 64 + 8 * g); qf[j][1] = *(const bf16x8_t*)(Qb + qrow[j] * 256 + h * 64 + 32 + 8 * g);
        const float gq = Fk[(size_t)qpos[j] * 4 + h] * LOG2E;
        gqx[j] = fix ? gq - 0.5f * sbound2 : gq; m[j] = fix ? 0.f : -INFINITY; lsum[j] = 0.f; OL[j] = (f32x4_t){0.f, 0.f, 0.f, 0.f};
#pragma unroll
        for (int dt = 0; dt < 4; ++dt) O[j][dt] = (f32x4_t){0.f, 0.f, 0.f, 0.f};
    }
    u32x4_t kreg0, vreg0, kreg1, vreg1; float greg0 = 0.f, greg1 = 0.f;
    int kkey = tid >> 3, kpc = tid & 7, vkey = tid & 63, vdg = tid >> 6;
#define ATT_LOAD(t, kreg, vreg, greg) do { const int k0_ = (t) * 64; \
        if (SAMPLE && (t) < 64) { \
            const float* ks_ = ck + ((size_t)(k0_ + kkey) * 4 + h) * 64 + kpc * 8; const float4 a_ = *(const float4*)ks_, b_ = *(const float4*)(ks_ + 4); \
            kreg = (u32x4_t){pk2bf(a_.x, a_.y), pk2bf(a_.z, a_.w), pk2bf(b_.x, b_.y), pk2bf(b_.z, b_.w)}; \
            const float* vs_ = cv + ((size_t)(k0_ + vkey) * 4 + h) * 64 + vdg * 8; const float4 c_ = *(const float4*)vs_, d_ = *(const float4*)(vs_ + 4); \
            vreg = (u32x4_t){pk2bf(c_.x, c_.y), pk2bf(c_.z, c_.w), pk2bf(d_.x, d_.y), pk2bf(d_.z, d_.w)}; \
        } else { const size_t rb_ = SAMPLE ? (size_t)M_P + b * T_S : (size_t)b * T_P + k0_; \
            kreg = *(const u32x4_t*)(Kb + (rb_ + kkey) * 256 + h * 64 + kpc * 8); vreg = *(const u32x4_t*)(Vb + (rb_ + vkey) * 256 + h * 64 + vdg * 8); } \
        if (tid < 64) greg = Fk[(size_t)(k0_ + tid) * 4 + h] * LOG2E; } while (0)
#define ATT_STORE(buf, kreg, vreg, greg) do { \
        *(LAS u32x4_t*)((buf) + kkey * ATT_KP + kpc * 16) = kreg; \
        { LAS unsigned short* vt = (LAS unsigned short*)((buf) + ATT_VOFF) + (vdg * 8) * (ATT_VP / 2) + vkey; \
          _Pragma("unroll") for (int i = 0; i < 4; ++i) { vt[(2 * i) * (ATT_VP / 2)] = (unsigned short)(vreg[i] & 0xffffu); vt[(2 * i + 1) * (ATT_VP / 2)] = (unsigned short)(vreg[i] >> 16); } } \
        if (tid < 64) ((LAS float*)((buf) + ATT_GOFF))[tid] = greg; } while (0)
    ATT_LOAD(t1 - 1, kreg0, vreg0, greg0); ATT_LOAD(t1 - 2, kreg1, vreg1, greg1);
    int cur = 0;
    for (int t = t1 - 1; t >= t0; t -= 2) {
        { int tl = tid; asm volatile("" : "+v"(tl)); kkey = tl >> 3; kpc = tl & 7; vkey = tl & 63; vdg = tl >> 6; }
        if (!SAMPLE && (Fk[(size_t)qb_or_sp * 256 * 4 + h] - Fk[(size_t)(t * 64 + 63) * 4 + h]) * LOG2E + sbound2 < -152.f) break;
        LAS unsigned char* buf = lds + cur * (2 * ATT_BUF);
        ATT_STORE(buf, kreg0, vreg0, greg0); ATT_STORE(buf + ATT_BUF, kreg1, vreg1, greg1);
        __syncthreads();
        if (t - 2 >= t0) { ATT_LOAD(t - 2, kreg0, vreg0, greg0); ATT_LOAD(t - 3, kreg1, vreg1, greg1); }
        if (active && (SAMPLE || (t - 1) * 64 <= qlo + 31)) {
            const bool dg = t * 64 + 63 > qlo;
            if (fix) { if (dg) attn_pair<true, true, NQ>(buf, t, qpos, qi, g, gqx, qf, m, lsum, O, OL); else attn_pair<false, true, NQ>(buf, t, qpos, qi, g, gqx, qf, m, lsum, O, OL); }
            else { if (dg) attn_pair<true, false, NQ>(buf, t, qpos, qi, g, gqx, qf, m, lsum, O, OL); else attn_pair<false, false, NQ>(buf, t, qpos, qi, g, gqx, qf, m, lsum, O, OL); } }
        cur ^= 1;
    }
#undef ATT_STORE
#undef ATT_LOAD
    if (active) {
#pragma unroll
        for (int j = 0; j < NQ; ++j) {
            float ls = lsum[j];
            if (fix) ls = __shfl(OL[j][0], qi);
            else { ls += __shfl_xor(ls, 16); ls += __shfl_xor(ls, 32); }
            if constexpr (!SAMPLE) {
                if (part >= 0) {
                    const size_t u = ((size_t)(((b * 4 + h) * (32 - APS_QB0) + (qb_or_sp - APS_QB0)) * 2 + part)) * 256 + 32 * wave + 16 * j + qi;
                    float* op = p.ppart() + u * 64 + 4 * g;
#pragma unroll
                    for (int dt = 0; dt < 4; ++dt) *(float4*)(op + 16 * dt) = make_float4(O[j][dt][0], O[j][dt][1], O[j][dt][2], O[j][dt][3]);
                    if (g == 0) { p.pml()[u * 2] = m[j]; p.pml()[u * 2 + 1] = ls; }
                    continue;
                }
                const float inv = 1.f / ls; bf16_t* op = p.mix() + qrow[j] * D + 512 + h * 64 + 4 * g;
#pragma unroll
                for (int dt = 0; dt < 4; ++dt) { uint2 o; o.x = pk2bf(O[j][dt][0] * inv, O[j][dt][1] * inv); o.y = pk2bf(O[j][dt][2] * inv, O[j][dt][3] * inv); *(uint2*)(op + 16 * dt) = o; }
            } else {
                const size_t u = ((size_t)(b * 4 + h) * 4 + qb_or_sp) * 64 + 16 * (wave & 3) + qi;
                float* op = p.apart() + u * 64 + 4 * g;
#pragma unroll
                for (int dt = 0; dt < 4; ++dt) *(float4*)(op + 16 * dt) = make_float4(O[j][dt][0], O[j][dt][1], O[j][dt][2], O[j][dt][3]);
                if (g == 0) { p.aml()[u * 2] = m[j]; p.aml()[u * 2 + 1] = ls; }
            }
        }
    }
    __syncthreads();
}
DEVI void attn_sample_combine(const P& p, long gtid, long gsz) {
    for (long i = gtid; i < (long)NB_S * 4 * 64 * 16; i += gsz) {
        const int d4 = (int)(i % 16), q = (int)((i / 16) % 64), bh = (int)(i / 1024);
        float mm = -INFINITY; float ms[4], ls[4];
#pragma unroll
        for (int s = 0; s < 4; ++s) { const size_t u = ((size_t)bh * 4 + s) * 64 + q; ms[s] = p.aml()[u * 2]; ls[s] = p.aml()[u * 2 + 1]; mm = fmaxf(mm, ms[s]); }
        float L = 0.f; float4 o = make_float4(0.f, 0.f, 0.f, 0.f);
#pragma unroll
        for (int s = 0; s < 4; ++s) { const float w = __builtin_amdgcn_exp2f(ms[s] - mm); L += w * ls[s]; const float4 a = *(const float4*)(p.apart() + (((size_t)bh * 4 + s) * 64 + q) * 64 + d4 * 4);
            o.x += w * a.x; o.y += w * a.y; o.z += w * a.z; o.w += w * a.w; }
        const float inv = 1.f / L; const int b = bh / 4, h = bh % 4;
        uint2 w2; w2.x = pk2bf(o.x * inv, o.y * inv); w2.y = pk2bf(o.z * inv, o.w * inv);
        *(uint2*)(p.mix() + ((size_t)M_P + b * T_S + q) * D + 512 + h * 64 + d4 * 4) = w2;
    }
}

DEVI void attn_prompt_combine(const P& p, long gtid, long gsz) {
    for (long i = gtid; i < (long)NB_P * 4 * (32 - APS_QB0) * 256 * 16; i += gsz) {
        const int d4 = (int)(i % 16), r = (int)((i / 16) % 256), un = (int)(i / 4096);
        const size_t u0 = ((size_t)un * 2) * 256 + r, u1 = u0 + 256;
        const float m0 = p.pml()[u0 * 2], l0 = p.pml()[u0 * 2 + 1], m1 = p.pml()[u1 * 2], l1 = p.pml()[u1 * 2 + 1];
        const float mm = fmaxf(m0, m1);
        const float w0 = __builtin_amdgcn_exp2f(m0 - mm), w1 = __builtin_amdgcn_exp2f(m1 - mm);
        const float4 a = *(const float4*)(p.ppart() + u0 * 64 + d4 * 4), c = *(const float4*)(p.ppart() + u1 * 64 + d4 * 4);
        const float inv = 1.f / (w0 * l0 + w1 * l1);
        const int qb = APS_QB0 + un % (32 - APS_QB0), bh = un / (32 - APS_QB0), b = bh / 4, h = bh % 4;
        uint2 w2; w2.x = pk2bf((w0 * a.x + w1 * c.x) * inv, (w0 * a.y + w1 * c.y) * inv); w2.y = pk2bf((w0 * a.z + w1 * c.z) * inv, (w0 * a.w + w1 * c.w) * inv);
        *(uint2*)(p.mix() + ((size_t)b * T_P + qb * 256 + r) * D + 512 + h * 64 + d4 * 4) = w2;
    }
}
constexpr int SSD_BCP = 528;
constexpr int SSD_BFRAG = 64 * SSD_BCP;
constexpr int SSD_SC = SSD_BFRAG + 16384;
constexpr int SSD_RAW = SSD_SC + 3 * 2048;
constexpr int SSD_RAWW = 67 * 128;
constexpr int SSD_LDS = SSD_RAW + 8 * SSD_RAWW;
static_assert(SSD_LDS <= 147456 - 64, "SSD chunk LDS");
DEVI float silu_fast(float x) { return x / (1.f + __expf(-x)); }

template <int NC16> DEVI void stage_raw(const bf16_t* proj, int r0, int col0, const float* hist, int hcol0, bool first_chunk, LAS unsigned char* rawb, int lane) {
    constexpr int RPI = 64 / NC16;
#pragma unroll
    for (int i = 0; i * RPI < 67; ++i) {
        const int row = i * RPI + lane / NC16, pc = lane % NC16;
        if (row < 67) { const int s = row - 3; u32x4_t v = {0u, 0u, 0u, 0u};
            if (s >= 0 || !first_chunk) v = *(const u32x4_t*)(proj + (size_t)(r0 + s) * NP + col0 + pc * 8);
            else if (hist) { const float* hp = hist + (3 + s) * CONVC + hcol0 + pc * 8; v = (u32x4_t){pk2bf(hp[0], hp[1]), pk2bf(hp[2], hp[3]), pk2bf(hp[4], hp[5]), pk2bf(hp[6], hp[7])}; }
            *(LAS u32x4_t*)(rawb + row * 128 + pc * 16) = v; }
    }
}
DEVI void conv_block(const LAS unsigned short* raw, float w0, float w1, float w2, float w3, float bs, int hh, float (&out)[32]) {
    const LAS unsigned short* rb = raw + (4 * hh) * 64;
#pragma unroll
    for (int j = 0; j < 8; ++j) {
        float rw[7];
#pragma unroll
        for (int i = 0; i < 7; ++i) rw[i] = bf2f(rb[(8 * j + i) * 64]);
#pragma unroll
        for (int e = 0; e < 4; ++e) out[4 * j + e] = silu_fast(bs + w0 * rw[e] + w1 * rw[e + 1] + w2 * rw[e + 2] + w3 * rw[e + 3]);
    }
}
DEVI bf16x8_t pack8(float a0, float a1, float a2, float a3, float a4, float a5, float a6, float a7) {
    const u32x4_t w = {pk2bf_c(a0, a1), pk2bf_c(a2, a3), pk2bf_c(a4, a5), pk2bf_c(a6, a7)}; return __builtin_bit_cast(bf16x8_t, w);
}

DEVI void ssd_chunk_unit(const P& p, int l, int ci, LAS unsigned char* lds, int tid, int wave, int lane) {
    const int c32 = lane & 31, hh = lane >> 5, r0 = ci * 64, g = wave >> 2;
    const int seq = ci < NB_P * NCH_P ? ci / NCH_P : NB_P + (ci - NB_P * NCH_P);
    const bool first_chunk = ci >= NB_P * NCH_P || (ci % NCH_P) == 0;
    const float* hist = seq >= NB_P ? inp(8) + ((size_t)l * NB_S + (seq - NB_P)) * 3 * CONVC : nullptr;
    const float* cw = inp(14) + (size_t)l * 4 * CONVC; const float* cbias = inp(15) + (size_t)l * CONVC;
    LAS float* acumL = (LAS float*)(lds + SSD_SC); LAS float* dtL = acumL + 512; LAS float* wgtL = dtL + 512;
    {
        const float dtv = p.dt()[(size_t)(r0 + lane) * 8 + wave]; const float A = -__expf(inp(17)[l * 8 + wave]);
        const float ac = wave_incl_scan(dtv * A, lane); const float alast = __shfl(ac, 63);
        p.acum()[(size_t)(r0 + lane) * 8 + wave] = ac;
        acumL[wave * 64 + lane] = ac; dtL[wave * 64 + lane] = dtv; wgtL[wave * 64 + lane] = dtv * __expf(alast - ac);
    }
    {
        float v[32];
        LAS unsigned char* rawb = lds + SSD_RAW + wave * SSD_RAWW;
        stage_raw<4>(p.proj(), r0, O_XBC + 512 + 32 * wave, hist, 512 + 32 * wave, first_chunk, rawb, lane);
        { const int ch = 512 + 32 * wave + c32; conv_block((const LAS unsigned short*)rawb + c32, cw[ch], cw[CONVC + ch], cw[2 * CONVC + ch], cw[3 * CONVC + ch], cbias[ch], hh, v); }
        LAS unsigned short* rowimg = (LAS unsigned short*)lds;
#pragma unroll
        for (int j = 0; j < 8; ++j)
#pragma unroll
            for (int e = 0; e < 4; ++e) rowimg[(8 * j + 4 * hh + e) * (SSD_BCP / 2) + 32 * wave + c32] = f2bf(v[4 * j + e]);
        if (wave < 4) {
#pragma unroll
            for (int ks = 0; ks < 4; ++ks)
                *(LAS bf16x8_t*)(lds + SSD_BFRAG + ((wave * 4 + ks) * 64 + lane) * 16) = pack8(v[8 * ks], v[8 * ks + 1], v[8 * ks + 2], v[8 * ks + 3], v[8 * ks + 4], v[8 * ks + 5], v[8 * ks + 6], v[8 * ks + 7]);
        }
    }
    bf16x8_t xf[2][4];
    __syncthreads();
    const f32x16_t z16 = {0.f, 0.f, 0.f, 0.f, 0.f, 0.f, 0.f, 0.f, 0.f, 0.f, 0.f, 0.f, 0.f, 0.f, 0.f, 0.f};
    stage_raw<8>(p.proj(), r0, O_XBC + 64 * wave, hist, 64 * wave, first_chunk, lds + SSD_RAW + wave * SSD_RAWW, lane);
#pragma unroll
    for (int pb = 0; pb < 2; ++pb) {
        bf16x8_t xs[4];
        {
            float v[32];
            { const int ch = 64 * wave + 32 * pb + c32; conv_block((const LAS unsigned short*)(lds + SSD_RAW + wave * SSD_RAWW) + 32 * pb + c32, cw[ch], cw[CONVC + ch], cw[2 * CONVC + ch], cw[3 * CONVC + ch], cbias[ch], hh, v); }
#pragma unroll
            for (int ks = 0; ks < 4; ++ks) {
                xf[pb][ks] = pack8(v[8 * ks], v[8 * ks + 1], v[8 * ks + 2], v[8 * ks + 3], v[8 * ks + 4], v[8 * ks + 5], v[8 * ks + 6], v[8 * ks + 7]);
                const f32x4_t wa = *(const LAS f32x4_t*)(wgtL + wave * 64 + 16 * ks + 4 * hh), wb = *(const LAS f32x4_t*)(wgtL + wave * 64 + 16 * ks + 8 + 4 * hh);
                xs[ks] = pack8(v[8 * ks] * wa[0], v[8 * ks + 1] * wa[1], v[8 * ks + 2] * wa[2], v[8 * ks + 3] * wa[3], v[8 * ks + 4] * wb[0], v[8 * ks + 5] * wb[1], v[8 * ks + 6] * wb[2], v[8 * ks + 7] * wb[3]);
            }
        }
        __builtin_amdgcn_sched_barrier(0);
#pragma unroll
        for (int nb = 0; nb < 2; ++nb) {
            f32x16_t Z = z16;
#pragma unroll
            for (int ks = 0; ks < 4; ++ks) { const bf16x8_t bfr = *(const LAS bf16x8_t*)(lds + SSD_BFRAG + (((g * 2 + nb) * 4 + ks) * 64 + lane) * 16); Z = __builtin_amdgcn_mfma_f32_32x32x16_bf16(xs[ks], bfr, Z, 0, 0, 0); }
            float* sp = p.states() + ((size_t)(ci * 8 + wave) * 64 + 32 * pb) * 64 + 32 * nb + c32;
#pragma unroll
            for (int e = 0; e < 16; ++e) sp[(size_t)(8 * (e >> 2) + 4 * hh + (e & 3)) * 64] = Z[e];
        }
        __builtin_amdgcn_sched_barrier(0);
    }
    for (int i = tid; i < 64 * 16; i += 512) { const int s = i >> 4, pc = i & 15; *(u32x4_t*)(p.cact() + (size_t)(r0 + s) * 128 + pc * 8) = *(const LAS u32x4_t*)(lds + s * SSD_BCP + 256 + pc * 16); }
    const float dskip = inp(18)[l * 8 + wave];
#pragma unroll
    for (int tb = 0; tb < 2; ++tb) {
        const int t = 32 * tb + c32; const float at = acumL[wave * 64 + t];
        bf16x8_t LT[2][2];
#pragma unroll
        for (int sb = 0; sb <= tb; ++sb) {
            f32x16_t D1 = z16;
#pragma unroll
            for (int kk = 0; kk < 4; ++kk) {
                const bf16x8_t a = *(const LAS bf16x8_t*)(lds + (32 * sb + c32) * SSD_BCP + (g * 64 + 16 * kk + 8 * hh) * 2);
                const bf16x8_t b = *(const LAS bf16x8_t*)(lds + (32 * tb + c32) * SSD_BCP + 256 + (g * 64 + 16 * kk + 8 * hh) * 2);
                D1 = __builtin_amdgcn_mfma_f32_32x32x16_bf16(a, b, D1, 0, 0, 0);
            }
            float lv[16];
#pragma unroll
            for (int q = 0; q < 4; ++q) { const int sq = 32 * sb + 8 * q + 4 * hh;
                const f32x4_t as = *(const LAS f32x4_t*)(acumL + wave * 64 + sq), ds = *(const LAS f32x4_t*)(dtL + wave * 64 + sq);
#pragma unroll
                for (int e = 0; e < 4; ++e) { const int s = sq + e; float val = D1[4 * q + e] * __expf(at - as[e]) * ds[e]; val = (s <= t) ? val : 0.f; val = (s == t) ? val + dskip : val; lv[4 * q + e] = val; } }
            LT[sb][0] = pack8(lv[0], lv[1], lv[2], lv[3], lv[4], lv[5], lv[6], lv[7]); LT[sb][1] = pack8(lv[8], lv[9], lv[10], lv[11], lv[12], lv[13], lv[14], lv[15]);
        }
#pragma unroll
        for (int pb = 0; pb < 2; ++pb) {
            f32x16_t Y = z16;
#pragma unroll
            for (int sb = 0; sb <= tb; ++sb)
#pragma unroll
                for (int kk = 0; kk < 2; ++kk) Y = __builtin_amdgcn_mfma_f32_32x32x16_bf16(xf[pb][2 * sb + kk], LT[sb][kk], Y, 0, 0, 0);
            float* yp = p.ydg() + (size_t)(r0 + t) * 512 + wave * 64 + 32 * pb + 4 * hh;
#pragma unroll
            for (int q = 0; q < 4; ++q) *(float4*)(yp + 8 * q) = make_float4(Y[4 * q], Y[4 * q + 1], Y[4 * q + 2], Y[4 * q + 3]);
        }
    }
    __syncthreads();
}

DEVI void ssd_scan(const P& p, int l, long gtid, long gsz) {
    const float* s0 = inp(7) + (size_t)l * NB_S * 32768;
    for (long i = gtid; i < (long)NB_P * 32768; i += gsz) {
        const int e = (int)(i % 32768), s = (int)(i / 32768); const int hh = e / 4096;
        if (s < NB_P) { float st = 0.f;
            for (int c0 = 0; c0 < NCH_P; c0 += 16) {
                float v[16], dc[16];
#pragma unroll
                for (int k = 0; k < 16; ++k) { const size_t ci = (size_t)s * NCH_P + c0 + k; v[k] = p.states()[ci * 32768 + e]; dc[k] = p.acum()[(ci * 64 + 63) * 8 + hh]; }
#pragma unroll
                for (int k = 0; k < 16; ++k) { const size_t ci = (size_t)s * NCH_P + c0 + k; p.prevb()[ci * 32768 + e] = f2bf(st); st = st * __expf(dc[k]) + v[k]; }
            }
            p.out[OUT_SSMP + ((size_t)l * NB_P + s) * 32768 + e] = st;
        } else { const int b = s - NB_P; const size_t ci = (size_t)NB_P * NCH_P + b; float st = s0[(size_t)b * 32768 + e];
            p.prevb()[ci * 32768 + e] = f2bf(st); st = st * __expf(p.acum()[(ci * 64 + 63) * 8 + hh]) + p.states()[ci * 32768 + e];
            p.out[OUT_SSMS + ((size_t)l * NB_S + b) * 32768 + e] = st; }
    }
}

DEVI void ssd_scan_sample(const P& p, int l, int b, int tid) {
    const float* s0 = inp(7) + ((size_t)l * NB_S + b) * 32768;
    const size_t ci = (size_t)NB_P * NCH_P + b;
#pragma unroll 4
    for (int e = tid * 4; e < 32768; e += 512 * 4) {
        const float4 s = *(const float4*)(s0 + e), v = *(const float4*)(p.states() + ci * 32768 + e);
        const float dc = __expf(p.acum()[(ci * 64 + 63) * 8 + e / 4096]);
        uint2 o; o.x = pk2bf(s.x, s.y); o.y = pk2bf(s.z, s.w); *(uint2*)(p.prevb() + ci * 32768 + e) = o;
        float4 f; f.x = s.x * dc + v.x; f.y = s.y * dc + v.y; f.z = s.z * dc + v.z; f.w = s.w * dc + v.w;
        *(float4*)(p.out + OUT_SSMS + ((size_t)l * NB_S + b) * 32768 + e) = f;
    }
}

DEVI void ssd_y_unit(const P& p, int l, int ci, LAS unsigned char* lds, int tid, int wave, int lane) {
    const int c32 = lane & 31, hh = lane >> 5, r0 = ci * 64, g = wave >> 2;
    LAS float* part = (LAS float*)lds;
    const f32x16_t z16 = {0.f, 0.f, 0.f, 0.f, 0.f, 0.f, 0.f, 0.f, 0.f, 0.f, 0.f, 0.f, 0.f, 0.f, 0.f, 0.f};
    float y[2][2][16];
#pragma unroll
    for (int tb = 0; tb < 2; ++tb) {
        const size_t r = (size_t)r0 + 32 * tb + c32; const float eat = __expf(p.acum()[r * 8 + wave]); float ssq = 0.f;
#pragma unroll
        for (int pb = 0; pb < 2; ++pb) {
            f32x16_t YO = z16;
#pragma unroll
            for (int kk = 0; kk < 4; ++kk) {
                const bf16x8_t a = *(const bf16x8_t*)(p.prevb() + ((size_t)(ci * 8 + wave) * 64 + 32 * pb + c32) * 64 + 16 * kk + 8 * hh);
                const bf16x8_t b = *(const bf16x8_t*)(p.cact() + r * 128 + g * 64 + 16 * kk + 8 * hh);
                YO = __builtin_amdgcn_mfma_f32_32x32x16_bf16(a, b, YO, 0, 0, 0);
            }
#pragma unroll
            for (int q = 0; q < 4; ++q) { const int p0 = wave * 64 + 32 * pb + 8 * q + 4 * hh;
                const float4 yd = *(const float4*)(p.ydg() + r * 512 + p0); const uint2 zz = *(const uint2*)(p.proj() + r * NP + O_Z + p0);
                const float z0 = __uint_as_float(zz.x << 16), z1 = __uint_as_float(zz.x & 0xffff0000u), z2 = __uint_as_float(zz.y << 16), z3 = __uint_as_float(zz.y & 0xffff0000u);
                const float v0 = (yd.x + YO[4 * q] * eat) * silu_fast(z0), v1 = (yd.y + YO[4 * q + 1] * eat) * silu_fast(z1), v2 = (yd.z + YO[4 * q + 2] * eat) * silu_fast(z2), v3 = (yd.w + YO[4 * q + 3] * eat) * silu_fast(z3);
                y[tb][pb][4 * q] = v0; y[tb][pb][4 * q + 1] = v1; y[tb][pb][4 * q + 2] = v2; y[tb][pb][4 * q + 3] = v3; ssq += v0 * v0 + v1 * v1 + v2 * v2 + v3 * v3; }
        }
        ssq += __shfl_xor(ssq, 32);
        if (hh == 0) part[wave * 64 + 32 * tb + c32] = ssq;
    }
    __syncthreads();
    const float* gn = inp(19) + (size_t)l * 512;
#pragma unroll
    for (int tb = 0; tb < 2; ++tb) {
        const int t = 32 * tb + c32; float tot = 0.f;
#pragma unroll
        for (int w = 0; w < 8; ++w) tot += part[w * 64 + t];
        const float rstd = rsqrtf(tot * (1.f / 512) + EPS); const size_t r = (size_t)r0 + t;
#pragma unroll
        for (int pb = 0; pb < 2; ++pb)
#pragma unroll
            for (int q = 0; q < 4; ++q) { const int p0 = wave * 64 + 32 * pb + 8 * q + 4 * hh; const float4 gg = *(const float4*)(gn + p0);
                uint2 o; o.x = pk2bf(y[tb][pb][4 * q] * rstd * gg.x, y[tb][pb][4 * q + 1] * rstd * gg.y); o.y = pk2bf(y[tb][pb][4 * q + 2] * rstd * gg.z, y[tb][pb][4 * q + 3] * rstd * gg.w);
                *(uint2*)(p.mix() + r * D + p0) = o; }
    }
    __syncthreads();
}

DEVI float sum8(float v) { v += __shfl_xor(v, 1); v += __shfl_xor(v, 2); v += __shfl_xor(v, 4); return v; }
DEVI void unpack8(const u32x4_t w, float (&f)[8]) {
    f[0] = __uint_as_float(w.x << 16); f[1] = __uint_as_float(w.x & 0xffff0000u); f[2] = __uint_as_float(w.y << 16); f[3] = __uint_as_float(w.y & 0xffff0000u);
    f[4] = __uint_as_float(w.z << 16); f[5] = __uint_as_float(w.z & 0xffff0000u); f[6] = __uint_as_float(w.w << 16); f[7] = __uint_as_float(w.w & 0xffff0000u);
}
DEVI void rows_qkv(const P& p, int l, int gw, int NGW, int lane) {
    const int hi = lane >> 5, l32 = lane & 31;
    const float* gq = inp(20) + l * 64; const float* gk = inp(21) + l * 64;
    float gain[8];
#pragma unroll
    for (int i = 0; i < 8; ++i) gain[i] = (hi ? gk : gq)[(l32 & 7) * 8 + i] * (hi ? 1.f : 0.125f * LOG2E);
    u32x4_t nwa = {0u, 0u, 0u, 0u}, nwb = {0u, 0u, 0u, 0u};
    if (gw < M) { const bf16_t* pr = p.proj() + (size_t)gw * NP; nwa = *(const u32x4_t*)(pr + O_Q + 8 * lane); nwb = *(const u32x4_t*)(pr + (hi ? O_VM : O_V) + 8 * l32); }
    for (int r = gw; r < M; r += NGW) {
        const u32x4_t wa = nwa;
        const u32x4_t wb = nwb;
        if (r + NGW < M) { const bf16_t* pr = p.proj() + (size_t)(r + NGW) * NP; nwa = *(const u32x4_t*)(pr + O_Q + 8 * lane); nwb = *(const u32x4_t*)(pr + (hi ? O_VM : O_V) + 8 * l32); }
        float a[8], b[8]; unpack8(wa, a); unpack8(wb, b);
        float ss = 0.f;
#pragma unroll
        for (int i = 0; i < 8; ++i) ss += a[i] * a[i];
        const float rs = rsqrtf(sum8(ss) * (1.f / 64) + EPS);
        float o[8];
#pragma unroll
        for (int i = 0; i < 8; ++i) o[i] = a[i] * rs * gain[i];
        const u32x4_t ow = {pk2bf(o[0], o[1]), pk2bf(o[2], o[3]), pk2bf(o[4], o[5]), pk2bf(o[6], o[7])};
        if (hi == 0) *(u32x4_t*)(p.qb() + (size_t)r * 256 + 8 * l32) = ow;
        else { *(u32x4_t*)(p.kb() + (size_t)r * 256 + 8 * l32) = ow;
            float* ko = r < M_P ? p.out + OUT_KP + ((size_t)l * M_P + r) * 256 + 8 * l32 : p.out + OUT_KS + ((size_t)l * M_S + (r - M_P)) * 256 + 8 * l32;
            *(float4*)ko = make_float4(o[0], o[1], o[2], o[3]); *(float4*)(ko + 4) = make_float4(o[4], o[5], o[6], o[7]); }
        float ge[8]; float s1 = 0.f;
#pragma unroll
        for (int i = 0; i < 8; ++i) { ge[i] = gelu_f(b[i]); s1 += ge[i]; }
        const float mu = sum8(s1) * (1.f / 64); float s2 = 0.f;
#pragma unroll
        for (int i = 0; i < 8; ++i) { ge[i] -= mu; s2 += ge[i] * ge[i]; }
        const float rv = rsqrtf(sum8(s2) * (1.f / 64) + EPS);
        if (hi == 0) { *(u32x4_t*)(p.vb() + (size_t)r * 256 + 8 * l32) = wb;
            float* vo = r < M_P ? p.out + OUT_VP + ((size_t)l * M_P + r) * 256 + 8 * l32 : p.out + OUT_VS + ((size_t)l * M_S + (r - M_P)) * 256 + 8 * l32;
            *(float4*)vo = make_float4(b[0], b[1], b[2], b[3]); *(float4*)(vo + 4) = make_float4(b[4], b[5], b[6], b[7]);
        } else {
#pragma unroll
            for (int i = 0; i < 8; ++i) ge[i] *= rv;
            *(u32x4_t*)(p.vnb() + (size_t)r * 256 + 8 * l32) = (u32x4_t){pk2bf(ge[0], ge[1]), pk2bf(ge[2], ge[3]), pk2bf(ge[4], ge[5]), pk2bf(ge[6], ge[7])};
            if (r >= M_P) { float* mo = p.out + OUT_MLPV + ((size_t)l * M_S + (r - M_P)) * 256 + 8 * l32;
                *(float4*)mo = make_float4(ge[0], ge[1], ge[2], ge[3]); *(float4*)(mo + 4) = make_float4(ge[4], ge[5], ge[6], ge[7]); }
        }
    }
}

DEVI void mlp_unit(const P& p, int l, int u, int wave, int lane) {
    const int c32 = lane & 31, hh = lane >> 5, g = wave >> 1, db = wave & 1;
    const int L = u < 128 ? 128 : 64; const int r0 = u < 128 ? u * 128 : M_P + (u - 128) * 64;
    const int col = g * 64 + 32 * db + c32;
    const float* W = inp(23) + ((size_t)l * 4 + g) * 128 * 128; const float* bsv = inp(24) + ((size_t)l * 4 + g) * 128;
    const int NKS = L / 16;
    bf16x8_t vf[8];
#pragma unroll
    for (int ks = 0; ks < 8; ++ks) {
        if (ks < NKS) { const bf16_t* vp = p.vnb() + (size_t)(r0 + 16 * ks + 8 * hh) * 256 + col;
            unsigned short e[8];
#pragma unroll
            for (int j = 0; j < 8; ++j) e[j] = vp[(size_t)j * 256];
            const u32x4_t w = {(unsigned)e[0] | ((unsigned)e[1] << 16), (unsigned)e[2] | ((unsigned)e[3] << 16), (unsigned)e[4] | ((unsigned)e[5] << 16), (unsigned)e[6] | ((unsigned)e[7] << 16)};
            vf[ks] = __builtin_bit_cast(bf16x8_t, w); }
    }
    const f32x16_t z16 = {0.f, 0.f, 0.f, 0.f, 0.f, 0.f, 0.f, 0.f, 0.f, 0.f, 0.f, 0.f, 0.f, 0.f, 0.f, 0.f};
#pragma unroll
    for (int tb = 0; tb < 4; ++tb) {
        if (32 * tb < L) {
            const int t = 32 * tb + c32; f32x16_t Dv = z16;
#pragma unroll
            for (int ks = 0; ks < 2 * tb + 2; ++ks) {
                const float* wp = W + (size_t)t * 128 + 16 * ks + 8 * hh; const float4 w0 = *(const float4*)wp, w1 = *(const float4*)(wp + 4); const int sb = 16 * ks + 8 * hh;
                const bf16x8_t a = pack8(sb <= t ? w0.x : 0.f, sb + 1 <= t ? w0.y : 0.f, sb + 2 <= t ? w0.z : 0.f, sb + 3 <= t ? w0.w : 0.f, sb + 4 <= t ? w1.x : 0.f, sb + 5 <= t ? w1.y : 0.f, sb + 6 <= t ? w1.z : 0.f, sb + 7 <= t ? w1.w : 0.f);
                Dv = __builtin_amdgcn_mfma_f32_32x32x16_bf16(a, vf[ks], Dv, 0, 0, 0);
            }
#pragma unroll
            for (int e = 0; e < 16; ++e) { const int tt = 32 * tb + 8 * (e >> 2) + 4 * hh + (e & 3); const size_t r = (size_t)r0 + tt;
                const float uu = bf2f(p.proj()[r * NP + O_U + col]);
                p.mix()[r * D + 768 + col] = f2bf(gelu_f(uu) * (Dv[e] + bsv[tt])); }
        }
    }
}


DEVI void mod_phase(const P& p, LAS unsigned char* lds, int bid, int nblk, int tid, int wave, int lane) {
    LAS float* sc = (LAS float*)lds;
    LAS float* red = sc + NSEQ * D;
    const float* cp = inp(2); const float* cs = inp(3); const float* w_ada = inp(11); const float* b_ada = inp(12);
    for (int i = tid; i < NSEQ * D; i += 512) { const int s = i / D, k = i % D; const float c = s < NB_P ? cp[(size_t)s * D + k] : cs[(size_t)(s - NB_P) * D + k]; sc[i] = silu_f(c); }
    __syncthreads();
    for (int it = bid; it < DEPTH * 96; it += nblk) {
        const int ll = it / 96, j0 = (it % 96) * 64;
        const float* wp = w_ada + ((size_t)ll * D + 128 * wave) * 6144 + j0 + lane;
        float acc[NSEQ];
#pragma unroll
        for (int s = 0; s < NSEQ; ++s) acc[s] = 0.f;
        for (int k4 = 0; k4 < 32; ++k4) {
            const float w0 = wp[(size_t)(4 * k4) * 6144], w1 = wp[(size_t)(4 * k4 + 1) * 6144], w2 = wp[(size_t)(4 * k4 + 2) * 6144], w3 = wp[(size_t)(4 * k4 + 3) * 6144];
#pragma unroll
            for (int s = 0; s < NSEQ; ++s) { const f32x4_t c4 = *(const LAS f32x4_t*)(sc + s * D + 128 * wave + 4 * k4); acc[s] += c4[0] * w0 + c4[1] * w1 + c4[2] * w2 + c4[3] * w3; }
        }
#pragma unroll
        for (int s = 0; s < NSEQ; ++s) red[(wave * NSEQ + s) * 64 + lane] = acc[s];
        __syncthreads();
        for (int o = tid; o < NSEQ * 64; o += 512) { const int s = o >> 6, j = o & 63; float t = b_ada[(size_t)ll * 6144 + j0 + j];
#pragma unroll
            for (int w = 0; w < 8; ++w) t += red[(w * NSEQ + s) * 64 + j];
            p.mod()[((size_t)ll * NSEQ + s) * 6144 + j0 + j] = t; }
        __syncthreads();
    }
}


template <int MODE> DEVI void light_gemm_tile(const bf16_t* A, const bf16_t* Bt, int row0, int col0, bf16_t* Obf, int ldo, float* X, const float* Xin, const float* gate, LAS unsigned char* lds, int tid, int wave, int lane) {
    const int r32 = lane & 31, h = lane >> 5;
    bf16x8_t af[2][8], bfr[2][8];
#pragma unroll
    for (int rb = 0; rb < 2; ++rb)
#pragma unroll
        for (int ks = 0; ks < 8; ++ks) {
            af[rb][ks] = *(const bf16x8_t*)(A + (size_t)(row0 + 32 * rb + r32) * D + 128 * wave + 16 * ks + 8 * h);
            bfr[rb][ks] = *(const bf16x8_t*)(Bt + (size_t)(col0 + 32 * rb + r32) * D + 128 * wave + 16 * ks + 8 * h);
        }
    LAS float* part = (LAS float*)lds;
#pragma unroll
    for (int rb = 0; rb < 2; ++rb)
#pragma unroll
        for (int cb = 0; cb < 2; ++cb) {
            f32x16_t acc = {0.f, 0.f, 0.f, 0.f, 0.f, 0.f, 0.f, 0.f, 0.f, 0.f, 0.f, 0.f, 0.f, 0.f, 0.f, 0.f};
#pragma unroll
            for (int ks = 0; ks < 8; ++ks) acc = __builtin_amdgcn_mfma_f32_32x32x16_bf16(af[rb][ks], bfr[cb][ks], acc, 0, 0, 0);
#pragma unroll
            for (int g = 0; g < 16; ++g) part[((wave * 4 + rb * 2 + cb) * 16 + g) * 64 + lane] = acc[g];
        }
    __syncthreads();
#pragma unroll
    for (int i = 0; i < 8; ++i) {
        const int o = tid + 512 * i; const int ln = o & 63, g = (o >> 6) & 15, t4 = o >> 10;
        float v = 0.f;
#pragma unroll
        for (int w = 0; w < 8; ++w) v += part[((w * 4 + t4) * 16 + g) * 64 + ln];
        const int row = row0 + 32 * (t4 >> 1) + (g & 3) + 8 * (g >> 2) + 4 * (ln >> 5), col = col0 + 32 * (t4 & 1) + (ln & 31);
        if (MODE == 0) Obf[(size_t)row * ldo + col] = f2bf(v);
        else X[(size_t)row * D + col] = Xin[(size_t)row * D + col] + gate[(size_t)row_seq(row) * 6144 + col] * v;
    }
    __syncthreads();
}
constexpr int NTHR = 512;
constexpr int CONV_TOPK_ROWS = 19456, CONV_Q_ITEMS = (2 * NEXP - CONV_TOPK_ROWS) / 128;
constexpr int Q_PROMPT = 8 * 2 * (32 - APS_QB0) + 8 * APS_QB0;
constexpr int Q_ATT = Q_PROMPT + 256;
constexpr int QEND = ((Q_ATT - 1) / 4) * 5 + ((Q_ATT - 1) % 4) + 1;
static_assert(CONV_TOPK_ROWS % 4 == 0 && CONV_TOPK_ROWS < 2 * NEXP && 5 * (CONV_Q_ITEMS - 1) + 4 < QEND && (2 * NEXP - CONV_TOPK_ROWS) % 128 == 0, "every conversion item needs a queue slot");
constexpr int LDS_BYTES = 147456;

struct Args { P p; unsigned* bar; };

DEVI void tr_item(const float* W, int ldw, int K, bf16_t* WT, int dst_row0, int src_col0, int k0, LAS float* scr, int lane) {
#pragma unroll 8
    for (int i = 0; i < 32; ++i) { const int kk = 2 * i + (lane >> 5); scr[kk * 33 + (lane & 31)] = W[(size_t)(k0 + kk) * ldw + src_col0 + (lane & 31)]; }
    asm volatile("s_waitcnt lgkmcnt(0)" ::: "memory");
    const int c = lane & 7;
#pragma unroll
    for (int j = 0; j < 4; ++j) { const int n = (lane >> 3) + 8 * j; const LAS float* s = scr + (8 * c) * 33 + n;
        uint4 o; o.x = (unsigned)f2bf(s[0 * 33]) | ((unsigned)f2bf(s[1 * 33]) << 16); o.y = (unsigned)f2bf(s[2 * 33]) | ((unsigned)f2bf(s[3 * 33]) << 16);
        o.z = (unsigned)f2bf(s[4 * 33]) | ((unsigned)f2bf(s[5 * 33]) << 16); o.w = (unsigned)f2bf(s[6 * 33]) | ((unsigned)f2bf(s[7 * 33]) << 16);
        *(uint4*)(WT + (size_t)(dst_row0 + n) * K + k0 + 8 * c) = o; }
    asm volatile("s_waitcnt lgkmcnt(0)" ::: "memory");
}

__global__ void __launch_bounds__(NTHR, 2) mega_fwd(Args a) {
    extern __shared__ __attribute__((aligned(16))) unsigned char lds[];
    LAS unsigned* ctl = (LAS unsigned*)(lds + LDS_BYTES - 64);
    if (threadIdx.x < 16) ctl[threadIdx.x] = 0u;
    __syncthreads();
    const unsigned bar_x = (unsigned)__builtin_amdgcn_readfirstlane((int)xcd_barrier_post(a.bar, (volatile LAS unsigned*)ctl).x);
    const long gsz = (long)gridDim.x * NTHR;
    const int lane = threadIdx.x & 63, wave = __builtin_amdgcn_readfirstlane(threadIdx.x >> 6);
    const int gw = blockIdx.x * 8 + wave, NGW = gridDim.x * 8;
#define LPQ() P q_; { __attribute__((address_space(1))) float* go_ = (__attribute__((address_space(1))) float*)a.p.out; __attribute__((address_space(1))) unsigned char* gw2_ = (__attribute__((address_space(1))) unsigned char*)a.p.ws; asm volatile("" : "+s"(go_), "+s"(gw2_)); q_.out = (float*)go_; q_.ws = (unsigned char*)gw2_; }
#define RUN(PH) do { LPQ(); int t_ = threadIdx.x, b_ = blockIdx.x, lr_ = l; asm volatile("" : "+v"(t_), "+s"(b_), "+s"(lr_)); const long g_ = (long)b_ * NTHR + t_; run_phase<PH>(q_, lr_, g_, gsz); } while (0)
#define LAUNDER() LPQ(); int l_ = l, gw_ = gw, lane_ = lane, bid_ = (int)blockIdx.x; asm volatile("" : "+s"(l_), "+s"(gw_), "+v"(lane_), "+s"(bid_)); (void)l_; (void)gw_; (void)lane_; (void)bid_
#define BAR() do { XcdBarrier bb_; bb_.bar = a.bar; asm volatile("" : "+s"(bb_.bar)); unsigned bx_ = bar_x; asm volatile("" : "+s"(bx_)); bb_.x = bx_; bb_.st = (volatile LAS unsigned*)(lds + LDS_BYTES - 64); xcd_barrier(bb_); } while (0)
    { LPQ(); int t_ = threadIdx.x, b_ = blockIdx.x; asm volatile("" : "+v"(t_), "+s"(b_)); mod_phase(q_, (LAS unsigned char*)lds, b_, (int)gridDim.x, t_, __builtin_amdgcn_readfirstlane(t_ >> 6), t_ & 63); }
    { const int l = 0; RUN(PH_PRO_SMALL); RUN(PH_PRO_TAB); }
    { LPQ(); const P& p = q_;
        LAS float* scr = (LAS float*)(lds + wave * 16384);
        constexpr int I_IN = (NP / 32) * 16, I_OUT = (D / 32) * 16, I_Q = (2048 / 32) * 16, I_L = I_IN + I_OUT + I_Q;
        for (int it = gw; it < DEPTH * I_L; it += NGW) {
            const int ll = it / I_L; int r = it % I_L;
            if (r < I_IN) { const int nb = r / 16, kb = r % 16; const int n0 = nb * 32; const int src = n0 < 1280 ? n0 : (n0 < 2048 ? n0 + 8 : n0 + 12);
                tr_item(inp(13) + (size_t)ll * D * DPROJ, DPROJ, D, p.w_in_t() + (size_t)ll * NP * D, n0, src, kb * 64, scr, lane); continue; }
            r -= I_IN;
            if (r < I_OUT) { const int nb = r / 16, kb = r % 16; tr_item(inp(25) + (size_t)ll * D * D, D, D, p.w_out_t() + (size_t)ll * D * D, nb * 32, nb * 32, kb * 64, scr, lane); continue; }
            r -= I_OUT;
            { const int nb = r / 16, kb = r % 16; tr_item(inp(26) + (size_t)ll * D * 2048, 2048, D, p.wq_t() + (size_t)ll * 2048 * D, nb * 32, nb * 32, kb * 64, scr, lane); }
        }
    }
    BAR();
    for (int l = 0; l < DEPTH; ++l) {
        if (l == 0) { { LAUNDER(); adaln_rows<1>(q_, l_, gw_, NGW, lane_, true); } BAR(); }
        { LAUNDER(); pg8::Gemm g{q_.hb(), q_.w_in_t() + (size_t)l_ * NP * D, M, NP, D}; pg8::StaticOrder S; S.init(M, NP, (int)gridDim.x, bid_);
          pg8::EpiBf16 E{q_.proj(), NP};
          pg8::gemm_phase<pg8::EpiBf16, pg8::StaticOrder, true, true>((PG8_LAS unsigned char*)lds, g, S, E); }
        { LAUNDER(); const int rem_ = ((M / 256) * (NP / 256)) % (int)gridDim.x;
          if (rem_ > 0 && ((int)gridDim.x - rem_) * 4 >= (int)gridDim.x) { if (bid_ >= rem_) scan_chunks(q_, l_, gw_ - rem_ * 8, NGW - rem_ * 8, lane_); }
          else scan_chunks(q_, l_, gw_, NGW, lane_);
        }
        BAR();
        { LAUNDER(); int tid_ = threadIdx.x; asm volatile("" : "+v"(tid_)); const int wv_ = __builtin_amdgcn_readfirstlane(tid_ >> 6);
          for (int ci = bid_; ci < NB_P * NCH_P; ci += (int)gridDim.x) ssd_chunk_unit(q_, l_, ci, (LAS unsigned char*)lds, tid_, wv_, tid_ & 63); }
        RUN(PH_CONVSTATE);
        { LAUNDER(); const int nx_ = NB_P * NCH_P - (int)gridDim.x;
          if (nx_ > 0 && nx_ * 2 < (int)gridDim.x) { if (bid_ >= nx_) { rows_qkv(q_, l_, gw_ - nx_ * 8, NGW - nx_ * 8, lane_); scan_fix(q_, gw_ - nx_ * 8, NGW - nx_ * 8, lane_); } }
          else { rows_qkv(q_, l_, gw_, NGW, lane_); scan_fix(q_, gw_, NGW, lane_); } }
        BAR();
        { LAUNDER(); for (int u = bid_; u < 144; u += (int)gridDim.x) mlp_unit(q_, l_, u, wave, lane_); }
        { LPQ(); int t_ = threadIdx.x, b_ = blockIdx.x, lr_ = l; asm volatile("" : "+v"(t_), "+s"(b_), "+s"(lr_)); const long g_ = (long)b_ * NTHR + t_; ssd_scan(q_, lr_, g_, gsz); }
        { LAUNDER(); int tid_ = threadIdx.x; asm volatile("" : "+v"(tid_)); const int wv_ = __builtin_amdgcn_readfirstlane(tid_ >> 6);
          const int sb_ = bid_ - ((int)gridDim.x - NB_S);
          if (sb_ >= 0 && (int)gridDim.x >= NB_S) {
              const int ci = NB_P * NCH_P + sb_;
              ssd_chunk_unit(q_, l_, ci, (LAS unsigned char*)lds, tid_, wv_, tid_ & 63);
              asm volatile("s_waitcnt vmcnt(0)" ::: "memory"); __syncthreads();
              ssd_scan_sample(q_, l_, sb_, tid_);
              asm volatile("s_waitcnt vmcnt(0)" ::: "memory"); __syncthreads();
              ssd_y_unit(q_, l_, ci, (LAS unsigned char*)lds, tid_, wv_, tid_ & 63);
              __syncthreads();
          } }
        { LAUNDER(); int tid_ = threadIdx.x; asm volatile("" : "+v"(tid_)); const int wv_ = __builtin_amdgcn_readfirstlane(tid_ >> 6);
          float mq = fabsf(inp(20)[l_ * 64 + lane_]), mk = fabsf(inp(21)[l_ * 64 + lane_]);
#pragma unroll
          for (int o = 1; o < 64; o <<= 1) { mq = fmaxf(mq, __shfl_xor(mq, o)); mk = fmaxf(mk, __shfl_xor(mk, o)); }
          const float sb2 = 2.02f * 64.f * 0.125f * LOG2E * mq * mk;
          unsigned* qctr = a.bar + 3600 + l_; asm volatile("" : "+s"(qctr));
          LAS int* qslot = (LAS int*)(lds + 81920);
          for (;;) {
              if (tid_ == 0) *qslot = (int)__hip_atomic_fetch_add(qctr, 1u, __ATOMIC_RELAXED, __HIP_MEMORY_SCOPE_AGENT);
              __syncthreads();
              const int it0 = __builtin_amdgcn_readfirstlane(*qslot);
              if (it0 >= QEND) break;
              const int qc = it0 / 5, qr = it0 - 5 * qc;
              if (qr == 4) {
                  if (qc < CONV_Q_ITEMS) peer_tables_fp8(q_, l_, CONV_TOPK_ROWS + qc * 128, CONV_TOPK_ROWS + (qc + 1) * 128, wv_, 8, tid_ & 63);
                  __syncthreads(); continue; }
              const int it = qc * 4 + qr;
              if (it < Q_PROMPT) {
                  static_assert(APS_QB0 == 16, "queue order below assumes 16 split + 16 whole row blocks");
                  const int r_ = it / 24, k_ = it - 24 * r_;
                  if (k_ < 16) { const int bh = k_ >> 1; attn_unit<false>(q_, l_, bh >> 2, bh & 3, 31 - r_, sb2, (LAS unsigned char*)lds, tid_, wv_, tid_ & 63, k_ & 1); }
                  else { const int bh = k_ - 16; attn_unit<false>(q_, l_, bh >> 2, bh & 3, 15 - r_, sb2, (LAS unsigned char*)lds, tid_, wv_, tid_ & 63, -1); } }
              else { const int si = it - Q_PROMPT; attn_unit<true>(q_, l_, si >> 4, (si >> 2) & 3, si & 3, sb2, (LAS unsigned char*)lds, tid_, wv_, tid_ & 63); }
          } }
        BAR();
        { LAUNDER(); int tid_ = threadIdx.x; asm volatile("" : "+v"(tid_)); const int wv_ = __builtin_amdgcn_readfirstlane(tid_ >> 6);
          for (int ci = bid_; ci < NB_P * NCH_P; ci += (int)gridDim.x) ssd_y_unit(q_, l_, ci, (LAS unsigned char*)lds, tid_, wv_, tid_ & 63); }
        { LPQ(); int t_ = threadIdx.x, b_ = blockIdx.x; asm volatile("" : "+v"(t_), "+s"(b_)); const int nx_ = NB_P * NCH_P - (int)gridDim.x;
          if (nx_ > 0 && nx_ * 2 < (int)gridDim.x) { if (b_ >= nx_) attn_sample_combine(q_, (long)(b_ - nx_) * NTHR + t_, gsz - (long)nx_ * NTHR); }
          else attn_sample_combine(q_, (long)b_ * NTHR + t_, gsz);
          attn_prompt_combine(q_, (long)b_ * NTHR + t_, gsz); }
        BAR();
        { LAUNDER(); pg8::Gemm g{q_.mix(), q_.w_out_t() + (size_t)l_ * D * D, M_P, D, D}; pg8::StaticOrder S; S.init(M_P, D, (int)gridDim.x, bid_);
          pg8::EpiResid E{q_.x(), q_.mod() + (size_t)l_ * NSEQ * 6144 + 2 * D, l_ == 0 ? inp(0) : (const float*)q_.x()};
          pg8::gemm_phase<pg8::EpiResid, pg8::StaticOrder, true, true>((PG8_LAS unsigned char*)lds, g, S, E); }
        { LAUNDER(); int tid_ = threadIdx.x; asm volatile("" : "+v"(tid_));
          for (int t = bid_; t < (M_S / 64) * (D / 64); t += (int)gridDim.x)
              light_gemm_tile<1>(q_.mix(), q_.w_out_t() + (size_t)l_ * D * D, M_P + 64 * (t / (D / 64)), 64 * (t % (D / 64)), (bf16_t*)nullptr, 0, q_.x(), l_ == 0 ? inp(1) - (size_t)M_P * D : (const float*)q_.x(), q_.mod() + (size_t)l_ * NSEQ * 6144 + 2 * D, (LAS unsigned char*)lds, tid_, wave, tid_ & 63); }
        BAR();
        { LAUNDER(); adaln_rows<2>(q_, l_, gw_, NGW, lane_); }
        BAR();
        { LAUNDER(); pg8::Gemm g{q_.hb(), q_.wq_t() + (size_t)l_ * 2048 * D, M_P, 2048, D}; pg8::StaticOrder S; S.init(M_P, 2048, (int)gridDim.x, bid_);
          pg8::EpiBf16 E{q_.pq(), 2048};
          pg8::gemm_phase<pg8::EpiBf16, pg8::StaticOrder, true, true>((PG8_LAS unsigned char*)lds, g, S, E); }
        { LAUNDER(); int tid_ = threadIdx.x; asm volatile("" : "+v"(tid_));
          for (int t = bid_; t < (M_S / 64) * (2048 / 64); t += (int)gridDim.x)
              light_gemm_tile<0>(q_.hb(), q_.wq_t() + (size_t)l_ * 2048 * D, M_P + 64 * (t / 32), 64 * (t % 32), q_.pq(), 2048, (float*)nullptr, (const float*)nullptr, (const float*)nullptr, (LAS unsigned char*)lds, tid_, wave, tid_ & 63); }
        BAR();
        { LAUNDER();
          for (int u = bid_; u < M / 32; u += (int)gridDim.x)
              peer_topk_unit(q_.pq(), q_.keysb() + (size_t)l_ * 16 * 128 * 128, q_.eidx(), q_.gw(), u * 32, wave, lane_, (LAS unsigned char*)lds + wave * 1024); }
        { LAUNDER(); const int rem_ = (M / 32) % (int)gridDim.x;
          if (rem_ > 0 && ((int)gridDim.x - rem_) * 2 >= (int)gridDim.x) { if (bid_ >= rem_) peer_tables_fp8(q_, l_, 0, CONV_TOPK_ROWS, gw_ - rem_ * 8, NGW - rem_ * 8, lane_); }
          else peer_tables_fp8(q_, l_, 0, CONV_TOPK_ROWS, gw_, NGW, lane_); }
        BAR();
        { LAUNDER();
#define GARGS q_.u8() + (size_t)l_ * NEXP * D, q_.v8() + (size_t)l_ * NEXP * D, q_.sinv() + (size_t)l_ * NEXP, q_.sinv() + (size_t)(DEPTH + l_) * NEXP, q_.h8(), q_.eidx(), q_.gw(), q_.x(), q_.mod() + (size_t)l_ * NSEQ * 6144 + 5 * D
          for (int k0 = 0; gw_ + NGW * k0 < M_P; k0 += 8) {
#pragma unroll 1
              for (int k = 0; k < 8; ++k) { const int tok = gw_ + NGW * (k0 + k);
                  if (tok < M_P) peer_gather_token_t<8, 1>(q_, l_, 0, -1, (LAS float*)nullptr, GARGS, tok, lane_, (LAS unsigned char*)lds + wave * 8192 + k * 1024); }
#pragma unroll 1
              for (int k = 0; k < 8; ++k) { const int tok = gw_ + NGW * (k0 + k);
                  if (tok < M_P) peer_gather_token_t<8, 2>(q_, l_, 0, -1, (LAS float*)nullptr, GARGS, tok, lane_, (LAS unsigned char*)lds + wave * 8192 + k * 1024); }
          }
          for (int j = bid_; j < M_S / 4; j += (int)gridDim.x)
              peer_gather_token_t<4>(q_, l_, 4 * (wave >> 2), wave >> 2, (LAS float*)(lds + 65536) + (wave & 3) * 1024, q_.u8() + (size_t)l_ * NEXP * D, q_.v8() + (size_t)l_ * NEXP * D, q_.sinv() + (size_t)l_ * NEXP, q_.sinv() + (size_t)(DEPTH + l_) * NEXP, q_.h8(), q_.eidx(), q_.gw(), q_.x(), q_.mod() + (size_t)l_ * NSEQ * 6144 + 5 * D, M_P + 4 * j + (wave & 3), lane_, (LAS unsigned char*)lds + wave * 8192);
        }
        BAR();
    }
#undef RUN
#undef BAR
}

extern "C" void kernel_launch(void* const* d_in, const int* in_sizes, int n_in, void* d_out, int out_size, void* d_ws, size_t ws_size, hipStream_t stream) {
    static int grid = 0;
    if (grid == 0) {
        int dev = 0, cus = 0;
        (void)hipGetDevice(&dev); (void)hipDeviceGetAttribute(&cus, hipDeviceAttributeMultiprocessorCount, dev);
        (void)hipFuncSetAttribute((const void*)mega_fwd, hipFuncAttributeMaxDynamicSharedMemorySize, LDS_BYTES);
        (void)hipGetLastError();
        grid = cus > 0 ? cus : 256;
    }
    if (ws_size < WS_END || n_in < 30) return;
    Args a{};
    P& p = a.p;
    for (int i = 0; i < 30; ++i) p.in[i] = (const float*)d_in[i];
    p.out = (float*)d_out;
    p.ws = (unsigned char*)d_ws; a.bar = (unsigned*)d_ws;
    (void)hipMemsetAsync(d_ws, 0, 16384, stream);
    hipLaunchKernelGGL(mega_fwd, dim3(grid), dim3(NTHR), LDS_BYTES, stream, a);
}
```
